# Optimizing an MI355X kernel written in HIP

```python
import math
import jax
import jax.numpy as jnp
from jax import lax
import numpy as np

D_MODEL = 2048
BATCH = 4
SEQ = 4096
DEPTH = 1

SSD_INNER = D_MODEL
SSD_HEADDIM = 64
SSD_HEADS = SSD_INNER // SSD_HEADDIM
SSD_GROUPS = 4
SSD_STATE = 128
SSD_CONV = 4
SSD_CHUNK = 128
SSD_XBC = SSD_INNER + 2 * SSD_GROUPS * SSD_STATE
ATTN_HEADS = D_MODEL // 128
ATTN_DK = 64
ATTN_DV = 2 * ATTN_DK
ATTN_WIDTH = ATTN_HEADS * ATTN_DV
ROT_DIM = ATTN_DK // 4
ROPE_THETA = 500000.0
Q_BLOCK = 128
N_EXPERTS = 32
TOP_K = 4
D_EXPERT = D_MODEL
SWIGLU_LIMIT = 7.0
SWIGLU_ALPHA = 1.702
MOE_BLOCK = 256
NORM_EPS = 1e-6
SUB_EPS = 1e-5
IN_SIZES = (SSD_INNER, SSD_XBC, SSD_HEADS, 2 * ATTN_HEADS * ATTN_DK, 2 * ATTN_HEADS * ATTN_DK, ATTN_WIDTH, D_MODEL, D_MODEL)
D_IN = sum(IN_SIZES)
IN_SPLITS = tuple(sum(IN_SIZES[:i + 1]) for i in range(len(IN_SIZES) - 1))

kernel_name = 'hybrid_ssd_diffattn_moe_adaln_block'


def rmsnorm(x, w, eps=NORM_EPS):
    xf = x.astype(jnp.float32)
    y = xf * lax.rsqrt(jnp.mean(xf * xf, axis=-1, keepdims=True) + eps)
    return (y * w.astype(jnp.float32)).astype(x.dtype)


def causal_depthwise_conv(u, w, b):
    y = lax.conv_general_dilated(u, w[:, None, :].astype(u.dtype), window_strides=(1,), padding=[(SSD_CONV - 1, 0)], dimension_numbers=('NWC', 'WIO', 'NWC'), feature_group_count=u.shape[-1])
    return y + b


def ssd_chunked(xs, dt, A, Bm, Cm):
    b, s, h, p = xs.shape
    g, n = Bm.shape[-2:]
    e = h // g
    nc = s // SSD_CHUNK
    L = SSD_CHUNK
    a = (dt * A).reshape(b, nc, L, g, e)
    X = (xs * dt[..., None]).reshape(b, nc, L, g, e, p)
    Bc = Bm.reshape(b, nc, L, g, n)
    Cc = Cm.reshape(b, nc, L, g, n)
    a_cs = jnp.cumsum(a, axis=2)
    causal = jnp.tril(jnp.ones((L, L), dtype=bool))[None, None, :, :, None, None]
    seg = a_cs[:, :, :, None] - a_cs[:, :, None, :]
    decay_in = jnp.exp(jnp.where(causal, seg, -jnp.inf))
    scores = jnp.einsum('bclgn,bcsgn->bclsg', Cc, Bc)
    y_diag = jnp.einsum('bclsge,bcsgep->bclgep', scores[..., None] * decay_in, X)
    decay_to_end = jnp.exp(a_cs[:, :, -1:] - a_cs)
    chunk_states = jnp.einsum('bclgn,bclgep->bcgepn', Bc, X * decay_to_end[..., None])
    chunk_decay = jnp.exp(a_cs[:, :, -1])

    def carry_state(state, inp):
        st, dec = inp
        return state * dec[..., None, None] + st, state

    init = jnp.zeros((b, g, e, p, n), jnp.float32)
    _, prev = lax.scan(carry_state, init, (jnp.moveaxis(chunk_states, 1, 0), jnp.moveaxis(chunk_decay, 1, 0)))
    prev = jnp.moveaxis(prev, 0, 1)
    y_off = jnp.einsum('bclgn,bcgepn->bclgep', Cc, prev) * jnp.exp(a_cs)[..., None]
    return (y_diag + y_off).reshape(b, s, h, p)


def gated_group_rmsnorm(y, z, w):
    b, s, d = y.shape
    u = (y * jax.nn.silu(z.astype(jnp.float32))).reshape(b, s, SSD_GROUPS, d // SSD_GROUPS)
    u = u * lax.rsqrt(jnp.mean(u * u, axis=-1, keepdims=True) + SUB_EPS)
    return u.reshape(b, s, d) * w.astype(jnp.float32)


def rope_tables(s):
    inv = ROPE_THETA ** (-jnp.arange(0, ROT_DIM, 2, dtype=jnp.float32) / ROT_DIM)
    ang = jnp.arange(s, dtype=jnp.float32)[:, None] * inv[None, :]
    return jnp.cos(ang), jnp.sin(ang)


def partial_rope(x, cos, sin):
    xf = x.astype(jnp.float32)
    x1 = xf[..., :ROT_DIM // 2]
    x2 = xf[..., ROT_DIM // 2:ROT_DIM]
    c = cos[None, :, None, :]
    s_ = sin[None, :, None, :]
    rot = jnp.concatenate([x1 * c - x2 * s_, x2 * c + x1 * s_], axis=-1).astype(x.dtype)
    return jnp.concatenate([rot, x[..., ROT_DIM:]], axis=-1)


def diff_attention(q, k, v, lam, lam_init, subln_w):
    b, s = q.shape[:2]
    nq = s // Q_BLOCK
    scale = ATTN_DK ** -0.5
    qb = q.reshape(b, nq, Q_BLOCK, 2 * ATTN_HEADS, ATTN_DK).transpose(1, 0, 3, 2, 4)
    kt = k.transpose(0, 2, 1, 3)
    vt = v.transpose(0, 2, 1, 3)
    kpos = jnp.arange(s)

    def block(args):
        qi, i = args
        qpos = i * Q_BLOCK + jnp.arange(Q_BLOCK)
        sc = jnp.einsum('bhqd,bhkd->bhqk', qi, kt).astype(jnp.float32) * scale
        sc = jnp.where(kpos[None, :] <= qpos[:, None], sc, -jnp.inf)
        pr = jax.nn.softmax(sc, axis=-1).reshape(b, ATTN_HEADS, 2, Q_BLOCK, s)
        att = pr[:, :, 0] - lam * pr[:, :, 1]
        return jnp.einsum('bhqk,bhkd->bhqd', att.astype(vt.dtype), vt)

    o = lax.map(block, (qb, jnp.arange(nq)))
    o = o.transpose(1, 0, 3, 2, 4).reshape(b, s, ATTN_HEADS, ATTN_DV)
    o = rmsnorm(o, subln_w, SUB_EPS) * (1.0 - lam_init)
    return o.reshape(b, s, ATTN_WIDTH)


def moe_ffn(h, w_router, b_router, w_gate_up, b_gate_up, w_down, b_down):
    bsz, s, d = h.shape
    t = h.reshape(-1, d)
    T = t.shape[0]
    TK = T * TOP_K
    logits = (t @ w_router + b_router).astype(jnp.float32)
    top_val, top_idx = lax.top_k(logits, TOP_K)
    top_w = jax.nn.softmax(top_val, axis=-1)
    flat_e = top_idx.reshape(-1)
    flat_tok = jnp.arange(TK, dtype=jnp.int32) // TOP_K
    flat_w = top_w.reshape(-1)
    order = jnp.argsort(flat_e)
    sorted_e = flat_e[order]
    counts = jnp.bincount(flat_e, length=N_EXPERTS)
    group_start = jnp.cumsum(counts) - counts
    padded = ((counts + MOE_BLOCK - 1) // MOE_BLOCK) * MOE_BLOCK
    padded_end = jnp.cumsum(padded)
    padded_start = padded_end - padded
    dest = padded_start[sorted_e] + (jnp.arange(TK) - group_start[sorted_e])
    n_slots = ((TK + MOE_BLOCK - 1) // MOE_BLOCK) * MOE_BLOCK + N_EXPERTS * MOE_BLOCK
    n_blocks = n_slots // MOE_BLOCK
    slot_tok = jnp.zeros((n_slots,), jnp.int32).at[dest].set(flat_tok[order])
    slot_w = jnp.zeros((n_slots,), jnp.float32).at[dest].set(flat_w[order])
    block_e = jnp.minimum(jnp.searchsorted(padded_end, jnp.arange(n_blocks) * MOE_BLOCK, side='right'), N_EXPERTS - 1)

    def expert_block(args):
        tok, wt, e = args
        xb = t[tok]
        gu = xb @ w_gate_up[e] + b_gate_up[e]
        gate = jnp.minimum(gu[:, :D_EXPERT], SWIGLU_LIMIT)
        up = jnp.clip(gu[:, D_EXPERT:], -SWIGLU_LIMIT, SWIGLU_LIMIT)
        act = (up + 1.0) * gate * jax.nn.sigmoid(SWIGLU_ALPHA * gate)
        y = act @ w_down[e] + b_down[e]
        return (y * wt[:, None]).astype(t.dtype)

    ys = lax.map(expert_block, (slot_tok.reshape(n_blocks, MOE_BLOCK), slot_w.reshape(n_blocks, MOE_BLOCK), block_e))
    out = jnp.zeros_like(t).at[slot_tok].add(ys.reshape(n_slots, d))
    return out.reshape(bsz, s, d)


def setup_inputs(seed: int = 0) -> dict:
    key = jax.random.key(seed)
    ks = jax.random.split(key, 32)
    f32 = jnp.float32
    nrm = lambda k, shape, sc: jax.random.normal(k, shape, f32) * sc
    dt = jnp.exp(jax.random.uniform(ks[9], (DEPTH, SSD_HEADS), f32) * (math.log(0.1) - math.log(0.001)) + math.log(0.001))
    return {
        'x': nrm(ks[0], (BATCH, SEQ, D_MODEL), 1.0),
        'c': nrm(ks[1], (BATCH, D_MODEL), 1.0),
        'w_ada': nrm(ks[2], (DEPTH, D_MODEL, 6 * D_MODEL), D_MODEL ** -0.5),
        'b_ada': nrm(ks[3], (DEPTH, 6 * D_MODEL), 0.02),
        'g_pre_mix': 1.0 + nrm(ks[4], (DEPTH, D_MODEL), 0.1),
        'g_post_mix': 1.0 + nrm(ks[5], (DEPTH, D_MODEL), 0.1),
        'g_pre_ffn': 1.0 + nrm(ks[6], (DEPTH, D_MODEL), 0.1),
        'g_post_ffn': 1.0 + nrm(ks[7], (DEPTH, D_MODEL), 0.1),
        'w_in': nrm(ks[8], (DEPTH, D_MODEL, D_IN), D_MODEL ** -0.5),
        'conv_w': nrm(ks[10], (DEPTH, SSD_CONV, SSD_XBC), SSD_CONV ** -0.5),
        'conv_b': nrm(ks[11], (DEPTH, SSD_XBC), 0.02),
        'dt_bias': dt + jnp.log(-jnp.expm1(-dt)),
        'a_log': jnp.log(jax.random.uniform(ks[12], (DEPTH, SSD_HEADS), f32, 1.0, 16.0)),
        'd_skip': 1.0 + nrm(ks[13], (DEPTH, SSD_HEADS), 0.1),
        'ssd_norm_w': 1.0 + nrm(ks[14], (DEPTH, SSD_INNER), 0.1),
        'lambda_q1': nrm(ks[15], (DEPTH, ATTN_DK), 0.1),
        'lambda_k1': nrm(ks[16], (DEPTH, ATTN_DK), 0.1),
        'lambda_q2': nrm(ks[17], (DEPTH, ATTN_DK), 0.1),
        'lambda_k2': nrm(ks[18], (DEPTH, ATTN_DK), 0.1),
        'subln_w': 1.0 + nrm(ks[19], (DEPTH, ATTN_DV), 0.1),
        'w_br_ssd': nrm(ks[20], (DEPTH, SSD_INNER, D_MODEL), SSD_INNER ** -0.5),
        'w_br_attn': nrm(ks[21], (DEPTH, ATTN_WIDTH, D_MODEL), ATTN_WIDTH ** -0.5),
        'w_out': nrm(ks[22], (DEPTH, D_MODEL, D_MODEL), D_MODEL ** -0.5),
        'w_router': nrm(ks[23], (DEPTH, D_MODEL, N_EXPERTS), D_MODEL ** -0.5),
        'b_router': nrm(ks[24], (DEPTH, N_EXPERTS), 0.01),
        'w_gate_up': nrm(ks[25], (DEPTH, N_EXPERTS, D_MODEL, 2 * D_EXPERT), D_MODEL ** -0.5),
        'b_gate_up': nrm(ks[26], (DEPTH, N_EXPERTS, 2 * D_EXPERT), 0.02),
        'w_down': nrm(ks[27], (DEPTH, N_EXPERTS, D_EXPERT, D_MODEL), D_EXPERT ** -0.5),
        'b_down': nrm(ks[28], (DEPTH, N_EXPERTS, D_MODEL), 0.02),
    }


def reference(x, c, w_ada, b_ada, g_pre_mix, g_post_mix, g_pre_ffn, g_post_ffn, w_in, conv_w, conv_b, dt_bias, a_log, d_skip, ssd_norm_w, lambda_q1, lambda_k1, lambda_q2, lambda_k2, subln_w, w_br_ssd, w_br_attn, w_out, w_router, b_router, w_gate_up, b_gate_up, w_down, b_down):
    bsz, s, _ = x.shape
    cos, sin = rope_tables(s)
    for l in range(DEPTH):
        mod = jax.nn.silu(c) @ w_ada[l] + b_ada[l]
        sh_m, sc_m, gt_m, sh_f, sc_f, gt_f = [m[:, None, :] for m in jnp.split(mod, 6, axis=-1)]

        h = rmsnorm(x, g_pre_mix[l]) * (1.0 + sc_m) + sh_m
        proj = h @ w_in[l]
        z, xbc, dt_raw, q, k, v, gate_s, gate_a = jnp.split(proj, IN_SPLITS, axis=-1)

        xbc = jax.nn.silu(causal_depthwise_conv(xbc, conv_w[l], conv_b[l]))
        xs, bm, cm = jnp.split(xbc, [SSD_INNER, SSD_INNER + SSD_GROUPS * SSD_STATE], axis=-1)
        xs = xs.reshape(bsz, s, SSD_HEADS, SSD_HEADDIM).astype(jnp.float32)
        bm = bm.reshape(bsz, s, SSD_GROUPS, SSD_STATE).astype(jnp.float32)
        cm = cm.reshape(bsz, s, SSD_GROUPS, SSD_STATE).astype(jnp.float32)
        dt = jax.nn.softplus(dt_raw.astype(jnp.float32) + dt_bias[l].astype(jnp.float32))
        A = -jnp.exp(a_log[l].astype(jnp.float32))
        y = ssd_chunked(xs, dt, A, bm, cm) + d_skip[l].astype(jnp.float32)[:, None] * xs
        y = gated_group_rmsnorm(y.reshape(bsz, s, SSD_INNER), z, ssd_norm_w[l]).astype(x.dtype)
        branch_ssd = y @ w_br_ssd[l]

        q = partial_rope(q.reshape(bsz, s, 2 * ATTN_HEADS, ATTN_DK), cos, sin)
        k = partial_rope(k.reshape(bsz, s, 2 * ATTN_HEADS, ATTN_DK), cos, sin)
        v = v.reshape(bsz, s, ATTN_HEADS, ATTN_DV)
        lam_init = 0.8 - 0.6 * math.exp(-0.3 * l)
        lam = (jnp.exp(jnp.sum(lambda_q1[l].astype(jnp.float32) * lambda_k1[l].astype(jnp.float32)))
               - jnp.exp(jnp.sum(lambda_q2[l].astype(jnp.float32) * lambda_k2[l].astype(jnp.float32))) + lam_init)
        o = diff_attention(q, k, v, lam, lam_init, subln_w[l])
        branch_attn = o @ w_br_attn[l]

        merged = jax.nn.sigmoid(gate_s) * branch_ssd + jax.nn.sigmoid(gate_a) * branch_attn
        mix = merged @ w_out[l]
        x = x + gt_m * rmsnorm(mix, g_post_mix[l])

        h2 = rmsnorm(x, g_pre_ffn[l]) * (1.0 + sc_f) + sh_f
        f = moe_ffn(h2, w_router[l], b_router[l], w_gate_up[l], b_gate_up[l], w_down[l], b_down[l])
        x = x + gt_f * rmsnorm(f, g_post_ffn[l])
    return x
```

```cpp
#include <hip/hip_runtime.h>
#include <cstdio>
#include <cstdint>

#define LAS __attribute__((address_space(3)))
#define GAS __attribute__((address_space(1)))
typedef unsigned short bf16;
typedef short bf16x8 __attribute__((ext_vector_type(8)));
typedef short s16x4 __attribute__((ext_vector_type(4)));
typedef float f32x2 __attribute__((ext_vector_type(2)));
typedef float f32x4 __attribute__((ext_vector_type(4)));
typedef float f32x16 __attribute__((ext_vector_type(16)));
typedef unsigned u32x2 __attribute__((ext_vector_type(2)));
typedef unsigned u32x4 __attribute__((ext_vector_type(4)));

#ifndef MK_PER_PHASE
#define MK_PER_PHASE 0
#endif

constexpr int DM = 2048, NB = 4, SEQ = 4096, MT = NB * SEQ;
constexpr int NE = 32, TOPK = 4, NSLOT_ROWS = MT * TOPK + NE * 256;
constexpr int NPROJ_T = 61, NPROJ = NPROJ_T * 256;
constexpr int XBCW = 3072;
constexpr int NWAVES = 8, NTHR = 512;
constexpr int NPH = 14;

constexpr size_t MiB = 1u << 20;
constexpr size_t WS_CTL = 0, CTL_ZERO_BYTES = 1 * MiB;
constexpr size_t WS_MOD = 1, WS_ROPE = 2, WS_WR = 3, WS_RSTD = 4, WS_LISTS = 8, WS_ACS = 16, WS_DT = 18, WS_DTRAW = 20;
constexpr size_t WS_WT_IN = 32, WS_WT_BS = 96, WS_WT_BA = 104, WS_WT_OUT = 112, WS_WT_GU = 128, WS_WT_DN = 640;
constexpr size_t WS_H = 896, WS_Z = 960, WS_XBC = 1024, WS_Q = 1120, WS_K = 1184, WS_V = 1248, WS_SGS = 1312, WS_SGA = 1376, WS_XBCC = 1440;
constexpr size_t WS_YDIAG = 1536, WS_STATES = 1664, WS_YBUF = 1792, WS_OATT = 1856, WS_OFIN = 1984, WS_M1 = 2048, WS_MERGED = 2176, WS_MIX = 2240;
constexpr size_t WS_X1 = 2368, WS_H2 = 2496, WS_ACT = 2560, WS_YS = 2848, WS_END = 3104;
constexpr int CW_BAR = 4096;
constexpr int CW_CNT = 16384;
constexpr size_t MOD_CB = 256 * 1024;
constexpr size_t LIST_STRIDE = 2 * MiB;

constexpr int RING_BYTES = 131072;
constexpr int TAB_OFF = RING_BYTES;
constexpr int MISC_OFF = RING_BYTES + 1024;
constexpr int LDS_BYTES = 147456;

#define RLX_AGENT __ATOMIC_RELAXED, __HIP_MEMORY_SCOPE_AGENT
#define LDS_WAIT() asm volatile("s_waitcnt lgkmcnt(0)" ::: "memory")
#define VM_WAIT() asm volatile("s_waitcnt vmcnt(0)" ::: "memory")
#define SBAR() __builtin_amdgcn_sched_barrier(0)
__device__ __forceinline__ unsigned f2bf(float f) { unsigned u = __builtin_bit_cast(unsigned, f); return (u + 0x7fffu + ((u >> 16) & 1u)) >> 16; }
__device__ __forceinline__ unsigned pk2(float lo, float hi) { return f2bf(lo) | (f2bf(hi) << 16); }
__device__ __forceinline__ float bf2f(unsigned short b) { return __builtin_bit_cast(float, (unsigned)b << 16); }
__device__ __forceinline__ float bflo(unsigned w) { return __builtin_bit_cast(float, w << 16); }
__device__ __forceinline__ float bfhi(unsigned w) { return __builtin_bit_cast(float, w & 0xffff0000u); }
__device__ __forceinline__ unsigned cvt_pk_bf16(float lo, float hi) { unsigned r; asm volatile("v_cvt_pk_bf16_f32 %0, %1, %2" : "=v"(r) : "v"(lo), "v"(hi)); return r; }
__device__ __forceinline__ float sigmoidf_(float x) { return 1.0f / (1.0f + __expf(-x)); }
__device__ __forceinline__ float siluf_(float x) { return x / (1.0f + __expf(-x)); }
__device__ __forceinline__ float wave_sum(float v) {
#pragma unroll
    for (int o = 1; o < 64; o <<= 1) v += __shfl_xor(v, o);
    return v;
}

#define XB_TMO      128
#define XB_XCNT(j)  (256  + 64 * (j))
#define XB_XSUB(j)  (1280 + 64 * (j))
#define XB_XGEN(j)  (2304 + 64 * (j))
#define XB_TOP      3328
#define XB_TOPGEN   3392
#define XCD_BAR_WORDS 3456
#define XB_SPIN_CAP (1u << 18)
__device__ __forceinline__ unsigned xb_ld(unsigned* p)              { return __hip_atomic_load(p, __ATOMIC_RELAXED, __HIP_MEMORY_SCOPE_AGENT); }
__device__ __forceinline__ unsigned xb_add(unsigned* p, unsigned v) { return __hip_atomic_fetch_add(p, v, __ATOMIC_RELAXED, __HIP_MEMORY_SCOPE_AGENT); }
__device__ __forceinline__ unsigned xb_xcc_id() { return (unsigned)__builtin_amdgcn_s_getreg((3 << 11) | 20) & 0xFu; }
#define XB_SPIN(cond, bar) do { unsigned _sp = 0; while (cond) { __builtin_amdgcn_s_sleep(1); \
    if ((++_sp & 255u) == 0u) { if (xb_ld(&(bar)[XB_TMO])) break; if (_sp > XB_SPIN_CAP) { atomicAdd(&(bar)[XB_TMO], 1u); break; } } } } while (0)
struct XcdBarrier { unsigned* bar; unsigned x; volatile LAS unsigned* st; };
__device__ __forceinline__ XcdBarrier xcd_barrier_post(unsigned* bar, volatile LAS unsigned* st) {
    XcdBarrier b; b.bar = bar; b.x = xb_xcc_id(); b.st = st;
    if (threadIdx.x == 0) (void)xb_add(&bar[XB_XCNT(b.x)], 1u);
    return b;
}
__device__ __forceinline__ void xcd_barrier_complete(unsigned* bar, unsigned x, unsigned& nloc, unsigned& nx) {
    const unsigned G = gridDim.x * gridDim.y * gridDim.z;
    unsigned sum, cnt, mine, sp = 0u;
    for (;;) {
        sum = 0u; cnt = 0u; mine = 0u;
#pragma unroll
        for (unsigned j = 0; j < 16; ++j) { const unsigned c = xb_ld(&bar[XB_XCNT(j)]); sum += c; cnt += (c > 0u) ? 1u : 0u; mine = (j == x) ? c : mine; }
        if (sum == G) break;
        __builtin_amdgcn_s_sleep(1);
        if ((++sp & 255u) == 0u) { if (xb_ld(&bar[XB_TMO])) break; if (sp > XB_SPIN_CAP) { atomicAdd(&bar[XB_TMO], 1u); break; } }
    }
    nloc = mine > 0u ? mine : 1u; nx = cnt > 0u ? cnt : 1u;
}
__device__ __forceinline__ void xcd_barrier(const XcdBarrier& b) {
    asm volatile("s_waitcnt vmcnt(0)" ::: "memory");
    __syncthreads();
    if (threadIdx.x == 0) {
        unsigned* bar = b.bar;
        __builtin_amdgcn_s_waitcnt(0);
        unsigned nloc = b.st[0], nx = b.st[1];
        if (nloc == 0u) { xcd_barrier_complete(bar, b.x, nloc, nx); b.st[0] = nloc; b.st[1] = nx; }
        const unsigned old = xb_add(&bar[XB_XSUB(b.x)], 1u);
        const unsigned gen = old / nloc;
        if (old + 1u == (gen + 1u) * nloc) {
            __builtin_amdgcn_fence(__ATOMIC_RELEASE, "agent");
            asm volatile("s_waitcnt vmcnt(0)" ::: "memory");
            const unsigned og = xb_add(&bar[XB_TOP], 1u);
            const unsigned tg = og / nx;
            if (og + 1u == (tg + 1u) * nx) xb_add(&bar[XB_TOPGEN], 1u);
            else XB_SPIN(xb_ld(&bar[XB_TOPGEN]) == tg, bar);
            __builtin_amdgcn_fence(__ATOMIC_ACQUIRE, "agent");
            xb_add(&bar[XB_XGEN(b.x)], 1u);
            asm volatile("s_waitcnt vmcnt(0)" ::: "memory");
        } else {
            XB_SPIN(xb_ld(&bar[XB_XGEN(b.x)]) == gen, bar);
            __builtin_amdgcn_fence(__ATOMIC_ACQUIRE, "agent");
            asm volatile("s_waitcnt vmcnt(0)" ::: "memory");
        }
    }
    __syncthreads();
}
namespace pg8 {
constexpr int BM = 256, BK = 64, HALF = 128, HTB = HALF * BK * 2, STAGE_BYTES = 8 * HTB, NXCD = 8, WGM = 8;
__host__ __device__ __forceinline__ int lds_byte(int r, int c) { const int st = (r >> 4) * 2 + (c >> 5), rr = r & 15, cc = c & 31, ob = rr * 64 + cc * 2; return st * 1024 + (ob ^ (((ob >> 9) & 1) << 5)); }
__host__ __device__ __forceinline__ void stage_rc(int b, int& R, int& C) { const int st = b / 1024, sb = b % 1024, swz = sb ^ (((sb >> 9) & 1) << 5); R = (st >> 1) * 16 + swz / 64; C = (st & 1) * 32 + (swz % 64) / 2; }
__host__ __device__ __forceinline__ int perm32(int rho) { const int n = rho >> 4, i = rho & 15; return 8 * (i >> 2) + 4 * n + (i & 3); }

struct Unit { int pm, pn, e, ml; };

struct ProbDense {
    const char* A; const char* Bt; int K;
    int nM, nN, nwg, G, c;
    __device__ __forceinline__ void init(const void* A_, const void* Bt_, int M, int N, int K_, int G_, int c_) { A = (const char*)A_; Bt = (const char*)Bt_; K = K_; nM = M / BM; nN = N / BM; nwg = nM * nN; G = G_; c = c_; }
    __device__ __forceinline__ bool next(int i, Unit& u) const {
        const long L = (long)i * G + c; if (L >= nwg) return false;
        int wgid = (int)L; { const int q = nwg / NXCD, r = nwg % NXCD, xcd = wgid % NXCD, off = wgid / NXCD; wgid = (xcd < r ? xcd * (q + 1) : r * (q + 1) + (xcd - r) * q) + off; }
        const int nig = WGM * nN, gid = wgid / nig, fm = gid * WGM, gsz = (nM - fm) < WGM ? (nM - fm) : WGM;
        u.pm = fm + ((wgid % nig) % gsz); u.pn = (wgid % nig) / gsz; u.e = 0; u.ml = 0; return true;
    }
    __device__ __forceinline__ const char* b_ptr(const Unit& u) const { return Bt + (size_t)u.pn * BM * K * 2; }
    __device__ __forceinline__ void a_offs(const Unit& u, const int (&R)[2], const int (&C)[2], unsigned (&off)[2][2]) const {
#pragma unroll
        for (int h = 0; h < 2; ++h)
#pragma unroll
            for (int i = 0; i < 2; ++i) off[h][i] = (unsigned)(((u.pm * BM + h * HALF + R[i]) * K + C[i]) * 2);
    }
};

template <bool GATHER> struct ProbMoE {
    const char* A; const char* Bt; int K, nN; size_t estride;
    const int* list_tok; const LAS int* tab; int G, c;
    __device__ __forceinline__ bool next(int i, Unit& u) const {
        const int L = i * G + c; const int NT = tab[64];
        if (L >= NT * nN) return false;
        int e = 0;
#pragma unroll 1
        for (int j = 1; j < 32; ++j) if (L >= tab[32 + j] * nN) e = j;
        const int tb = tab[32 + e], ntile = tab[33 + e] - tb, Lp = L - tb * nN;
        u.e = e; u.pn = Lp / ntile; u.ml = Lp % ntile; u.pm = tb + u.ml; return true;
    }
    __device__ __forceinline__ const char* b_ptr(const Unit& u) const { return Bt + (size_t)u.e * estride + (size_t)u.pn * BM * K * 2; }
    __device__ __forceinline__ void a_offs(const Unit& u, const int (&R)[2], const int (&C)[2], unsigned (&off)[2][2]) const {
        if constexpr (GATHER) {
            const int cnt = tab[u.e];
#pragma unroll
            for (int h = 0; h < 2; ++h)
#pragma unroll
                for (int i = 0; i < 2; ++i) { const int j = u.ml * BM + h * HALF + R[i]; const int tok = (j < cnt) ? list_tok[u.e * 16384 + j] : 0; off[h][i] = (unsigned)((tok * K + C[i]) * 2); }
        } else {
#pragma unroll
            for (int h = 0; h < 2; ++h)
#pragma unroll
                for (int i = 0; i < 2; ++i) off[h][i] = (unsigned)(((u.pm * BM + h * HALF + R[i]) * K + C[i]) * 2);
        }
    }
};

template <class Epi, class Prob, bool ALIGN_EPI>
__device__ __forceinline__ void gemm_phase(LAS unsigned char* lds, const Prob& P, const Epi& E) {
    const int tid = threadIdx.x, wid = __builtin_amdgcn_readfirstlane(tid >> 6), lane = tid & 63, wr = wid >> 2, wc = wid & 3, fr = lane & 15, fq = lane >> 4;
    const int K = P.K, nt = K / BK;
    unsigned voffB[2]; int RA[2], CA[2];
#pragma unroll
    for (int i = 0; i < 2; ++i) { int R, C; stage_rc(tid * 16 + i * 8192, R, C); const int Rb = Epi::PERM ? ((R & ~31) + perm32(R & 31)) : R;
        RA[i] = R; CA[i] = C; voffB[i] = (unsigned)(Rb * K + C) * 2u; }
    const size_t kstep = (size_t)(BK * 2);
    const size_t hstep = (size_t)HALF * K * 2;
    const unsigned ldsw = (unsigned)wid * 1024u;
    const int aoff = lds_byte(wr * 64 + fr, fq * 8), boff = lds_byte(wc * 32 + fr, fq * 8);
#define PG8_SA(b, h) (((b) * 2 + (h)) * HTB)
#define PG8_SB(b, h) ((4 + (b) * 2 + (h)) * HTB)
#define PG8_STAGE(bufoff, gbase, voff) do { _Pragma("unroll") for (int _i = 0; _i < 2; ++_i) \
        __builtin_amdgcn_global_load_lds((const unsigned*)((const char*)(gbase) + (voff)[_i]), (LAS unsigned*)(lds + (bufoff) + ldsw + _i * 8192), 16, 0, 0); } while (0)
#define PG8_LDA(dst, b, h) do { _Pragma("unroll") for (int m = 0; m < 4; ++m) _Pragma("unroll") for (int k = 0; k < 2; ++k) dst[m][k] = *(const LAS bf16x8*)(lds + PG8_SA(b, h) + aoff + m * 2048 + k * 1024); } while (0)
#define PG8_LDB(dst, b, h) do { _Pragma("unroll") for (int n = 0; n < 2; ++n) _Pragma("unroll") for (int k = 0; k < 2; ++k) dst[n][k] = *(const LAS bf16x8*)(lds + PG8_SB(b, h) + boff + n * 2048 + k * 1024); } while (0)
#define PG8_MMA(ai, bj, At, Bt) do { __builtin_amdgcn_s_setprio(1); _Pragma("unroll") for (int m = 0; m < 4; ++m) _Pragma("unroll") for (int n = 0; n < 2; ++n) _Pragma("unroll") for (int k = 0; k < 2; ++k) \
        acc[ai][bj][m][n] = __builtin_amdgcn_mfma_f32_16x16x32_bf16(Bt[n][k], At[m][k], acc[ai][bj][m][n], 0, 0, 0); __builtin_amdgcn_s_setprio(0); } while (0)
#define PG8_WAIT_V(n) asm volatile("s_waitcnt vmcnt(" #n ")" ::: "memory")
#define PG8_WAIT_L(n) asm volatile("s_waitcnt lgkmcnt(" #n ")" ::: "memory")
#define PG8_BAR __builtin_amdgcn_s_barrier()
    Unit cur, nxt; int ui = 0;
    if (!P.next(0, cur)) return;
    f32x4 acc[2][2][4][2];
#pragma unroll
    for (int a = 0; a < 2; ++a)
#pragma unroll
        for (int b = 0; b < 2; ++b)
#pragma unroll
            for (int m = 0; m < 4; ++m)
#pragma unroll
                for (int n = 0; n < 2; ++n) acc[a][b][m][n] = (f32x4){0.f, 0.f, 0.f, 0.f};
    bf16x8 At[4][2], B0[2][2], B1[2][2];
    unsigned offA[2][2], noffA[2][2];
    P.a_offs(cur, RA, CA, offA);
    const char* Ab = P.A;
    const char* cB = P.b_ptr(cur);
    PG8_STAGE(PG8_SB(0, 0), cB, voffB); PG8_STAGE(PG8_SB(0, 1), cB + hstep, voffB); PG8_STAGE(PG8_SA(0, 0), Ab, offA[0]); PG8_STAGE(PG8_SA(0, 1), Ab, offA[1]);
    if (wr == 1) PG8_BAR;
    PG8_WAIT_V(2); PG8_BAR;
    PG8_STAGE(PG8_SB(1, 0), cB + kstep, voffB); PG8_STAGE(PG8_SA(1, 0), Ab + kstep, offA[0]); PG8_STAGE(PG8_SB(1, 1), cB + hstep + kstep, voffB);
    PG8_WAIT_V(6); PG8_BAR;
    for (;;) {
        const bool has_next = P.next(ui + 1, nxt);
        if (has_next) P.a_offs(nxt, RA, CA, noffA);
        else {
#pragma unroll
            for (int h = 0; h < 2; ++h)
#pragma unroll
                for (int i = 0; i < 2; ++i) noffA[h][i] = offA[h][i];
        }
        const char* nB = has_next ? P.b_ptr(nxt) : cB;
        for (int t = 0; t < nt; t += 2) {
            const bool last = (t == nt - 2);
            const char* a1 = Ab + (size_t)(t + 1) * kstep;
            const char* a2 = last ? Ab : Ab + (size_t)(t + 2) * kstep; const char* b2 = last ? nB : cB + (size_t)(t + 2) * kstep;
            const char* a3 = a2 + kstep; const char* b3 = b2 + kstep;
            unsigned o2[2][2];
#pragma unroll
            for (int h = 0; h < 2; ++h)
#pragma unroll
                for (int i = 0; i < 2; ++i) o2[h][i] = last ? noffA[h][i] : offA[h][i];
            PG8_LDB(B0, 0, 0); PG8_LDB(B1, 0, 1); SBAR(); PG8_LDA(At, 0, 0); PG8_STAGE(PG8_SA(1, 1), a1, offA[1]);
            PG8_WAIT_V(8); PG8_WAIT_L(0); PG8_BAR; PG8_MMA(0, 0, At, B0); PG8_MMA(0, 1, At, B1); PG8_BAR; SBAR();
            PG8_LDA(At, 0, 1); PG8_STAGE(PG8_SB(0, 0), b2, voffB); PG8_STAGE(PG8_SB(0, 1), b2 + hstep, voffB); PG8_STAGE(PG8_SA(0, 0), a2, o2[0]);
            PG8_WAIT_V(8); PG8_WAIT_L(0); PG8_BAR; PG8_MMA(1, 0, At, B0); PG8_MMA(1, 1, At, B1); PG8_BAR; SBAR();
            PG8_LDB(B0, 1, 0); PG8_LDB(B1, 1, 1); SBAR(); PG8_LDA(At, 1, 0); PG8_STAGE(PG8_SA(0, 1), a2, o2[1]);
            PG8_WAIT_V(8); PG8_WAIT_L(0); PG8_BAR; PG8_MMA(0, 0, At, B0); PG8_MMA(0, 1, At, B1); PG8_BAR; SBAR();
            PG8_LDA(At, 1, 1); PG8_STAGE(PG8_SB(1, 0), b3, voffB); PG8_STAGE(PG8_SB(1, 1), b3 + hstep, voffB); PG8_STAGE(PG8_SA(1, 0), a3, o2[0]);
            PG8_WAIT_V(8); PG8_WAIT_L(0); PG8_BAR; PG8_MMA(1, 0, At, B0); PG8_MMA(1, 1, At, B1); PG8_BAR; SBAR();
        }
        if constexpr (ALIGN_EPI) { if (wr == 0) PG8_BAR; }
        E(acc, cur, wr, wc, fr, fq);
        if (!has_next) break;
#pragma unroll
        for (int a = 0; a < 2; ++a)
#pragma unroll
            for (int b = 0; b < 2; ++b)
#pragma unroll
                for (int m = 0; m < 4; ++m)
#pragma unroll
                    for (int n = 0; n < 2; ++n) acc[a][b][m][n] = (f32x4){0.f, 0.f, 0.f, 0.f};
        cur = nxt; cB = nB; ++ui;
#pragma unroll
        for (int h = 0; h < 2; ++h)
#pragma unroll
            for (int i = 0; i < 2; ++i) offA[h][i] = noffA[h][i];
        if constexpr (ALIGN_EPI) { if (wr == 1) PG8_BAR; }
    }
    PG8_WAIT_V(0);
    if constexpr (!ALIGN_EPI) { if (wr == 0) PG8_BAR; }
    PG8_BAR;
#undef PG8_SA
#undef PG8_SB
#undef PG8_STAGE
#undef PG8_LDA
#undef PG8_LDB
#undef PG8_MMA
#undef PG8_WAIT_V
#undef PG8_WAIT_L
#undef PG8_BAR
}
}
namespace pg8 {
struct EpiInProj {
    static constexpr bool PERM = true;
    unsigned char* ws;
    __device__ __forceinline__ void operator()(const f32x4 (&acc)[2][2][4][2], const Unit& u, int wr, int wc, int fr, int fq) const {
        const int pn = u.pn; const int row0 = u.pm * BM + wr * 64 + fr;
        if (pn == 60) {
            if (wc == 0) { float* dst = (float*)(ws + WS_DTRAW * MiB);
#pragma unroll
                for (int ai = 0; ai < 2; ++ai)
#pragma unroll
                    for (int m = 0; m < 4; ++m) { float* rp = dst + (size_t)(row0 + ai * HALF + m * 16) * 32 + 8 * fq;
                        *(f32x4*)rp = acc[ai][0][m][0]; *(f32x4*)(rp + 4) = acc[ai][0][m][1]; } }
            return;
        }
        bf16* base; int ldc, colt; bool sig = false;
        if (pn < 8)       { base = (bf16*)(ws + WS_Z * MiB);   ldc = DM;   colt = pn * BM; }
        else if (pn < 20) { base = (bf16*)(ws + WS_XBC * MiB); ldc = XBCW; colt = (pn - 8) * BM; }
        else if (pn < 28) { base = (bf16*)(ws + WS_Q * MiB);   ldc = DM;   colt = (pn - 20) * BM; }
        else if (pn < 36) { base = (bf16*)(ws + WS_K * MiB);   ldc = DM;   colt = (pn - 28) * BM; }
        else if (pn < 44) { base = (bf16*)(ws + WS_V * MiB);   ldc = DM;   colt = (pn - 36) * BM; }
        else if (pn < 52) { base = (bf16*)(ws + WS_SGS * MiB); ldc = DM;   colt = (pn - 44) * BM; sig = true; }
        else              { base = (bf16*)(ws + WS_SGA * MiB); ldc = DM;   colt = (pn - 52) * BM; sig = true; }
        const int col0 = colt + wc * 32 + 8 * fq;
#pragma unroll
        for (int ai = 0; ai < 2; ++ai)
#pragma unroll
            for (int m = 0; m < 4; ++m) { bf16* rowp = base + (size_t)(row0 + ai * HALF + m * 16) * ldc + col0;
#pragma unroll
                for (int bj = 0; bj < 2; ++bj) { f32x4 v0 = acc[ai][bj][m][0], v1 = acc[ai][bj][m][1];
                    if (sig) {
#pragma unroll
                        for (int q = 0; q < 4; ++q) { v0[q] = sigmoidf_(v0[q]); v1[q] = sigmoidf_(v1[q]); } }
                    u32x4 w; w.x = cvt_pk_bf16(v0[0], v0[1]); w.y = cvt_pk_bf16(v0[2], v0[3]); w.z = cvt_pk_bf16(v1[0], v1[1]); w.w = cvt_pk_bf16(v1[2], v1[3]);
                    *(u32x4*)(rowp + bj * HALF) = w; } }
    }
};
struct EpiBr1 {
    static constexpr bool PERM = false;
    const bf16* sg; float* m1;
    __device__ __forceinline__ void operator()(const f32x4 (&acc)[2][2][4][2], const Unit& u, int wr, int wc, int fr, int fq) const {
        const int row0 = u.pm * BM + wr * 64 + fr, col0 = u.pn * BM + wc * 32 + 4 * fq;
#pragma unroll
        for (int ai = 0; ai < 2; ++ai)
#pragma unroll
            for (int m = 0; m < 4; ++m) { const size_t off = (size_t)(row0 + ai * HALF + m * 16) * DM + col0;
#pragma unroll
                for (int bj = 0; bj < 2; ++bj)
#pragma unroll
                    for (int n = 0; n < 2; ++n) { const u32x2 g = *(const u32x2*)(sg + off + bj * HALF + n * 16); const f32x4 a = acc[ai][bj][m][n];
                        *(f32x4*)(m1 + off + bj * HALF + n * 16) = (f32x4){a[0] * bflo(g.x), a[1] * bfhi(g.x), a[2] * bflo(g.y), a[3] * bfhi(g.y)}; } }
    }
};
struct EpiBr2 {
    static constexpr bool PERM = false;
    const bf16* sg; const float* m1; bf16* out;
    __device__ __forceinline__ void operator()(const f32x4 (&acc)[2][2][4][2], const Unit& u, int wr, int wc, int fr, int fq) const {
        const int row0 = u.pm * BM + wr * 64 + fr, col0 = u.pn * BM + wc * 32 + 4 * fq;
#pragma unroll
        for (int ai = 0; ai < 2; ++ai)
#pragma unroll
            for (int m = 0; m < 4; ++m) { const size_t off = (size_t)(row0 + ai * HALF + m * 16) * DM + col0;
#pragma unroll
                for (int bj = 0; bj < 2; ++bj)
#pragma unroll
                    for (int n = 0; n < 2; ++n) { const size_t o2 = off + bj * HALF + n * 16; const u32x2 g = *(const u32x2*)(sg + o2); const f32x4 a = acc[ai][bj][m][n]; const f32x4 p = *(const f32x4*)(m1 + o2);
                        u32x2 w; w.x = cvt_pk_bf16(p[0] + a[0] * bflo(g.x), p[1] + a[1] * bfhi(g.x)); w.y = cvt_pk_bf16(p[2] + a[2] * bflo(g.y), p[3] + a[3] * bfhi(g.y));
                        *(u32x2*)(out + o2) = w; } }
    }
};
struct EpiF32 {
    static constexpr bool PERM = false;
    float* out; int ldc;
    __device__ __forceinline__ void operator()(const f32x4 (&acc)[2][2][4][2], const Unit& u, int wr, int wc, int fr, int fq) const {
        const int row0 = u.pm * BM + wr * 64 + fr, col0 = u.pn * BM + wc * 32 + 4 * fq;
#pragma unroll
        for (int ai = 0; ai < 2; ++ai)
#pragma unroll
            for (int m = 0; m < 4; ++m) { const size_t off = (size_t)(row0 + ai * HALF + m * 16) * ldc + col0;
#pragma unroll
                for (int bj = 0; bj < 2; ++bj)
#pragma unroll
                    for (int n = 0; n < 2; ++n) *(f32x4*)(out + off + bj * HALF + n * 16) = acc[ai][bj][m][n]; }
    }
};
struct EpiGateUp {
    static constexpr bool PERM = true;
    const float* bgu; bf16* act;
    __device__ __forceinline__ void operator()(const f32x4 (&acc)[2][2][4][2], const Unit& u, int wr, int wc, int fr, int fq) const {
        const int row0 = u.pm * BM + wr * 64 + fr; const int f0 = u.pn * 128 + wc * 16 + 4 * fq;
        const float* bg = bgu + (size_t)u.e * 4096;
#pragma unroll
        for (int bj = 0; bj < 2; ++bj) { const int f = f0 + bj * 64; const f32x4 bgate = *(const f32x4*)(bg + f), bup = *(const f32x4*)(bg + 2048 + f);
#pragma unroll
            for (int ai = 0; ai < 2; ++ai)
#pragma unroll
                for (int m = 0; m < 4; ++m) { const f32x4 g4 = acc[ai][bj][m][0] + bgate, u4 = acc[ai][bj][m][1] + bup; float r[4];
#pragma unroll
                    for (int q = 0; q < 4; ++q) { const float g = fminf(g4[q], 7.0f), up = fminf(fmaxf(u4[q], -7.0f), 7.0f); r[q] = (up + 1.0f) * g * sigmoidf_(1.702f * g); }
                    u32x2 w; w.x = cvt_pk_bf16(r[0], r[1]); w.y = cvt_pk_bf16(r[2], r[3]);
                    *(u32x2*)(act + (size_t)(row0 + ai * HALF + m * 16) * DM + f) = w; } }
    }
};
struct EpiDown {
    static constexpr bool PERM = true;
    const float* bdn; const int* list_dst; const float* list_w; const LAS int* tab; bf16* ys;
    __device__ __forceinline__ void operator()(const f32x4 (&acc)[2][2][4][2], const Unit& u, int wr, int wc, int fr, int fq) const {
        const int cnt = tab[u.e]; const int col0 = u.pn * BM + wc * 32 + 8 * fq; const float* bd = bdn + (size_t)u.e * DM + col0;
        f32x4 bv[2][2];
#pragma unroll
        for (int bj = 0; bj < 2; ++bj)
#pragma unroll
            for (int n = 0; n < 2; ++n) bv[bj][n] = *(const f32x4*)(bd + bj * HALF + 4 * n);
#pragma unroll
        for (int ai = 0; ai < 2; ++ai)
#pragma unroll
            for (int m = 0; m < 4; ++m) { const int j = u.ml * BM + ai * HALF + wr * 64 + m * 16 + fr;
                if (j < cnt) { const int dst = list_dst[u.e * 16384 + j]; const float w = list_w[u.e * 16384 + j]; bf16* rowp = ys + (size_t)dst * DM + col0;
#pragma unroll
                    for (int bj = 0; bj < 2; ++bj) { const f32x4 v0 = (acc[ai][bj][m][0] + bv[bj][0]) * w, v1 = (acc[ai][bj][m][1] + bv[bj][1]) * w;
                        u32x4 o; o.x = cvt_pk_bf16(v0[0], v0[1]); o.y = cvt_pk_bf16(v0[2], v0[3]); o.z = cvt_pk_bf16(v1[0], v1[1]); o.w = cvt_pk_bf16(v1[2], v1[3]);
                        *(u32x4*)(rowp + bj * HALF) = o; } } }
    }
};
}
namespace att {
constexpr int NW = 8, QBLK = 32, KVBLK = 64, QB = NW * QBLK;
constexpr int SHM_V = KVBLK * 128 * 2, SHM_K = KVBLK * 64 * 2;
constexpr int LDS_BYTES = 2 * SHM_V + 2 * SHM_K + NW * 64 * 4;
constexpr int QP = 2048, OP = 4096;
constexpr float SCALE = 0.125f, THR = 8.f;
#define KSWZ(row, colB) ((row) * 128 + ((colB) ^ ((((row) >> 1) & 7) << 4)))
__device__ __forceinline__ int v_st(int k, int c) { const int kk = (k & ~0xC) | ((k & 4) << 1) | ((k & 8) >> 1); return ((kk >> 3) * 4 + (c >> 5)) * 512 + ((kk & 7) * 32 + (c & 31)) * 2; }
__device__ __forceinline__ int v_rd_base(int lane) { return ((lane & 3) << 3) | (((lane >> 2) & 3) << 6) | (((lane >> 4) & 1) << 5) | (((lane >> 5) & 1) << 8); }
constexpr int v_rd_off(int d0, int ks, int half) { return d0 * 512 + ks * 4096 + half * 2048; }
__device__ __forceinline__ int crow(int r, int hi) { return (r & 3) + 8 * (r >> 2) + 4 * hi; }
__device__ __forceinline__ unsigned cvtpk(float lo, float hi) { unsigned r; asm volatile("v_cvt_pk_bf16_f32 %0, %1, %2" : "=v"(r) : "v"(lo), "v"(hi)); return r; }
__device__ __forceinline__ bf16x8 load8(const bf16* p) { return *reinterpret_cast<const bf16x8*>(p); }
__device__ __forceinline__ void mask_tile(f32x16& p0, f32x16& p1, int dq) {
    const float NEG = -__builtin_inff();
#pragma unroll
    for (int r = 0; r < 16; ++r) {
        const int c = (r & 3) + 8 * (r >> 2);
        if (dq - c < 0) p0[r] = NEG;
        if (dq - c - 32 < 0) p1[r] = NEG;
    }
}
__device__ __forceinline__ void partialSM(f32x16& p0, f32x16& p1, float& m_reg, float& mn, float& alpha) {
    float pmax = p0[0];
#pragma unroll
    for (int r = 1; r < 16; ++r) pmax = fmaxf(pmax, p0[r]);
#pragma unroll
    for (int r = 0; r < 16; ++r) pmax = fmaxf(pmax, p1[r]);
    { auto rr = __builtin_amdgcn_permlane32_swap(__float_as_uint(pmax), __float_as_uint(pmax), false, false);
      pmax = fmaxf(__uint_as_float(rr[0]), __uint_as_float(rr[1])); }
    constexpr float C2 = 1.4426950408889634f * SCALE;
    if (__builtin_expect(__all((pmax - m_reg) * SCALE <= THR), 1)) { mn = m_reg; alpha = 1.f; }
    else { mn = fmaxf(m_reg, pmax); alpha = __builtin_amdgcn_exp2f((m_reg - mn) * C2); m_reg = mn; }
    const float mnL = -mn * C2;
#pragma unroll
    for (int r = 0; r < 16; ++r) p0[r] = fmaf(p0[r], C2, mnL);
#pragma unroll
    for (int r = 0; r < 16; ++r) p1[r] = fmaf(p1[r], C2, mnL);
#pragma unroll
    for (int r = 0; r < 16; ++r) p0[r] = __builtin_amdgcn_exp2f(p0[r]);
}
__device__ __forceinline__ void finishSM(f32x16& p0, f32x16& p1, float alpha, float& l_reg, bf16x8& pa0, bf16x8& pa1, bf16x8& pa2, bf16x8& pa3) {
#pragma unroll
    for (int r = 0; r < 16; ++r) p1[r] = __builtin_amdgcn_exp2f(p1[r]);
    float ps = 0;
#pragma unroll
    for (int r = 0; r < 16; ++r) ps += p0[r];
#pragma unroll
    for (int r = 0; r < 16; ++r) ps += p1[r];
    { auto rr = __builtin_amdgcn_permlane32_swap(__float_as_uint(ps), __float_as_uint(ps), false, false);
      ps = __uint_as_float(rr[0]) + __uint_as_float(rr[1]); }
    l_reg = l_reg * alpha + ps;
#define PK4(P, B_, OUT) do { unsigned a0 = cvtpk(P[B_+0], P[B_+1]), a1 = cvtpk(P[B_+2], P[B_+3]);                          \
        unsigned b0 = cvtpk(P[B_+4], P[B_+5]), b1 = cvtpk(P[B_+6], P[B_+7]);                                             \
        auto r0 = __builtin_amdgcn_permlane32_swap(a0, b0, false, false); auto r1 = __builtin_amdgcn_permlane32_swap(a1, b1, false, false); \
        u32x4 w = {r0[0], r1[0], r0[1], r1[1]}; OUT = *reinterpret_cast<bf16x8*>(&w); } while (0)
    PK4(p0, 0, pa0); PK4(p0, 8, pa1); PK4(p1, 0, pa2); PK4(p1, 8, pa3);
#undef PK4
}
template <int KB>
__device__ __forceinline__ void qkt(f32x16& p0, f32x16& p1, const char* K_lds, int r32, int hi, const bf16x8* qr) {
    p0 = f32x16{}; p1 = f32x16{};
#pragma unroll
    for (int d0 = 0; d0 < 4; ++d0) { const char* a = K_lds + KB * SHM_K + KSWZ(r32, (d0 * 2 + hi) * 16);
        bf16x8 b0 = *reinterpret_cast<const bf16x8*>(a);
        bf16x8 b1 = *reinterpret_cast<const bf16x8*>(a + 32 * 128);
        p0 = __builtin_amdgcn_mfma_f32_32x32x16_bf16(b0, qr[d0], p0, 0, 0, 0);
        p1 = __builtin_amdgcn_mfma_f32_32x32x16_bf16(b1, qr[d0], p1, 0, 0, 0); }
}
template <int VB>
__device__ __forceinline__ void pv_tile(f32x16* o, int vb0, bf16x8 pa0, bf16x8 pa1, bf16x8 pa2, bf16x8 pa3) {
#define TRRD(dst, off) asm volatile("ds_read_b64_tr_b16 %0, %1 offset:%2" : "=&v"(dst) : "v"(vb0), "i"(off) : "memory")
#define PV_D0(d0) do { s16x4 l0, l1, l2, l3, h0, h1, h2, h3; constexpr int b_ = VB * SHM_V + v_rd_off(d0, 0, 0); \
        TRRD(l0, b_); TRRD(h0, b_ + 2048); TRRD(l1, b_ + 4096); TRRD(h1, b_ + 6144); TRRD(l2, b_ + 8192); TRRD(h2, b_ + 10240); TRRD(l3, b_ + 12288); TRRD(h3, b_ + 14336); \
        asm volatile("s_waitcnt lgkmcnt(0)" ::: "memory"); SBAR();   \
        o[d0] = __builtin_amdgcn_mfma_f32_32x32x16_bf16(pa0, (bf16x8){l0[0], l0[1], l0[2], l0[3], h0[0], h0[1], h0[2], h0[3]}, o[d0], 0, 0, 0);   \
        o[d0] = __builtin_amdgcn_mfma_f32_32x32x16_bf16(pa1, (bf16x8){l1[0], l1[1], l1[2], l1[3], h1[0], h1[1], h1[2], h1[3]}, o[d0], 0, 0, 0);   \
        o[d0] = __builtin_amdgcn_mfma_f32_32x32x16_bf16(pa2, (bf16x8){l2[0], l2[1], l2[2], l2[3], h2[0], h2[1], h2[2], h2[3]}, o[d0], 0, 0, 0);   \
        o[d0] = __builtin_amdgcn_mfma_f32_32x32x16_bf16(pa3, (bf16x8){l3[0], l3[1], l3[2], l3[3], h3[0], h3[1], h3[2], h3[3]}, o[d0], 0, 0, 0); } while (0)
    PV_D0(0); PV_D0(1); PV_D0(2); PV_D0(3);
#undef PV_D0
#undef TRRD
}
struct BlockRef { const bf16* Q; const bf16* K; const bf16* V; bf16* O; int P0; };
struct Seam { bf16x8 qr[4]; bf16x8 st_v0, st_v1, st_k0; };
#define VMW() asm volatile("s_waitcnt vmcnt(0)" ::: "memory")
#define VMWN(n) asm volatile("s_waitcnt vmcnt(%0)" :: "i"(n) : "memory")
#define SLOAD_H(Kp, Vp, k0) do { S.st_v0 = load8((Vp) + (size_t)((k0) + sr) * QP + sc); S.st_v1 = load8((Vp) + (size_t)((k0) + 32 + sr) * QP + sc);              \
                                 S.st_k0 = load8((Kp) + (size_t)((k0) + krow) * QP + kc); } while (0)
#define SWRITE_HK(bf) do { *(bf16x8*)(K_lds + (bf) * SHM_K + kws) = S.st_k0; } while (0)
#define SWRITE_HV(bf) do { *(bf16x8*)(V_lds + (bf) * SHM_V + vst0) = S.st_v0; *(bf16x8*)(V_lds + (bf) * SHM_V + vst1) = S.st_v1; } while (0)
#define SWRITE_H(bf) do { SWRITE_HV(bf); SWRITE_HK(bf); } while (0)
__device__ __forceinline__ void attn_prime(const BlockRef& cur, char* lds, Seam& S) {
    const int tid = threadIdx.x, wid = __builtin_amdgcn_readfirstlane(tid >> 6), lane = tid & 63, r32 = lane & 31, hi = lane >> 5;
    const int sr = tid >> 4, sc = (tid & 15) * 8, krow = tid >> 3, kc = (tid & 7) * 8, kws = KSWZ(krow, kc * 2); char* K_lds = lds + 2 * SHM_V;
#pragma unroll
    for (int d0 = 0; d0 < 4; ++d0) S.qr[d0] = load8(cur.Q + (size_t)(wid * QBLK + r32) * QP + d0 * 16 + hi * 8);
    SLOAD_H(cur.K, cur.V, 0); VMW(); SWRITE_HK(0);
    __syncthreads();
}
__device__ __forceinline__ void attn_block(const BlockRef& cur, const BlockRef& nxt, char* lds, Seam& S) {
    const int tid = threadIdx.x, wid = __builtin_amdgcn_readfirstlane(tid >> 6), lane = tid & 63, r32 = lane & 31, hi = lane >> 5;
    const int NT = (cur.P0 + QB - 1) / KVBLK + 1;
    const int qlo = cur.P0 + wid * QBLK, qm = qlo + r32 - 4 * hi;
    char* V_lds = lds; char* K_lds = lds + 2 * SHM_V;
    float* ws = (float*)(lds + 2 * SHM_V + 2 * SHM_K) + wid * 64; float* li_l = ws, * al_l = ws + 32;
    float m_reg = -1e30f, l_reg = 0; f32x16 o[4] = {};
    const int sr = tid >> 4, sc = (tid & 15) * 8, vst0 = v_st(sr, sc), vst1 = v_st(32 + sr, sc);
    const int krow = tid >> 3, kc = (tid & 7) * 8, kws = KSWZ(krow, kc * 2);
    const int vb0 = (int)(uintptr_t)V_lds + v_rd_base(lane);
    const bf16* Kh = cur.K; const bf16* Vh = cur.V;
#define RESC(a) do { if (__any((a) < 1.f)) { if (hi == 0) al_l[r32] = (a); asm volatile("s_waitcnt lgkmcnt(0)" ::: "memory");              \
                     for (int d_ = 0; d_ < 4; ++d_) for (int r = 0; r < 16; ++r) o[d_][r] *= al_l[crow(r, hi)]; } } while (0)
#define KBASE(t) ((t) * KVBLK)
#define MASKT(P0_, P1_, t) do { const int kb_ = KBASE(t); if (kb_ + KVBLK - 1 > qlo) mask_tile(P0_, P1_, qm - kb_); } while (0)
    constexpr int NQL = 4;
#define SEAM_K0() do { VMWN(NQL); SWRITE_HK(0); SBAR(); } while (0)
    f32x16 pA0, pA1, pB0, pB1; float mnA, mnB, alA, alB; bf16x8 pa0, pa1, pa2, pa3;
    SWRITE_HV(0); SBAR();
    SLOAD_H(Kh, Vh, KBASE(1));
    SBAR(); qkt<0>(pA0, pA1, K_lds, r32, hi, S.qr);
    MASKT(pA0, pA1, 0); partialSM(pA0, pA1, m_reg, mnA, alA);
    VMW(); SWRITE_H(1);
    __syncthreads();
#define HALF_STEP(PX0, PX1, mnX, alX, PY0, PY1, alY, t, KB, VB, SB) do {                                                      \
        SBAR(); qkt<KB>(PX0, PX1, K_lds, r32, hi, S.qr);                                             \
        finishSM(PY0, PY1, alY, l_reg, pa0, pa1, pa2, pa3); SBAR();                                                           \
        if ((t) + 1 < NT) { SLOAD_H(Kh, Vh, KBASE((t) + 1)); SBAR(); }                                               \
        pv_tile<VB>(o, vb0, pa0, pa1, pa2, pa3); MASKT(PX0, PX1, (t)); partialSM(PX0, PX1, m_reg, mnX, alX);                                        \
        __syncthreads();                                                                                                      \
        if ((t) + 1 < NT) { VMW(); SWRITE_H(SB); }                                                                          \
        RESC(alX); __syncthreads(); } while (0)
    for (int t = 1; t + 1 < NT; t += 2) {
        HALF_STEP(pB0, pB1, mnB, alB, pA0, pA1, alA, t, 1, 0, 0);
        HALF_STEP(pA0, pA1, mnA, alA, pB0, pB1, alB, t + 1, 0, 1, 1);
    }
    const bool even = (NT & 1) == 0;
    if (even) { SBAR(); qkt<1>(pB0, pB1, K_lds, r32, hi, S.qr); SBAR(); }
    SLOAD_H(nxt.K, nxt.V, 0); SBAR();
#pragma unroll
    for (int d0 = 0; d0 < 4; ++d0) S.qr[d0] = load8(nxt.Q + (size_t)(wid * QBLK + r32) * QP + d0 * 16 + hi * 8);
    SBAR();
    finishSM(pA0, pA1, alA, l_reg, pa0, pa1, pa2, pa3); SBAR();
    pv_tile<0>(o, vb0, pa0, pa1, pa2, pa3);
    if (even) { MASKT(pB0, pB1, NT - 1); partialSM(pB0, pB1, m_reg, mnB, alB); __syncthreads(); RESC(alB);
        finishSM(pB0, pB1, alB, l_reg, pa0, pa1, pa2, pa3); SBAR(); pv_tile<1>(o, vb0, pa0, pa1, pa2, pa3); }
    SBAR(); SEAM_K0();
    if (hi == 0) li_l[r32] = l_reg; asm volatile("s_waitcnt lgkmcnt(0)" ::: "memory");
    float rli[16];
#pragma unroll
    for (int r = 0; r < 16; ++r) rli[r] = __builtin_amdgcn_rcpf(li_l[crow(r, hi)]);
    bf16* Ow = cur.O + (size_t)(wid * QBLK) * OP;
#pragma unroll
    for (int r = 0; r < 16; ++r) { const int orow = crow(r, hi);
#pragma unroll
        for (int d0 = 0; d0 < 4; ++d0) { const float v = o[d0][r] * rli[r];
            const float vn = __shfl_xor(v, 1);
            if ((r32 & 1) == 0) *(unsigned*)(Ow + (size_t)orow * OP + d0 * 32 + r32) = cvtpk(v, vn); } }
    __syncthreads();
#undef RESC
#undef KBASE
#undef MASKT
#undef SEAM_K0
#undef HALF_STEP
}
#undef VMW
#undef VMWN
#undef SLOAD_H
#undef SWRITE_HK
#undef SWRITE_HV
#undef SWRITE_H
#undef KSWZ
__device__ __forceinline__ BlockRef make_ref(int L, int pass, const bf16* Q, const bf16* K, const bf16* V, bf16* O) {
    const int bh = L >> 3, x = L & 7, qb = pass ? 15 - x : x, b = bh >> 5, map = bh & 31;
    const size_t seq0 = (size_t)b * SEQ, row0 = seq0 + (size_t)qb * QB;
    BlockRef r; r.Q = Q + row0 * QP + map * 64; r.K = K + seq0 * QP + map * 64; r.V = V + seq0 * QP + (map >> 1) * 128; r.O = O + row0 * OP + map * 128; r.P0 = qb * QB; return r;
}
__device__ __forceinline__ void attn_phase(char* lds, const bf16* Q, const bf16* K, const bf16* V, bf16* O, int first, int stride) {
    constexpr int total = NB * 32 * 8;
    int L = first; if (L >= total) return;
    int pass = 0;
    BlockRef cur = make_ref(L, 0, Q, K, V, O);
    Seam S;
    attn_prime(cur, lds, S);
    for (;;) {
        const bool more_pass = pass == 0, more_item = L + stride < total, last = !more_pass && !more_item;
        int passn = pass + 1, Ln = L;
        if (!more_pass) { passn = 0; Ln = more_item ? L + stride : L; }
        const BlockRef nxt = last ? cur : make_ref(Ln, passn, Q, K, V, O);
        attn_block(cur, nxt, lds, S);
        if (last) break;
        cur = nxt; pass = passn; L = Ln;
    }
}
}
struct Args { const float* in[29]; float* out; unsigned char* ws; int ph_lo, ph_hi; };
enum { I_X = 0, I_C, I_WADA, I_BADA, I_GPREMIX, I_GPOSTMIX, I_GPREFFN, I_GPOSTFFN, I_WIN, I_CONVW, I_CONVB, I_DTBIAS, I_ALOG, I_DSKIP, I_SSDNW,
       I_LQ1, I_LK1, I_LQ2, I_LK2, I_SUBLN, I_WBS, I_WBA, I_WOUT, I_WR, I_BR, I_WGU, I_BGU, I_WDN, I_BDN };
#define WSP(T, off) ((T*)(a.ws + (off) * MiB))

__device__ __forceinline__ void ph_mod(const Args& a, LAS unsigned char* lds) {
    LAS float* sc = (LAS float*)lds;
    LAS float* part = (LAS float*)(lds + 32768);
    const int tid = threadIdx.x; const float* c = a.in[I_C]; const float* W = a.in[I_WADA]; const float* bada = a.in[I_BADA]; float* mod = WSP(float, WS_MOD);
    for (int i = tid; i < NB * DM; i += NTHR) sc[i] = siluf_(c[i]);
    __syncthreads();
    for (int cb = blockIdx.x; cb < 256; cb += gridDim.x) {
        const int ks = tid / 12, quad = tid % 12;
        f32x4 acc[4] = {{0.f, 0.f, 0.f, 0.f}, {0.f, 0.f, 0.f, 0.f}, {0.f, 0.f, 0.f, 0.f}, {0.f, 0.f, 0.f, 0.f}};
        if (ks < 42) {
#pragma unroll 4
            for (int k = ks; k < DM; k += 42) { const f32x4 w = *(const f32x4*)(W + (size_t)k * 12288 + cb * 48 + quad * 4);
#pragma unroll
                for (int b = 0; b < 4; ++b) acc[b] += w * sc[b * DM + k]; }
#pragma unroll
            for (int b = 0; b < 4; ++b) *(LAS f32x4*)(part + (ks * 12 + quad) * 16 + b * 4) = acc[b];
        }
        __syncthreads();
        if (tid < 192) { const int col = tid % 48, b = tid / 48; float s = 0.f;
            for (int k2 = 0; k2 < 42; ++k2) s += part[(k2 * 12 + (col >> 2)) * 16 + b * 4 + (col & 3)];
            mod[b * 12288 + cb * 48 + col] = s + bada[cb * 48 + col]; }
        __syncthreads();
    }
}

__device__ __forceinline__ void tr_item(const float* W, int K, int N, bf16* WT, int k0, int d0  , int kind, LAS float* scr, int lane) {
    const int j = lane & 31;
    int scol; bool zero = false;
    if (kind == 0) scol = d0 + j;
    else if (kind == 1) {
        const int r = d0 + j;
        if (r < 5120) scol = r; else if (r < 15360) scol = r + 32; else if (r < 15392) scol = 5120 + (r - 15360); else { scol = 0; zero = true; }
    } else {
        const int a16 = (d0 >> 5) * 16; scol = (j < 16) ? a16 + j : 2048 + a16 + (j - 16);
    }
#pragma unroll 8
    for (int i = 0; i < 32; ++i) { const int kk = 2 * i + (lane >> 5); scr[kk * 33 + j] = zero ? 0.f : W[(size_t)(k0 + kk) * N + scol]; }
    LDS_WAIT(); asm volatile("" ::: "memory");
    const int c = lane & 7;
#pragma unroll
    for (int q = 0; q < 4; ++q) { const int n = (lane >> 3) + 8 * q;
        const int lc = (kind == 2) ? (((n & 7) < 4) ? 4 * (n >> 3) + (n & 3) : 16 + 4 * (n >> 3) + (n & 3)) : n;
        const LAS float* s = scr + (8 * c) * 33 + lc;
        u32x4 o; o.x = pk2(s[0 * 33], s[1 * 33]); o.y = pk2(s[2 * 33], s[3 * 33]); o.z = pk2(s[4 * 33], s[5 * 33]); o.w = pk2(s[6 * 33], s[7 * 33]);
        *(u32x4*)(WT + (size_t)(d0 + n) * K + k0 + 8 * c) = o; }
    LDS_WAIT(); asm volatile("" ::: "memory");
}
__device__ __forceinline__ void sincos_acc(float angf, float& s_out, float& c_out) {
    const double ang = (double)angf; const double twopi = 6.283185307179586476925, inv2pi = 0.159154943091895335769;
    double q = ang * inv2pi; q = q - (double)(long long)(q + 0.5);
    const double r = q * twopi * 0.25, r2 = r * r;
    double s = r * (1.0 + r2 * (-1.0 / 6 + r2 * (1.0 / 120 + r2 * (-1.0 / 5040 + r2 * (1.0 / 362880 + r2 * (-1.0 / 39916800 + r2 * (1.0 / 6227020800.0)))))));
    double c = 1.0 + r2 * (-0.5 + r2 * (1.0 / 24 + r2 * (-1.0 / 720 + r2 * (1.0 / 40320 + r2 * (-1.0 / 3628800 + r2 * (1.0 / 479001600.0))))));
    double s2 = 2 * s * c, c2 = c * c - s * s; s = 2 * s2 * c2; c = c2 * c2 - s2 * s2;
    s_out = (float)s; c_out = (float)c;
}
__device__ __forceinline__ void rms_row_to_bf16(const float* xrow, const float* g, const float* scv, const float* shv, bf16* orow, int lane, float eps) {
    f32x4 v[8]; float s = 0.f;
#pragma unroll
    for (int j = 0; j < 8; ++j) { v[j] = *((const f32x4*)xrow + lane + 64 * j); s += (v[j].x * v[j].x + v[j].y * v[j].y) + (v[j].z * v[j].z + v[j].w * v[j].w); }
    const float rstd = 1.0f / sqrtf(wave_sum(s) * (1.0f / DM) + eps);
#pragma unroll
    for (int j = 0; j < 8; ++j) { const int o4 = lane + 64 * j; const f32x4 gg = *((const f32x4*)g + o4), s1 = *((const f32x4*)scv + o4), s0 = *((const f32x4*)shv + o4);
        const f32x4 y = v[j] * rstd * gg * (s1 + 1.0f) + s0;
        u32x2 w; w.x = pk2(y.x, y.y); w.y = pk2(y.z, y.w); *((u32x2*)orow + o4) = w; }
}
__device__ __forceinline__ void ph_prep(const Args& a, LAS unsigned char* lds, int vcu, int G) {
    const int tid = threadIdx.x, lane = tid & 63, wave = __builtin_amdgcn_readfirstlane(tid >> 6);
    const int gw = vcu * NWAVES + wave, NGW = G * NWAVES, gt = vcu * NTHR + tid, NGT = G * NTHR;
    const float* mod = WSP(float, WS_MOD);
    { float* rope = WSP(float, WS_ROPE);
      const float invf[8] = {1.0f, 0.19392274f, 0.03760603f, 0.0072926646f, 0.0014142136f, 0.0002742482f, 5.3182957e-05f, 1.0313385e-05f};
      for (int i = gt; i < SEQ * 8; i += NGT) { const int pos = i >> 3, j = i & 7; float fr_ = 1.0f;
#pragma unroll
          for (int q = 0; q < 8; ++q) fr_ = (j == q) ? invf[q] : fr_;
          const float ang = (float)pos * fr_; float s, c; sincos_acc(ang, s, c); rope[pos * 16 + j] = c; rope[pos * 16 + 8 + j] = s; } }
    { float* wr = WSP(float, WS_WR); const float* Wr = a.in[I_WR]; const float* g = a.in[I_GPREFFN];
      for (int i = gt; i < NB * DM * NE; i += NGT) { const int b = i / (DM * NE), r = i % (DM * NE), k = r / NE; wr[i] = g[k] * (1.0f + mod[b * 12288 + 8192 + k]) * Wr[r]; }
      if (vcu == 0 && tid < NB * NE) { const int b = tid / NE, e = tid % NE; float s = 0.f; for (int k = 0; k < DM; ++k) s += mod[b * 12288 + 6144 + k] * Wr[k * NE + e];
          ((float*)(a.ws + WS_MOD * MiB + MOD_CB))[tid] = s + a.in[I_BR][e]; } }
    { const float* x = a.in[I_X]; bf16* H = WSP(bf16, WS_H); const float* g = a.in[I_GPREMIX];
      for (int m = gw; m < MT; m += NGW) { const int b = m / SEQ; rms_row_to_bf16(x + (size_t)m * DM, g, mod + b * 12288 + 2048, mod + b * 12288, H + (size_t)m * DM, lane, 1e-6f); } }
    { LAS float* scr = (LAS float*)(lds + wave * 16384);
      constexpr int I_IN = (DM / 64) * (NPROJ / 32), I_SQ = (DM / 64) * (DM / 32), I_GU = (DM / 64) * (4096 / 32), I_DN = I_SQ;
      constexpr int NITEMS = I_IN + 3 * I_SQ + NE * I_GU + NE * I_DN;
      for (int it = gw; it < NITEMS; it += NGW) { int r = it;
          if (r < I_IN) { const int nblk = NPROJ / 32; tr_item(a.in[I_WIN], DM, 15392, WSP(bf16, WS_WT_IN), 64 * (r / nblk), 32 * (r % nblk), 1, scr, lane); continue; } r -= I_IN;
          if (r < I_SQ) { tr_item(a.in[I_WBS], DM, DM, WSP(bf16, WS_WT_BS), 64 * (r / 64), 32 * (r % 64), 0, scr, lane); continue; } r -= I_SQ;
          if (r < I_SQ) { tr_item(a.in[I_WBA], DM, DM, WSP(bf16, WS_WT_BA), 64 * (r / 64), 32 * (r % 64), 0, scr, lane); continue; } r -= I_SQ;
          if (r < I_SQ) { tr_item(a.in[I_WOUT], DM, DM, WSP(bf16, WS_WT_OUT), 64 * (r / 64), 32 * (r % 64), 0, scr, lane); continue; } r -= I_SQ;
          if (r < NE * I_GU) { const int e = r / I_GU, q = r % I_GU; tr_item(a.in[I_WGU] + (size_t)e * DM * 4096, DM, 4096, WSP(bf16, WS_WT_GU) + (size_t)e * 4096 * DM, 64 * (q / 128), 32 * (q % 128), 2, scr, lane); continue; } r -= NE * I_GU;
          { const int e = r / I_DN, q = r % I_DN; tr_item(a.in[I_WDN] + (size_t)e * DM * DM, DM, DM, WSP(bf16, WS_WT_DN) + (size_t)e * DM * DM, 64 * (q / 64), 32 * (q % 64), 0, scr, lane); } } }
}

__device__ __forceinline__ void ph_conv(const Args& a, int vcu, int G) {
    const int gt = vcu * NTHR + threadIdx.x, NGT = G * NTHR;
    { const bf16* X = WSP(bf16, WS_XBC); bf16* Y = WSP(bf16, WS_XBCC); const float* cw = a.in[I_CONVW]; const float* cbias = a.in[I_CONVB];
      for (int it = gt; it < (XBCW / 8) * (MT / 64); it += NGT) { const int cg = it % (XBCW / 8), seg = it / (XBCW / 8), c0 = cg * 8, t0 = seg * 64;
          float w[4][8], bb[8];
#pragma unroll
          for (int k = 0; k < 4; ++k) { const f32x4 w0 = *(const f32x4*)(cw + k * XBCW + c0), w1 = *(const f32x4*)(cw + k * XBCW + c0 + 4);
#pragma unroll
              for (int q = 0; q < 4; ++q) { w[k][q] = w0[q]; w[k][4 + q] = w1[q]; } }
          { const f32x4 b0 = *(const f32x4*)(cbias + c0), b1 = *(const f32x4*)(cbias + c0 + 4);
#pragma unroll
            for (int q = 0; q < 4; ++q) { bb[q] = b0[q]; bb[4 + q] = b1[q]; } }
          float hs[3][8];
          const bool seqstart = (t0 % SEQ) == 0;
#pragma unroll
          for (int r = 0; r < 3; ++r) { u32x4 v = {0u, 0u, 0u, 0u}; if (!seqstart) v = *(const u32x4*)(X + (size_t)(t0 - 3 + r) * XBCW + c0);
              hs[r][0] = bflo(v.x); hs[r][1] = bfhi(v.x); hs[r][2] = bflo(v.y); hs[r][3] = bfhi(v.y); hs[r][4] = bflo(v.z); hs[r][5] = bfhi(v.z); hs[r][6] = bflo(v.w); hs[r][7] = bfhi(v.w); }
#pragma unroll 4
          for (int t = 0; t < 64; ++t) { const u32x4 v = *(const u32x4*)(X + (size_t)(t0 + t) * XBCW + c0);
              float xc[8] = {bflo(v.x), bfhi(v.x), bflo(v.y), bfhi(v.y), bflo(v.z), bfhi(v.z), bflo(v.w), bfhi(v.w)}; float y[8];
#pragma unroll
              for (int q = 0; q < 8; ++q) { const float s = bb[q] + w[0][q] * hs[0][q] + w[1][q] * hs[1][q] + w[2][q] * hs[2][q] + w[3][q] * xc[q]; y[q] = siluf_(s); hs[0][q] = hs[1][q]; hs[1][q] = hs[2][q]; hs[2][q] = xc[q]; }
              u32x4 o; o.x = pk2(y[0], y[1]); o.y = pk2(y[2], y[3]); o.z = pk2(y[4], y[5]); o.w = pk2(y[6], y[7]);
              *(u32x4*)(Y + (size_t)(t0 + t) * XBCW + c0) = o; } } }
    { const float* dr = WSP(float, WS_DTRAW); float* dt = WSP(float, WS_DT); const float* bias = a.in[I_DTBIAS];
      for (int i = gt; i < MT * 32; i += NGT) { const float x = dr[i] + bias[i & 31]; dt[i] = (x > 20.f) ? x : log1pf(__expf(x)); } }
    { const float* rope = WSP(float, WS_ROPE);
      for (int it = gt; it < MT * 32 * 2; it += NGT) { const int which = it / (MT * 32), r = it % (MT * 32), t = r >> 5, hd = r & 31; bf16* p = (which ? WSP(bf16, WS_K) : WSP(bf16, WS_Q)) + (size_t)t * DM + hd * 64;
          const u32x4 v1 = *(const u32x4*)p, v2 = *(const u32x4*)(p + 8); const float* rp = rope + (t % SEQ) * 16;
          const f32x4 c0 = *(const f32x4*)rp, c1 = *(const f32x4*)(rp + 4), s0 = *(const f32x4*)(rp + 8), s1 = *(const f32x4*)(rp + 12);
          const float x1[8] = {bflo(v1.x), bfhi(v1.x), bflo(v1.y), bfhi(v1.y), bflo(v1.z), bfhi(v1.z), bflo(v1.w), bfhi(v1.w)};
          const float x2[8] = {bflo(v2.x), bfhi(v2.x), bflo(v2.y), bfhi(v2.y), bflo(v2.z), bfhi(v2.z), bflo(v2.w), bfhi(v2.w)};
          const float cc[8] = {c0[0], c0[1], c0[2], c0[3], c1[0], c1[1], c1[2], c1[3]}, ss[8] = {s0[0], s0[1], s0[2], s0[3], s1[0], s1[1], s1[2], s1[3]};
          float y1[8], y2[8];
#pragma unroll
          for (int q = 0; q < 8; ++q) { y1[q] = x1[q] * cc[q] - x2[q] * ss[q]; y2[q] = x2[q] * cc[q] + x1[q] * ss[q]; }
          u32x4 o1, o2; o1.x = pk2(y1[0], y1[1]); o1.y = pk2(y1[2], y1[3]); o1.z = pk2(y1[4], y1[5]); o1.w = pk2(y1[6], y1[7]);
          o2.x = pk2(y2[0], y2[1]); o2.y = pk2(y2[2], y2[3]); o2.z = pk2(y2[4], y2[5]); o2.w = pk2(y2[6], y2[7]);
          *(u32x4*)p = o1; *(u32x4*)(p + 8) = o2; } }
}
constexpr int SP = 136;
#define SSD_FRAG(base, row, k0) (*(const LAS bf16x8*)((base) + (row) * SP + (k0)))
template <bool ALSO_T> __device__ __forceinline__ void ssd_stage128(const bf16* X, int t0, int col0, LAS bf16* dst, LAS bf16* dstT, int tid) {
#pragma unroll
    for (int i = 0; i < 4; ++i) { const int q = tid + NTHR * i, row = q >> 4, ch = q & 15;
        const u32x4 v = *(const u32x4*)(X + (size_t)(t0 + row) * XBCW + col0 + ch * 8);
        *(LAS u32x4*)(dst + row * SP + ch * 8) = v;
        if constexpr (ALSO_T) { const unsigned w[4] = {v.x, v.y, v.z, v.w};
#pragma unroll
            for (int j = 0; j < 4; ++j) { dstT[(ch * 8 + 2 * j) * SP + row] = (bf16)(w[j] & 0xffffu); dstT[(ch * 8 + 2 * j + 1) * SP + row] = (bf16)(w[j] >> 16); } } }
}
__device__ __forceinline__ void ph_ssd1(const Args& a, LAS unsigned char* lds, int first, int stride) {
    const int tid = threadIdx.x, lane = tid & 63, w = __builtin_amdgcn_readfirstlane(tid >> 6), l15 = lane & 15, lq = lane >> 4;
    LAS bf16* R1 = (LAS bf16*)lds;
    LAS bf16* R2 = (LAS bf16*)(lds + 34816);
    LAS bf16* R3 = (LAS bf16*)(lds + 69632);
    LAS float* acs = (LAS float*)(lds + 104448);
    LAS float* dts = (LAS float*)(lds + 108544);
    const bf16* X = WSP(bf16, WS_XBCC); const float* DT = WSP(float, WS_DT); float* ACS = WSP(float, WS_ACS); float* YD = WSP(float, WS_YDIAG); float* ST = WSP(float, WS_STATES);
    for (int u = first; u < NB * 32 * 4; u += stride) {
        const int g = u & 3, bc = u >> 2, t0 = bc * 128;
        ssd_stage128<false>(X, t0, 2560 + g * 128, R1, nullptr, tid);
        ssd_stage128<true>(X, t0, 2048 + g * 128, R2, R3, tid);
        { const int h = g * 8 + w; const float Ah = -__expf(a.in[I_ALOG][h]);
          const float d0 = DT[(size_t)(t0 + 2 * lane) * 32 + h], d1 = DT[(size_t)(t0 + 2 * lane + 1) * 32 + h];
          const float a0 = d0 * Ah, a1 = d1 * Ah; float s = a0 + a1;
#pragma unroll
          for (int o = 1; o < 64; o <<= 1) { const float t = __shfl_up(s, o); if (lane >= o) s += t; }
          acs[w * 128 + 2 * lane] = s - a1; acs[w * 128 + 2 * lane + 1] = s; dts[w * 128 + 2 * lane] = d0; dts[w * 128 + 2 * lane + 1] = d1;
          float* ag = ACS + ((size_t)bc * 32 + h) * 128; ag[2 * lane] = s - a1; ag[2 * lane + 1] = s; }
        __syncthreads();
        f32x4 S[8];
#pragma unroll
        for (int mt = 0; mt < 8; ++mt) { S[mt] = (f32x4){0.f, 0.f, 0.f, 0.f};
#pragma unroll
            for (int ks = 0; ks < 4; ++ks) S[mt] = __builtin_amdgcn_mfma_f32_16x16x32_bf16(SSD_FRAG(R2, 16 * mt + l15, 32 * ks + 8 * lq), SSD_FRAG(R1, 16 * w + l15, 32 * ks + 8 * lq), S[mt], 0, 0, 0); }
        __syncthreads();
        LAS bf16* G = R1; LAS bf16* Xt = R2; LAS bf16* Xwt = R2 + 64 * SP;
#pragma unroll 1
        for (int hh = 0; hh < 8; ++hh) {
            const int h = g * 8 + hh; const LAS float* ac = acs + hh * 128; const float aend = ac[127];
#pragma unroll
            for (int i = 0; i < 2; ++i) { const int q = tid + NTHR * i, l = q >> 3, ch = q & 7;
                const u32x4 v = *(const u32x4*)(X + (size_t)(t0 + l) * XBCW + h * 64 + ch * 8); const float dl = dts[hh * 128 + l], wl = dl * __expf(aend - ac[l]);
                const float xv[8] = {bflo(v.x), bfhi(v.x), bflo(v.y), bfhi(v.y), bflo(v.z), bfhi(v.z), bflo(v.w), bfhi(v.w)};
#pragma unroll
                for (int j = 0; j < 8; ++j) { Xt[(ch * 8 + j) * SP + l] = (bf16)f2bf(xv[j] * dl); Xwt[(ch * 8 + j) * SP + l] = (bf16)f2bf(xv[j] * wl); } }
            { const int l = 16 * w + l15; const float al = ac[l];
#pragma unroll
              for (int mt = 0; mt < 8; ++mt) { float gv[4];
#pragma unroll
                  for (int r = 0; r < 4; ++r) { const int s = 16 * mt + 4 * lq + r; gv[r] = (s <= l) ? S[mt][r] * __expf(al - ac[s]) : 0.f; }
                  u32x2 pk; pk.x = pk2(gv[0], gv[1]); pk.y = pk2(gv[2], gv[3]);
                  *(LAS u32x2*)(G + l * SP + 16 * mt + 4 * lq) = pk; } }
            __syncthreads();
#pragma unroll
            for (int pt = 0; pt < 4; ++pt) { f32x4 acc = {0.f, 0.f, 0.f, 0.f};
#pragma unroll
                for (int ks = 0; ks < 4; ++ks) acc = __builtin_amdgcn_mfma_f32_16x16x32_bf16(SSD_FRAG(Xt, 16 * pt + l15, 32 * ks + 8 * lq), SSD_FRAG(G, 16 * w + l15, 32 * ks + 8 * lq), acc, 0, 0, 0);
                *(f32x4*)(YD + (size_t)(t0 + 16 * w + l15) * DM + h * 64 + 16 * pt + 4 * lq) = acc; }
#pragma unroll
            for (int pt = 0; pt < 4; ++pt) { f32x4 acc = {0.f, 0.f, 0.f, 0.f};
#pragma unroll
                for (int ks = 0; ks < 4; ++ks) acc = __builtin_amdgcn_mfma_f32_16x16x32_bf16(SSD_FRAG(R3, 16 * w + l15, 32 * ks + 8 * lq), SSD_FRAG(Xwt, 16 * pt + l15, 32 * ks + 8 * lq), acc, 0, 0, 0);
                *(f32x4*)(ST + (((size_t)bc * 32 + h) * 64 + 16 * pt + l15) * 128 + 16 * w + 4 * lq) = acc; }
            __syncthreads();
        }
    }
}
__device__ __forceinline__ void ph_ssd2(const Args& a, int vcu, int G) {
    const int gt = vcu * NTHR + threadIdx.x, NGT = G * NTHR; float* ST = WSP(float, WS_STATES); const float* ACS = WSP(float, WS_ACS);
    for (int it = gt; it < NB * 32 * 2048; it += NGT) { const int q = it & 2047, bh = it >> 11, b = bh >> 5, h = bh & 31;
        f32x4 run = {0.f, 0.f, 0.f, 0.f};
#pragma unroll 4
        for (int c = 0; c < 32; ++c) { const size_t bc = (size_t)b * 32 + c; f32x4* p = (f32x4*)(ST + (bc * 32 + h) * 8192) + q; const f32x4 s = *p; const float dec = __expf(ACS[(bc * 32 + h) * 128 + 127]);
            *p = run; run = run * dec + s; } }
}
__device__ __forceinline__ void ph_ssd3(const Args& a, LAS unsigned char* lds, int first, int stride) {
    const int tid = threadIdx.x, lane = tid & 63, w = __builtin_amdgcn_readfirstlane(tid >> 6), l15 = lane & 15, lq = lane >> 4;
    LAS bf16* Cs = (LAS bf16*)lds; LAS bf16* Pv = (LAS bf16*)(lds + 34816); LAS float* acs = (LAS float*)(lds + 104448);
    const bf16* X = WSP(bf16, WS_XBCC); const float* ACS = WSP(float, WS_ACS); const float* YD = WSP(float, WS_YDIAG); const float* ST = WSP(float, WS_STATES);
    const bf16* Z = WSP(bf16, WS_Z); bf16* YB = WSP(bf16, WS_YBUF); const float* dskip = a.in[I_DSKIP]; const float* nw = a.in[I_SSDNW];
    for (int u = first; u < NB * 32 * 4; u += stride) {
        const int g = u & 3, bc = u >> 2, t0 = bc * 128;
        ssd_stage128<false>(X, t0, 2560 + g * 128, Cs, nullptr, tid);
#pragma unroll
        for (int i = 0; i < 2; ++i) { const int q = tid + NTHR * i; acs[q] = ACS[((size_t)bc * 32 + g * 8 + (q >> 7)) * 128 + (q & 127)]; }
        __syncthreads();
        const int l = 16 * w + l15; const size_t t = (size_t)t0 + l; float ss = 0.f;
#pragma unroll 1
        for (int hh = 0; hh < 8; ++hh) {
            const int h = g * 8 + hh;
#pragma unroll
            for (int i = 0; i < 4; ++i) { const int q = tid + NTHR * i, p = q >> 5, n4 = (q & 31) * 4;
                const f32x4 v = *(const f32x4*)(ST + ((size_t)bc * 32 + h) * 8192 + p * 128 + n4); u32x2 pk; pk.x = pk2(v[0], v[1]); pk.y = pk2(v[2], v[3]);
                *(LAS u32x2*)(Pv + p * SP + n4) = pk; }
            __syncthreads();
            const float ea = __expf(acs[hh * 128 + l]), dsk = dskip[h];
#pragma unroll
            for (int pt = 0; pt < 4; ++pt) { f32x4 acc = {0.f, 0.f, 0.f, 0.f};
#pragma unroll
                for (int ks = 0; ks < 4; ++ks) acc = __builtin_amdgcn_mfma_f32_16x16x32_bf16(SSD_FRAG(Pv, 16 * pt + l15, 32 * ks + 8 * lq), SSD_FRAG(Cs, 16 * w + l15, 32 * ks + 8 * lq), acc, 0, 0, 0);
                const int col = h * 64 + 16 * pt + 4 * lq;
                const f32x4 yd = *(const f32x4*)(YD + t * DM + col); const u32x2 xs = *(const u32x2*)(X + t * XBCW + col), zz = *(const u32x2*)(Z + t * DM + col);
                const float xv[4] = {bflo(xs.x), bfhi(xs.x), bflo(xs.y), bfhi(xs.y)}, zv[4] = {bflo(zz.x), bfhi(zz.x), bflo(zz.y), bfhi(zz.y)}; float uu[4];
#pragma unroll
                for (int r = 0; r < 4; ++r) { const float y = yd[r] + ea * acc[r] + dsk * xv[r]; uu[r] = y * siluf_(zv[r]); ss += uu[r] * uu[r]; }
                u32x2 pk; pk.x = pk2(uu[0], uu[1]); pk.y = pk2(uu[2], uu[3]); *(u32x2*)(YB + t * DM + col) = pk; }
            __syncthreads();
        }
        ss += __shfl_xor(ss, 16); ss += __shfl_xor(ss, 32);
        const float rstd = 1.0f / sqrtf(ss * (1.0f / 512.0f) + 1e-5f);
        VM_WAIT();
#pragma unroll 1
        for (int hh = 0; hh < 8; ++hh)
#pragma unroll
            for (int pt = 0; pt < 4; ++pt) { const int col = (g * 8 + hh) * 64 + 16 * pt + 4 * lq; u32x2* p = (u32x2*)(YB + t * DM + col); const u32x2 v = *p; const f32x4 wv = *(const f32x4*)(nw + col);
                u32x2 pk; pk.x = pk2(bflo(v.x) * rstd * wv[0], bfhi(v.x) * rstd * wv[1]); pk.y = pk2(bflo(v.y) * rstd * wv[2], bfhi(v.y) * rstd * wv[3]); *p = pk; }
        __syncthreads();
    }
}
__device__ __forceinline__ void ph_attn_combine(const Args& a, int vcu, int G) {
    const int tid = threadIdx.x, lane = tid & 63, wave = __builtin_amdgcn_readfirstlane(tid >> 6), gw = vcu * NWAVES + wave, NGW = G * NWAVES;
    float d1 = a.in[I_LQ1][lane] * a.in[I_LK1][lane], d2 = a.in[I_LQ2][lane] * a.in[I_LK2][lane]; d1 = wave_sum(d1); d2 = wave_sum(d2);
    const float lam = __expf(d1) - __expf(d2) + 0.2f;
    const bf16* OA = WSP(bf16, WS_OATT); bf16* OF = WSP(bf16, WS_OFIN); const float* sw = a.in[I_SUBLN];
    const int head = lane >> 2, dq = (lane & 3) * 32;
    for (int m = gw; m < MT; m += NGW) { const bf16* p0 = OA + (size_t)m * 4096 + (2 * head) * 128 + dq; const bf16* p1 = p0 + 128; float d[32]; float ss = 0.f;
#pragma unroll
        for (int i = 0; i < 4; ++i) { const u32x4 x = *(const u32x4*)(p0 + 8 * i), y = *(const u32x4*)(p1 + 8 * i);
            const unsigned xa[4] = {x.x, x.y, x.z, x.w}, ya[4] = {y.x, y.y, y.z, y.w};
#pragma unroll
            for (int j = 0; j < 4; ++j) { const float v0 = bflo(xa[j]) - lam * bflo(ya[j]), v1 = bfhi(xa[j]) - lam * bfhi(ya[j]); d[8 * i + 2 * j] = v0; d[8 * i + 2 * j + 1] = v1; ss += v0 * v0 + v1 * v1; } }
        ss += __shfl_xor(ss, 1); ss += __shfl_xor(ss, 2);
        const float rstd = 0.8f / sqrtf(ss * (1.0f / 128.0f) + 1e-5f);
        bf16* o = OF + (size_t)m * DM + head * 128 + dq;
#pragma unroll
        for (int i = 0; i < 4; ++i) { const f32x4 w0 = *(const f32x4*)(sw + dq + 8 * i), w1 = *(const f32x4*)(sw + dq + 8 * i + 4);
            u32x4 pk; pk.x = pk2(d[8 * i] * rstd * w0[0], d[8 * i + 1] * rstd * w0[1]); pk.y = pk2(d[8 * i + 2] * rstd * w0[2], d[8 * i + 3] * rstd * w0[3]);
            pk.z = pk2(d[8 * i + 4] * rstd * w1[0], d[8 * i + 5] * rstd * w1[1]); pk.w = pk2(d[8 * i + 6] * rstd * w1[2], d[8 * i + 7] * rstd * w1[3]);
            *(u32x4*)(o + 8 * i) = pk; } }
}
__device__ __forceinline__ void ph_rows1(const Args& a, int vcu, int G) {
    const int tid = threadIdx.x, lane = tid & 63, wave = __builtin_amdgcn_readfirstlane(tid >> 6), gw = vcu * NWAVES + wave, NGW = G * NWAVES;
    const float* mod = WSP(float, WS_MOD); const float* x = a.in[I_X]; const float* mix = WSP(float, WS_MIX); float* X1 = WSP(float, WS_X1); bf16* H2 = WSP(bf16, WS_H2); float* RS = WSP(float, WS_RSTD);
    const float* gpm = a.in[I_GPOSTMIX]; const float* gpf = a.in[I_GPREFFN];
    for (int m = gw; m < MT; m += NGW) { const int b = m / SEQ; const float* mb = mod + b * 12288;
        f32x4 v[8]; float s = 0.f;
#pragma unroll
        for (int j = 0; j < 8; ++j) { v[j] = *((const f32x4*)(mix + (size_t)m * DM) + lane + 64 * j); s += (v[j].x * v[j].x + v[j].y * v[j].y) + (v[j].z * v[j].z + v[j].w * v[j].w); }
        const float rstdm = 1.0f / sqrtf(wave_sum(s) * (1.0f / DM) + 1e-6f); float s1 = 0.f;
#pragma unroll
        for (int j = 0; j < 8; ++j) { const int o4 = lane + 64 * j; const f32x4 xx = *((const f32x4*)(x + (size_t)m * DM) + o4), gg = *((const f32x4*)gpm + o4), gt = *((const f32x4*)(mb + 4096) + o4);
            v[j] = xx + gt * (v[j] * rstdm * gg); *((f32x4*)(X1 + (size_t)m * DM) + o4) = v[j]; s1 += (v[j].x * v[j].x + v[j].y * v[j].y) + (v[j].z * v[j].z + v[j].w * v[j].w); }
        const float rstd1 = 1.0f / sqrtf(wave_sum(s1) * (1.0f / DM) + 1e-6f);
        if (lane == 0) RS[m] = rstd1;
#pragma unroll
        for (int j = 0; j < 8; ++j) { const int o4 = lane + 64 * j; const f32x4 gg = *((const f32x4*)gpf + o4), sc = *((const f32x4*)(mb + 8192) + o4), sh = *((const f32x4*)(mb + 6144) + o4);
            const f32x4 y = v[j] * rstd1 * gg * (sc + 1.0f) + sh; u32x2 pk; pk.x = pk2(y.x, y.y); pk.y = pk2(y.z, y.w); *((u32x2*)(H2 + (size_t)m * DM) + o4) = pk; } }
}
__device__ __forceinline__ void ph_router(const Args& a, LAS unsigned char* lds, int first, int stride) {
    const int tid = threadIdx.x, lane = tid & 63, w = __builtin_amdgcn_readfirstlane(tid >> 6), r32 = lane & 31, hi = lane >> 5;
    LAS float* part = (LAS float*)lds;
    LAS float* lg = (LAS float*)(lds + 8 * 32 * 33 * 4);
    const float* X1 = WSP(float, WS_X1); const float* WR = WSP(float, WS_WR); const float* RS = WSP(float, WS_RSTD); const float* CB = (const float*)(a.ws + WS_MOD * MiB + MOD_CB);
    unsigned* cnt = (unsigned*)(a.ws + WS_CTL * MiB) + CW_CNT;
    int* ltok = (int*)(a.ws + WS_LISTS * MiB); float* lw = (float*)(a.ws + WS_LISTS * MiB + LIST_STRIDE); int* ldst = (int*)(a.ws + WS_LISTS * MiB + 2 * LIST_STRIDE);
    for (int tile = first; tile < MT / 32; tile += stride) {
        const int tok0 = tile * 32, b = tok0 / SEQ; const int kb = w * 256;
        const float* xr = X1 + (size_t)(tok0 + r32) * DM + kb; const float* wb = WR + ((size_t)b * DM + kb) * NE;
        f32x16 acc = {};
#pragma unroll 4
        for (int q = 0; q < 64; ++q) { const f32x4 xv = *(const f32x4*)(xr + 4 * q);
            const float a0 = hi ? xv[1] : xv[0], a1 = hi ? xv[3] : xv[2];
            const float b0 = wb[(4 * q + hi) * NE + r32], b1 = wb[(4 * q + 2 + hi) * NE + r32];
            acc = __builtin_amdgcn_mfma_f32_32x32x2f32(a0, b0, acc, 0, 0, 0);
            acc = __builtin_amdgcn_mfma_f32_32x32x2f32(a1, b1, acc, 0, 0, 0); }
#pragma unroll
        for (int r = 0; r < 16; ++r) part[(w * 32 + (r & 3) + 8 * (r >> 2) + 4 * hi) * 33 + r32] = acc[r];
        __syncthreads();
#pragma unroll
        for (int i = 0; i < 2; ++i) { const int o = tid + NTHR * i, tk = o >> 5, e = o & 31; float s = 0.f;
#pragma unroll
            for (int ww = 0; ww < 8; ++ww) s += part[(ww * 32 + tk) * 33 + e];
            lg[tk * 33 + e] = s * RS[tok0 + tk] + CB[b * NE + e]; }
        __syncthreads();
        if (tid < 32) { const int tk = tok0 + tid; float v[4]; int ix[4]; unsigned used = 0u;
#pragma unroll
            for (int k = 0; k < 4; ++k) { float best = -__builtin_inff(); int bi = 0;
                for (int e = 0; e < NE; ++e) { const float x = lg[tid * 33 + e]; if (!((used >> e) & 1u) && x > best) { best = x; bi = e; } }
                v[k] = best; ix[k] = bi; used |= 1u << bi; }
            float p[4], sum = 0.f;
#pragma unroll
            for (int k = 0; k < 4; ++k) { p[k] = __expf(v[k] - v[0]); sum += p[k]; }
            const float inv = 1.0f / sum;
#pragma unroll
            for (int k = 0; k < 4; ++k) { const int e = ix[k]; const unsigned pos = __hip_atomic_fetch_add(cnt + 64 * e, 1u, RLX_AGENT);
                ltok[e * 16384 + pos] = tk; lw[e * 16384 + pos] = p[k] * inv; ldst[e * 16384 + pos] = tk * 4 + k; } }
        __syncthreads();
    }
}
__device__ __forceinline__ void ph_final(const Args& a, int vcu, int G) {
    const int tid = threadIdx.x, lane = tid & 63, wave = __builtin_amdgcn_readfirstlane(tid >> 6), gw = vcu * NWAVES + wave, NGW = G * NWAVES;
    const float* mod = WSP(float, WS_MOD); const float* X1 = WSP(float, WS_X1); const bf16* YS = WSP(bf16, WS_YS); const float* gp = a.in[I_GPOSTFFN];
    for (int m = gw; m < MT; m += NGW) { const int b = m / SEQ; const float* mb = mod + b * 12288;
        f32x4 f[8]; float s = 0.f;
#pragma unroll
        for (int j = 0; j < 8; ++j) { f[j] = (f32x4){0.f, 0.f, 0.f, 0.f};
#pragma unroll
            for (int k = 0; k < 4; ++k) { const u32x2 v = *((const u32x2*)(YS + ((size_t)m * 4 + k) * DM) + lane + 64 * j); f[j] += (f32x4){bflo(v.x), bfhi(v.x), bflo(v.y), bfhi(v.y)}; }
            s += (f[j].x * f[j].x + f[j].y * f[j].y) + (f[j].z * f[j].z + f[j].w * f[j].w); }
        const float rstd = 1.0f / sqrtf(wave_sum(s) * (1.0f / DM) + 1e-6f);
#pragma unroll
        for (int j = 0; j < 8; ++j) { const int o4 = lane + 64 * j; const f32x4 xx = *((const f32x4*)(X1 + (size_t)m * DM) + o4), gg = *((const f32x4*)gp + o4), gt = *((const f32x4*)(mb + 10240) + o4);
            *((f32x4*)(a.out + (size_t)m * DM) + o4) = xx + gt * (f[j] * rstd * gg); } }
}
__device__ __forceinline__ void moe_table(const Args& a, LAS unsigned char* lds) {
    LAS int* tab = (LAS int*)(lds + TAB_OFF); const unsigned* cnt = (const unsigned*)(a.ws + WS_CTL * MiB) + CW_CNT;
    __syncthreads();
    if (threadIdx.x < 32) tab[threadIdx.x] = (int)__hip_atomic_load(cnt + 64 * threadIdx.x, RLX_AGENT);
    __syncthreads();
    if (threadIdx.x == 0) { int s = 0; for (int e = 0; e < 32; ++e) { tab[32 + e] = s; s += (tab[e] + 255) >> 8; } tab[64] = s; }
    __syncthreads();
}

__global__ void __launch_bounds__(NTHR, 2) hybrid_fwd(Args a) {
    extern __shared__ __attribute__((aligned(16))) unsigned char lds_raw[];
    LAS unsigned char* lds = (LAS unsigned char*)lds_raw;
    volatile LAS unsigned* MISC = (volatile LAS unsigned*)(lds + MISC_OFF);
    const int tid = threadIdx.x; const int G = gridDim.x; const int bx = blockIdx.x;
    const int vcu = (G % 8 == 0) ? (bx % 8) * (G / 8) + bx / 8 : bx;
    for (int u = tid; u < (LDS_BYTES - MISC_OFF) / 4; u += NTHR) ((LAS unsigned*)(lds + MISC_OFF))[u] = 0u;
    __syncthreads();
    unsigned* ctl = (unsigned*)(a.ws + WS_CTL * MiB);
    XcdBarrier bar; bar.bar = ctl + CW_BAR; bar.x = 0; bar.st = nullptr;
    const int lo = a.ph_lo, hi = a.ph_hi;
    const bool fused = (hi - lo) > 1;
    if (fused) bar = xcd_barrier_post(ctl + CW_BAR, MISC + 8);
#define IN(k) (lo <= (k) && (k) < hi)
#define SEAM(k) do { if (IN(k) && IN((k) + 1)) xcd_barrier(bar); } while (0)

    if (IN(0)) { ph_mod(a, lds); } SEAM(0);
    if (IN(1)) { ph_prep(a, lds, vcu, G); } SEAM(1);
    if (IN(2)) {
        pg8::ProbDense P; P.init(WSP(bf16, WS_H), WSP(bf16, WS_WT_IN), MT, NPROJ, DM, G, bx);
        pg8::EpiInProj E{a.ws};
        pg8::gemm_phase<pg8::EpiInProj, pg8::ProbDense, true>(lds, P, E);
    } SEAM(2);
    if (IN(3)) { ph_conv(a, vcu, G); } SEAM(3);
    if (IN(4)) {
        ph_ssd1(a, lds, bx, G);
        __syncthreads();
        att::attn_phase((char*)lds_raw, WSP(bf16, WS_Q), WSP(bf16, WS_K), WSP(bf16, WS_V), WSP(bf16, WS_OATT), bx, G);
    } SEAM(4);
    if (IN(5)) { ph_ssd2(a, vcu, G); ph_attn_combine(a, vcu, G); } SEAM(5);
    if (IN(6)) { ph_ssd3(a, lds, bx, G); } SEAM(6);
    if (IN(7)) {
        { pg8::ProbDense P; P.init(WSP(bf16, WS_YBUF), WSP(bf16, WS_WT_BS), MT, DM, DM, G, bx);
          pg8::EpiBr1 E{WSP(bf16, WS_SGS), WSP(float, WS_M1)};
          pg8::gemm_phase<pg8::EpiBr1, pg8::ProbDense, true>(lds, P, E); }
        __syncthreads();
        { pg8::ProbDense P; P.init(WSP(bf16, WS_OFIN), WSP(bf16, WS_WT_BA), MT, DM, DM, G, bx);
          pg8::EpiBr2 E{WSP(bf16, WS_SGA), WSP(float, WS_M1), WSP(bf16, WS_MERGED)};
          pg8::gemm_phase<pg8::EpiBr2, pg8::ProbDense, true>(lds, P, E); }
    } SEAM(7);
    if (IN(8)) {
        pg8::ProbDense P; P.init(WSP(bf16, WS_MERGED), WSP(bf16, WS_WT_OUT), MT, DM, DM, G, bx);
        pg8::EpiF32 E{WSP(float, WS_MIX), DM};
        pg8::gemm_phase<pg8::EpiF32, pg8::ProbDense, true>(lds, P, E);
    } SEAM(8);
    if (IN(9)) { ph_rows1(a, vcu, G); } SEAM(9);
    if (IN(10)) { ph_router(a, lds, bx, G); } SEAM(10);
    if (IN(11)) {
        moe_table(a, lds);
        pg8::ProbMoE<true> P; P.A = (const char*)WSP(bf16, WS_H2); P.Bt = (const char*)WSP(bf16, WS_WT_GU); P.K = DM; P.nN = 16; P.estride = (size_t)4096 * DM * 2;
        P.list_tok = (const int*)(a.ws + WS_LISTS * MiB); P.tab = (const LAS int*)(lds + TAB_OFF); P.G = G; P.c = bx;
        pg8::EpiGateUp E{a.in[I_BGU], WSP(bf16, WS_ACT)};
        pg8::gemm_phase<pg8::EpiGateUp, pg8::ProbMoE<true>, true>(lds, P, E);
    } SEAM(11);
    if (IN(12)) {
        moe_table(a, lds);
        pg8::ProbMoE<false> P; P.A = (const char*)WSP(bf16, WS_ACT); P.Bt = (const char*)WSP(bf16, WS_WT_DN); P.K = DM; P.nN = 8; P.estride = (size_t)DM * DM * 2;
        P.list_tok = nullptr; P.tab = (const LAS int*)(lds + TAB_OFF); P.G = G; P.c = bx;
        pg8::EpiDown E{a.in[I_BDN], (const int*)(a.ws + WS_LISTS * MiB + 2 * LIST_STRIDE), (const float*)(a.ws + WS_LISTS * MiB + LIST_STRIDE), (const LAS int*)(lds + TAB_OFF), WSP(bf16, WS_YS)};
        pg8::gemm_phase<pg8::EpiDown, pg8::ProbMoE<false>, true>(lds, P, E);
    } SEAM(12);
    if (IN(13)) { ph_final(a, vcu, G); }
#undef IN
#undef SEAM
}

extern "C" void kernel_launch(void* const* d_in, const int* in_sizes, int n_in, void* d_out, int out_size, void* d_ws, size_t ws_size, hipStream_t stream) {
    static int grid = 0;
    if (grid == 0) {
        if (n_in != 29 || in_sizes[0] != MT * DM || out_size != MT * DM || ws_size < WS_END * MiB) {
            fprintf(stderr, "kernel_launch: unexpected shapes (n_in %d, in0 %d, out %d, ws %zu); nothing launched\n", n_in, n_in > 0 ? in_sizes[0] : -1, out_size, ws_size); grid = -1; return; }
        int dev = 0, cus = 0, per_cu = 0;
        if (hipGetDevice(&dev) != hipSuccess || hipDeviceGetAttribute(&cus, hipDeviceAttributeMultiprocessorCount, dev) != hipSuccess) { grid = -1; return; }
        if (hipFuncSetAttribute((const void*)hybrid_fwd, hipFuncAttributeMaxDynamicSharedMemorySize, LDS_BYTES) != hipSuccess) { fprintf(stderr, "kernel_launch: hipFuncSetAttribute failed\n"); grid = -1; return; }
        if (hipOccupancyMaxActiveBlocksPerMultiprocessor(&per_cu, (const void*)hybrid_fwd, NTHR, LDS_BYTES) != hipSuccess || per_cu < 1)
            fprintf(stderr, "kernel_launch: note: occupancy query reports %d workgroups per CU\n", per_cu);
        (void)hipGetLastError();
        grid = cus;
    }
    if (grid < 0) return;
    (void)hipMemsetAsync((char*)d_ws + WS_CTL * MiB, 0, CTL_ZERO_BYTES, stream);
    Args a{};
    for (int i = 0; i < 29; ++i) a.in[i] = (const float*)d_in[i];
    a.out = (float*)d_out; a.ws = (unsigned char*)d_ws;
#if MK_PER_PHASE
    for (int k = 0; k < NPH; ++k) { a.ph_lo = k; a.ph_hi = k + 1; hipLaunchKernelGGL(hybrid_fwd, dim3(grid), dim3(NTHR), LDS_BYTES, stream, a); }
#else
    a.ph_lo = 0; a.ph_hi = NPH;
    hipLaunchKernelGGL(hybrid_fwd, dim3(grid), dim3(NTHR), LDS_BYTES, stream, a);
#endif
    const hipError_t le = hipPeekAtLastError();
    if (le != hipSuccess) fprintf(stderr, "kernel_launch: launch failed: %s\n", hipGetErrorName(le));
}
```

```cpp
#include <hip/hip_runtime.h>
#include <cstdio>
#include <cstdint>

#define LAS __attribute__((address_space(3)))
#define GAS __attribute__((address_space(1)))
typedef unsigned short bf16;
typedef short bf16x8 __attribute__((ext_vector_type(8)));
typedef short s16x4 __attribute__((ext_vector_type(4)));
typedef float f32x2 __attribute__((ext_vector_type(2)));
typedef float f32x4 __attribute__((ext_vector_type(4)));
typedef float f32x16 __attribute__((ext_vector_type(16)));
typedef unsigned u32x2 __attribute__((ext_vector_type(2)));
typedef unsigned u32x4 __attribute__((ext_vector_type(4)));

#ifndef REP_MOD
#define REP_MOD 1
#endif
#ifndef REP_PREP
#define REP_PREP 1
#endif
#ifndef REP_INPROJ
#define REP_INPROJ 1
#endif
#ifndef REP_SSD1
#define REP_SSD1 1
#endif
#ifndef REP_ATTN
#define REP_ATTN 1
#endif
#ifndef REP_COMB
#define REP_COMB 1
#endif
#ifndef REP_SSD3
#define REP_SSD3 1
#endif
#ifndef REP_BR
#define REP_BR 1
#endif
#ifndef REP_OUT
#define REP_OUT 1
#endif
#ifndef REP_ROWS1
#define REP_ROWS1 1
#endif
#ifndef REP_GU
#define REP_GU 1
#endif
#ifndef REP_DN
#define REP_DN 1
#endif
#ifndef REP_FINAL
#define REP_FINAL 1
#endif
#ifndef MK_PER_PHASE
#define MK_PER_PHASE 0
#endif

constexpr int DM = 2048, NB = 4, SEQ = 4096, MT = NB * SEQ;
constexpr int NE = 32, TOPK = 4, NSLOT_ROWS = MT * TOPK + NE * 256;
constexpr int NPROJ_T = 61, NPROJ = NPROJ_T * 256;
constexpr int XBCW = 3072;
constexpr int NWAVES = 8, NTHR = 512;
constexpr int NPH = 14;

constexpr size_t MiB = 1u << 20;
constexpr size_t WS_CTL = 0, CTL_ZERO_BYTES = 1 * MiB;
constexpr size_t WS_MOD = 1, WS_ROPE = 2, WS_WR = 3, WS_RSTD = 4, WS_LISTS = 8, WS_ACS = 16, WS_DT = 18, WS_DTRAW = 20;
constexpr size_t WS_WT_IN = 32, WS_WT_BS = 96, WS_WT_BA = 104, WS_WT_OUT = 112, WS_WT_GU = 128, WS_WT_DN = 640;
constexpr size_t WS_H = 896, WS_Z = 960, WS_XBC = 1024, WS_Q = 1120, WS_K = 1184, WS_V = 1248, WS_SGS = 1312, WS_SGA = 1376, WS_XBCC = 1440;
constexpr size_t WS_YDIAG = 1536, WS_STATES = 1664, WS_YBUF = 1792, WS_OATT = 1856, WS_OFIN = 1984, WS_M1 = 2048, WS_MERGED = 2176, WS_MIX = 2240;
constexpr size_t WS_X1 = 2368, WS_H2 = 2496, WS_ACT = 2560, WS_YS = 2848, WS_END = 3104;
constexpr int CW_BAR = 4096;
constexpr int CW_CNT = 16384;
constexpr size_t MOD_CB = 256 * 1024;
constexpr size_t LIST_STRIDE = 2 * MiB;

constexpr int RING_BYTES = 131072;
constexpr int TAB_OFF = RING_BYTES;
constexpr int MISC_OFF = RING_BYTES + 1024;
constexpr int LDS_BYTES = 147456;

#define RLX_AGENT __ATOMIC_RELAXED, __HIP_MEMORY_SCOPE_AGENT
#define LDS_WAIT() asm volatile("s_waitcnt lgkmcnt(0)" ::: "memory")
#define VM_WAIT() asm volatile("s_waitcnt vmcnt(0)" ::: "memory")
#define SBAR() __builtin_amdgcn_sched_barrier(0)
__device__ __forceinline__ unsigned f2bf(float f) { unsigned u = __builtin_bit_cast(unsigned, f); return (u + 0x7fffu + ((u >> 16) & 1u)) >> 16; }

__device__ __forceinline__ float bf2f(unsigned short b) { return __builtin_bit_cast(float, (unsigned)b << 16); }
__device__ __forceinline__ float bflo(unsigned w) { return __builtin_bit_cast(float, w << 16); }
__device__ __forceinline__ float bfhi(unsigned w) { return __builtin_bit_cast(float, w & 0xffff0000u); }
__device__ __forceinline__ unsigned cvt_pk_bf16(float lo, float hi) { unsigned r; asm("v_cvt_pk_bf16_f32 %0, %1, %2" : "=v"(r) : "v"(lo), "v"(hi)); return r; }
__device__ __forceinline__ unsigned pk2(float lo, float hi) { return cvt_pk_bf16(lo, hi); }
__device__ __forceinline__ unsigned pk4_fp8(float a, float b, float c, float d) { int w = __builtin_amdgcn_cvt_pk_fp8_f32(a, b, 0, false); w = __builtin_amdgcn_cvt_pk_fp8_f32(c, d, w, true); return (unsigned)w; }
__device__ __forceinline__ float sigmoidf_(float x) { return 1.0f / (1.0f + __expf(-x)); }
__device__ __forceinline__ float siluf_(float x) { return x / (1.0f + __expf(-x)); }
__device__ __forceinline__ float wave_sum(float v) {
#pragma unroll
    for (int o = 1; o < 64; o <<= 1) v += __shfl_xor(v, o);
    return v;
}

#define XB_TMO      128
#define XB_XCNT(j)  (256  + 64 * (j))
#define XB_XSUB(j)  (1280 + 64 * (j))
#define XB_XGEN(j)  (2304 + 64 * (j))
#define XB_TOP      3328
#define XB_TOPGEN   3392
#define XCD_BAR_WORDS 3456
#define XB_SPIN_CAP (1u << 18)
__device__ __forceinline__ unsigned xb_ld(unsigned* p)              { return __hip_atomic_load(p, __ATOMIC_RELAXED, __HIP_MEMORY_SCOPE_AGENT); }
__device__ __forceinline__ unsigned xb_add(unsigned* p, unsigned v) { return __hip_atomic_fetch_add(p, v, __ATOMIC_RELAXED, __HIP_MEMORY_SCOPE_AGENT); }
__device__ __forceinline__ unsigned xb_xcc_id() { return (unsigned)__builtin_amdgcn_s_getreg((3 << 11) | 20) & 0xFu; }
#define XB_SPIN(cond, bar) do { unsigned _sp = 0; while (cond) { __builtin_amdgcn_s_sleep(1); \
    if ((++_sp & 255u) == 0u) { if (xb_ld(&(bar)[XB_TMO])) break; if (_sp > XB_SPIN_CAP) { atomicAdd(&(bar)[XB_TMO], 1u); break; } } } } while (0)
struct XcdBarrier { unsigned* bar; unsigned x; volatile LAS unsigned* st; };
__device__ __forceinline__ XcdBarrier xcd_barrier_post(unsigned* bar, volatile LAS unsigned* st) {
    XcdBarrier b; b.bar = bar; b.x = xb_xcc_id(); b.st = st;
    if (threadIdx.x == 0) (void)xb_add(&bar[XB_XCNT(b.x)], 1u);
    return b;
}
__device__ __forceinline__ void xcd_barrier_complete(unsigned* bar, unsigned x, unsigned& nloc, unsigned& nx) {
    const unsigned G = gridDim.x * gridDim.y * gridDim.z;
    unsigned sum, cnt, mine, sp = 0u;
    for (;;) {
        sum = 0u; cnt = 0u; mine = 0u;
#pragma unroll
        for (unsigned j = 0; j < 16; ++j) { const unsigned c = xb_ld(&bar[XB_XCNT(j)]); sum += c; cnt += (c > 0u) ? 1u : 0u; mine = (j == x) ? c : mine; }
        if (sum == G) break;
        __builtin_amdgcn_s_sleep(1);
        if ((++sp & 255u) == 0u) { if (xb_ld(&bar[XB_TMO])) break; if (sp > XB_SPIN_CAP) { atomicAdd(&bar[XB_TMO], 1u); break; } }
    }
    nloc = mine > 0u ? mine : 1u; nx = cnt > 0u ? cnt : 1u;
}
__device__ __forceinline__ void xcd_barrier(const XcdBarrier& b) {
    asm volatile("s_waitcnt vmcnt(0)" ::: "memory");
    __syncthreads();
    if (threadIdx.x == 0) {
        unsigned* bar = b.bar;
        __builtin_amdgcn_s_waitcnt(0);
        unsigned nloc = b.st[0], nx = b.st[1];
        if (nloc == 0u) { xcd_barrier_complete(bar, b.x, nloc, nx); b.st[0] = nloc; b.st[1] = nx; }
        const unsigned old = xb_add(&bar[XB_XSUB(b.x)], 1u);
        const unsigned gen = old / nloc;
        if (old + 1u == (gen + 1u) * nloc) {
            __builtin_amdgcn_fence(__ATOMIC_RELEASE, "agent");
            asm volatile("s_waitcnt vmcnt(0)" ::: "memory");
            const unsigned og = xb_add(&bar[XB_TOP], 1u);
            const unsigned tg = og / nx;
            if (og + 1u == (tg + 1u) * nx) xb_add(&bar[XB_TOPGEN], 1u);
            else XB_SPIN(xb_ld(&bar[XB_TOPGEN]) == tg, bar);
            __builtin_amdgcn_fence(__ATOMIC_ACQUIRE, "agent");
            xb_add(&bar[XB_XGEN(b.x)], 1u);
            asm volatile("s_waitcnt vmcnt(0)" ::: "memory");
        } else {
            XB_SPIN(xb_ld(&bar[XB_XGEN(b.x)]) == gen, bar);
            __builtin_amdgcn_fence(__ATOMIC_ACQUIRE, "agent");
            asm volatile("s_waitcnt vmcnt(0)" ::: "memory");
        }
    }
    __syncthreads();
}
namespace pg8 {
constexpr int BM = 256, BK = 64, HALF = 128, HTB = HALF * BK * 2, STAGE_BYTES = 8 * HTB, NXCD = 8, WGM = 8;
__host__ __device__ __forceinline__ int lds_byte(int r, int c) { const int st = (r >> 4) * 2 + (c >> 5), rr = r & 15, cc = c & 31, ob = rr * 64 + cc * 2; return st * 1024 + (ob ^ (((ob >> 9) & 1) << 5)); }
__host__ __device__ __forceinline__ void stage_rc(int b, int& R, int& C) { const int st = b / 1024, sb = b % 1024, swz = sb ^ (((sb >> 9) & 1) << 5); R = (st >> 1) * 16 + swz / 64; C = (st & 1) * 32 + (swz % 64) / 2; }
__host__ __device__ __forceinline__ int perm32(int rho) { const int n = rho >> 4, i = rho & 15; return 8 * (i >> 2) + 4 * n + (i & 3); }

struct Unit { int pm, pn, e, ml; };

struct ProbDense {
    static constexpr bool PRELOAD = false;
    const char* A; const char* Bt; int rb;
    int nM, nN, nwg, G, c;
    __device__ __forceinline__ void init(const void* A_, const void* Bt_, int M, int N, int K_, int G_, int c_) { A = (const char*)A_; Bt = (const char*)Bt_; rb = K_ * 2; nM = M / BM; nN = N / BM; nwg = nM * nN; G = G_; c = c_; }
    __device__ __forceinline__ bool next(int i, Unit& u) const {
        const long L = (long)i * G + c; if (L >= nwg) return false;
        int wgid = (int)L; { const int q = nwg / NXCD, r = nwg % NXCD, xcd = wgid % NXCD, off = wgid / NXCD; wgid = (xcd < r ? xcd * (q + 1) : r * (q + 1) + (xcd - r) * q) + off; }
        const int nig = WGM * nN, gid = wgid / nig, fm = gid * WGM, gsz = (nM - fm) < WGM ? (nM - fm) : WGM;
        u.pm = fm + ((wgid % nig) % gsz); u.pn = (wgid % nig) / gsz; u.e = 0; u.ml = 0; return true;
    }
    __device__ __forceinline__ const char* b_ptr(const Unit& u) const { return Bt + (size_t)u.pn * BM * rb; }
    __device__ __forceinline__ void a_offs(const Unit& u, const int (&R)[2], const int (&C)[2], unsigned (&off)[2][2]) const {
#pragma unroll
        for (int h = 0; h < 2; ++h)
#pragma unroll
            for (int i = 0; i < 2; ++i) off[h][i] = (unsigned)((u.pm * BM + h * HALF + R[i]) * rb + C[i] * 2);
    }
};

template <bool GATHER> struct ProbMoE {
    static constexpr bool PRELOAD = GATHER;
    const char* A; const char* Bt; int rb, nN; size_t estride;
    const int* list_tok; const LAS int* tab; int G, c;
    __device__ __forceinline__ bool next(int i, Unit& u) const {
        const int L = i * G + c; const int NT = tab[64];
        if (L >= NT * nN) return false;
        int e = 0;
#pragma unroll 1
        for (int j = 1; j < 32; ++j) if (L >= tab[32 + j] * nN) e = j;
        const int tb = tab[32 + e], ntile = tab[33 + e] - tb, Lp = L - tb * nN;
        u.e = e; u.pn = Lp / ntile; u.ml = Lp % ntile; u.pm = tb + u.ml; return true;
    }
    __device__ __forceinline__ const char* b_ptr(const Unit& u) const { return Bt + (size_t)u.e * estride + (size_t)u.pn * BM * rb; }
    __device__ __forceinline__ void a_offs(const Unit& u, const int (&R)[2], const int (&C)[2], unsigned (&off)[2][2]) const {
        if constexpr (GATHER) {
            const int cnt = tab[u.e];
#pragma unroll
            for (int h = 0; h < 2; ++h)
#pragma unroll
                for (int i = 0; i < 2; ++i) { const int j = u.ml * BM + h * HALF + R[i]; const int tok = (j < cnt) ? list_tok[u.e * 16384 + j] : 0; off[h][i] = (unsigned)(tok * rb + C[i] * 2); }
        } else {
#pragma unroll
            for (int h = 0; h < 2; ++h)
#pragma unroll
                for (int i = 0; i < 2; ++i) off[h][i] = (unsigned)((u.pm * BM + h * HALF + R[i]) * rb + C[i] * 2);
        }
    }
};

typedef int v8i32 __attribute__((ext_vector_type(8)));
typedef int v4i32 __attribute__((ext_vector_type(4)));
__device__ __forceinline__ v8i32 cat8(bf16x8 a, bf16x8 b) { const v4i32 x = __builtin_bit_cast(v4i32, a), y = __builtin_bit_cast(v4i32, b); return __builtin_shufflevector(x, y, 0, 1, 2, 3, 4, 5, 6, 7); }
template <class Epi, class Prob, bool ALIGN_EPI, bool FP8 = false, int WSCALE = 127>
__device__ __forceinline__ void gemm_phase(LAS unsigned char* lds, const Prob& P, const Epi& E) {
    const int tid = threadIdx.x, wid = __builtin_amdgcn_readfirstlane(tid >> 6), lane = tid & 63, wr = wid >> 2, wc = wid & 3, fr = lane & 15, fq = lane >> 4;
    const int rb = P.rb, nt = rb / 128;
    unsigned voffB[2]; int RA[2], CA[2];
#pragma unroll
    for (int i = 0; i < 2; ++i) { int R, C; stage_rc(tid * 16 + i * 8192, R, C); const int Rb = Epi::PERM ? ((R & ~31) + perm32(R & 31)) : R;
        RA[i] = R; CA[i] = C; voffB[i] = (unsigned)(Rb * rb + C * 2); }
    const size_t kstep = (size_t)(BK * 2);
    const size_t hstep = (size_t)HALF * rb;
    const unsigned ldsw = (unsigned)wid * 1024u;
    const int aoff = lds_byte(wr * 64 + fr, fq * 8), boff = lds_byte(wc * 32 + fr, fq * 8);
#define PG8_SA(b, h) (((b) * 2 + (h)) * HTB)
#define PG8_SB(b, h) ((4 + (b) * 2 + (h)) * HTB)
#define PG8_STAGE(bufoff, gbase, voff) do { _Pragma("unroll") for (int _i = 0; _i < 2; ++_i) \
        __builtin_amdgcn_global_load_lds((const unsigned*)((const char*)(gbase) + (voff)[_i]), (LAS unsigned*)(lds + (bufoff) + ldsw + _i * 8192), 16, 0, 0); } while (0)
#define PG8_LDA(dst, b, h) do { _Pragma("unroll") for (int m = 0; m < 4; ++m) _Pragma("unroll") for (int k = 0; k < 2; ++k) dst[m][k] = *(const LAS bf16x8*)(lds + PG8_SA(b, h) + aoff + m * 2048 + k * 1024); } while (0)
#define PG8_LDB(dst, b, h) do { _Pragma("unroll") for (int n = 0; n < 2; ++n) _Pragma("unroll") for (int k = 0; k < 2; ++k) dst[n][k] = *(const LAS bf16x8*)(lds + PG8_SB(b, h) + boff + n * 2048 + k * 1024); } while (0)
#define PG8_MMA(ai, bj, At, Bt) do { __builtin_amdgcn_s_setprio(1); _Pragma("unroll") for (int m = 0; m < 4; ++m) _Pragma("unroll") for (int n = 0; n < 2; ++n) { \
        if constexpr (FP8) acc[ai][bj][m][n] = __builtin_amdgcn_mfma_scale_f32_16x16x128_f8f6f4(cat8(Bt[n][0], Bt[n][1]), cat8(At[m][0], At[m][1]), acc[ai][bj][m][n], 0, 0, 0, WSCALE, 0, 127); \
        else { _Pragma("unroll") for (int k = 0; k < 2; ++k) acc[ai][bj][m][n] = __builtin_amdgcn_mfma_f32_16x16x32_bf16(Bt[n][k], At[m][k], acc[ai][bj][m][n], 0, 0, 0); } } \
        __builtin_amdgcn_s_setprio(0); } while (0)
#define PG8_WAIT_V(n) asm volatile("s_waitcnt vmcnt(" #n ")" ::: "memory")
#define PG8_WAIT_L(n) asm volatile("s_waitcnt lgkmcnt(" #n ")" ::: "memory")
#define PG8_BAR __builtin_amdgcn_s_barrier()
    Unit cur, nxt; int ui = 0;
    if (!P.next(0, cur)) return;
    f32x4 acc[2][2][4][2];
#pragma unroll
    for (int a = 0; a < 2; ++a)
#pragma unroll
        for (int b = 0; b < 2; ++b)
#pragma unroll
            for (int m = 0; m < 4; ++m)
#pragma unroll
                for (int n = 0; n < 2; ++n) acc[a][b][m][n] = (f32x4){0.f, 0.f, 0.f, 0.f};
    bf16x8 At[4][2], B0[2][2], B1[2][2];
    unsigned offA[2][2], noffA[2][2];
    P.a_offs(cur, RA, CA, offA);
    const char* Ab = P.A;
    const char* cB = P.b_ptr(cur);
    PG8_STAGE(PG8_SB(0, 0), cB, voffB); PG8_STAGE(PG8_SB(0, 1), cB + hstep, voffB); PG8_STAGE(PG8_SA(0, 0), Ab, offA[0]); PG8_STAGE(PG8_SA(0, 1), Ab, offA[1]);
    if (wr == 1) PG8_BAR;
    PG8_WAIT_V(2); PG8_BAR;
    PG8_STAGE(PG8_SB(1, 0), cB + kstep, voffB); PG8_STAGE(PG8_SA(1, 0), Ab + kstep, offA[0]); PG8_STAGE(PG8_SB(1, 1), cB + hstep + kstep, voffB);
    PG8_WAIT_V(6); PG8_BAR;
    for (;;) {
        const bool has_next = P.next(ui + 1, nxt);
        if constexpr (Prob::PRELOAD) {
            if (has_next) P.a_offs(nxt, RA, CA, noffA);
            else {
#pragma unroll
                for (int h = 0; h < 2; ++h)
#pragma unroll
                    for (int i = 0; i < 2; ++i) noffA[h][i] = offA[h][i];
            }
        }
        const char* nB = has_next ? P.b_ptr(nxt) : cB;
        for (int t = 0; t < nt; t += 2) {
            const bool last = (t == nt - 2);
            const char* a1 = Ab + (size_t)(t + 1) * kstep;
            const char* a2 = last ? Ab : Ab + (size_t)(t + 2) * kstep; const char* b2 = last ? nB : cB + (size_t)(t + 2) * kstep;
            const char* a3 = a2 + kstep; const char* b3 = b2 + kstep;
            PG8_LDB(B0, 0, 0); PG8_LDB(B1, 0, 1); SBAR(); PG8_LDA(At, 0, 0); PG8_STAGE(PG8_SA(1, 1), a1, offA[1]);
            PG8_WAIT_V(8); PG8_WAIT_L(0); PG8_BAR; PG8_MMA(0, 0, At, B0); PG8_MMA(0, 1, At, B1); PG8_BAR; SBAR();
            if (last) {
                if constexpr (Prob::PRELOAD) {
#pragma unroll
                    for (int h = 0; h < 2; ++h)
#pragma unroll
                        for (int i = 0; i < 2; ++i) offA[h][i] = noffA[h][i];
                } else { if (has_next) P.a_offs(nxt, RA, CA, offA); }
            }
            PG8_LDA(At, 0, 1); PG8_STAGE(PG8_SB(0, 0), b2, voffB); PG8_STAGE(PG8_SB(0, 1), b2 + hstep, voffB); PG8_STAGE(PG8_SA(0, 0), a2, offA[0]);
            PG8_WAIT_V(8); PG8_WAIT_L(0); PG8_BAR; PG8_MMA(1, 0, At, B0); PG8_MMA(1, 1, At, B1); PG8_BAR; SBAR();
            PG8_LDB(B0, 1, 0); PG8_LDB(B1, 1, 1); SBAR(); PG8_LDA(At, 1, 0); PG8_STAGE(PG8_SA(0, 1), a2, offA[1]);
            PG8_WAIT_V(8); PG8_WAIT_L(0); PG8_BAR; PG8_MMA(0, 0, At, B0); PG8_MMA(0, 1, At, B1); PG8_BAR; SBAR();
            PG8_LDA(At, 1, 1); PG8_STAGE(PG8_SB(1, 0), b3, voffB); PG8_STAGE(PG8_SB(1, 1), b3 + hstep, voffB); PG8_STAGE(PG8_SA(1, 0), a3, offA[0]);
            PG8_WAIT_V(8); PG8_WAIT_L(0); PG8_BAR; PG8_MMA(1, 0, At, B0); PG8_MMA(1, 1, At, B1); PG8_BAR; SBAR();
        }
        if constexpr (ALIGN_EPI) { if (wr == 0) PG8_BAR; }
        E(acc, cur, wr, wc, fr, fq);
        if (!has_next) break;
#pragma unroll
        for (int a = 0; a < 2; ++a)
#pragma unroll
            for (int b = 0; b < 2; ++b)
#pragma unroll
                for (int m = 0; m < 4; ++m)
#pragma unroll
                    for (int n = 0; n < 2; ++n) acc[a][b][m][n] = (f32x4){0.f, 0.f, 0.f, 0.f};
        cur = nxt; cB = nB; ++ui;
        if constexpr (ALIGN_EPI) { if (wr == 1) PG8_BAR; }
    }
    PG8_WAIT_V(0);
    if constexpr (!ALIGN_EPI) { if (wr == 0) PG8_BAR; }
    PG8_BAR;
#undef PG8_SA
#undef PG8_SB
#undef PG8_STAGE
#undef PG8_LDA
#undef PG8_LDB
#undef PG8_MMA
#undef PG8_WAIT_V
#undef PG8_WAIT_L
#undef PG8_BAR
}
}
namespace pg8 {
struct EpiInProj {
    static constexpr bool PERM = true;
    unsigned char* ws;
    __device__ __forceinline__ void operator()(const f32x4 (&acc)[2][2][4][2], const Unit& u, int wr, int wc, int fr, int fq) const {
        const int pn = u.pn; const int row0 = u.pm * BM + wr * 64 + fr;
        if (pn == 60) {
            if (wc == 0) { float* dst = (float*)(ws + WS_DTRAW * MiB);
#pragma unroll
                for (int ai = 0; ai < 2; ++ai)
#pragma unroll
                    for (int m = 0; m < 4; ++m) { float* rp = dst + (size_t)(row0 + ai * HALF + m * 16) * 32 + 8 * fq;
                        *(f32x4*)rp = acc[ai][0][m][0]; *(f32x4*)(rp + 4) = acc[ai][0][m][1]; } }
            return;
        }
        bf16* base; int ldc, colt; bool sig = false;
        if (pn < 8)       { base = (bf16*)(ws + WS_Z * MiB);   ldc = DM;   colt = pn * BM; }
        else if (pn < 20) { base = (bf16*)(ws + WS_XBC * MiB); ldc = XBCW; colt = (pn - 8) * BM; }
        else if (pn < 28) { base = (bf16*)(ws + WS_Q * MiB);   ldc = DM;   colt = (pn - 20) * BM; }
        else if (pn < 36) { base = (bf16*)(ws + WS_K * MiB);   ldc = DM;   colt = (pn - 28) * BM; }
        else if (pn < 44) { base = (bf16*)(ws + WS_V * MiB);   ldc = DM;   colt = (pn - 36) * BM; }
        else if (pn < 52) { base = (bf16*)(ws + WS_SGS * MiB); ldc = DM;   colt = (pn - 44) * BM; sig = true; }
        else              { base = (bf16*)(ws + WS_SGA * MiB); ldc = DM;   colt = (pn - 52) * BM; sig = true; }
        const int col0 = colt + wc * 32 + 8 * fq;
#pragma unroll
        for (int ai = 0; ai < 2; ++ai)
#pragma unroll
            for (int m = 0; m < 4; ++m) { bf16* rowp = base + (size_t)(row0 + ai * HALF + m * 16) * ldc + col0;
#pragma unroll
                for (int bj = 0; bj < 2; ++bj) { f32x4 v0 = acc[ai][bj][m][0], v1 = acc[ai][bj][m][1];
                    if (sig) {
#pragma unroll
                        for (int q = 0; q < 4; ++q) { v0[q] = sigmoidf_(v0[q]); v1[q] = sigmoidf_(v1[q]); } }
                    u32x4 w; w.x = cvt_pk_bf16(v0[0], v0[1]); w.y = cvt_pk_bf16(v0[2], v0[3]); w.z = cvt_pk_bf16(v1[0], v1[1]); w.w = cvt_pk_bf16(v1[2], v1[3]);
                    *(u32x4*)(rowp + bj * HALF) = w; } }
    }
};
struct EpiBr1 {
    static constexpr bool PERM = false;
    const bf16* sg; float* m1;
    __device__ __forceinline__ void operator()(const f32x4 (&acc)[2][2][4][2], const Unit& u, int wr, int wc, int fr, int fq) const {
        const int row0 = u.pm * BM + wr * 64 + fr, col0 = u.pn * BM + wc * 32 + 4 * fq;
#pragma unroll
        for (int ai = 0; ai < 2; ++ai)
#pragma unroll
            for (int m = 0; m < 4; ++m) { const size_t off = (size_t)(row0 + ai * HALF + m * 16) * DM + col0;
#pragma unroll
                for (int bj = 0; bj < 2; ++bj)
#pragma unroll
                    for (int n = 0; n < 2; ++n) { const u32x2 g = *(const u32x2*)(sg + off + bj * HALF + n * 16); const f32x4 a = acc[ai][bj][m][n];
                        *(f32x4*)(m1 + off + bj * HALF + n * 16) = (f32x4){a[0] * bflo(g.x), a[1] * bfhi(g.x), a[2] * bflo(g.y), a[3] * bfhi(g.y)}; } }
    }
};
struct EpiBr2 {
    static constexpr bool PERM = false;
    const bf16* sg; const float* m1; bf16* out;
    __device__ __forceinline__ void operator()(const f32x4 (&acc)[2][2][4][2], const Unit& u, int wr, int wc, int fr, int fq) const {
        const int row0 = u.pm * BM + wr * 64 + fr, col0 = u.pn * BM + wc * 32 + 4 * fq;
#pragma unroll
        for (int ai = 0; ai < 2; ++ai)
#pragma unroll
            for (int m = 0; m < 4; ++m) { const size_t off = (size_t)(row0 + ai * HALF + m * 16) * DM + col0;
#pragma unroll
                for (int bj = 0; bj < 2; ++bj)
#pragma unroll
                    for (int n = 0; n < 2; ++n) { const size_t o2 = off + bj * HALF + n * 16; const u32x2 g = *(const u32x2*)(sg + o2); const f32x4 a = acc[ai][bj][m][n]; const f32x4 p = *(const f32x4*)(m1 + o2);
                        u32x2 w; w.x = cvt_pk_bf16(p[0] + a[0] * bflo(g.x), p[1] + a[1] * bfhi(g.x)); w.y = cvt_pk_bf16(p[2] + a[2] * bflo(g.y), p[3] + a[3] * bfhi(g.y));
                        *(u32x2*)(out + o2) = w; } }
    }
};
struct EpiF32 {
    static constexpr bool PERM = false;
    float* out; int ldc;
    __device__ __forceinline__ void operator()(const f32x4 (&acc)[2][2][4][2], const Unit& u, int wr, int wc, int fr, int fq) const {
        const int row0 = u.pm * BM + wr * 64 + fr, col0 = u.pn * BM + wc * 32 + 4 * fq;
#pragma unroll
        for (int ai = 0; ai < 2; ++ai)
#pragma unroll
            for (int m = 0; m < 4; ++m) { const size_t off = (size_t)(row0 + ai * HALF + m * 16) * ldc + col0;
#pragma unroll
                for (int bj = 0; bj < 2; ++bj)
#pragma unroll
                    for (int n = 0; n < 2; ++n) *(f32x4*)(out + off + bj * HALF + n * 16) = acc[ai][bj][m][n]; }
    }
};
struct EpiGateUp {
    static constexpr bool PERM = true;
    const float* bgu; unsigned char* act;
    __device__ __forceinline__ void operator()(const f32x4 (&acc)[2][2][4][2], const Unit& u, int wr, int wc, int fr, int fq) const {
        const int row0 = u.pm * BM + wr * 64 + fr; const int f0 = u.pn * 128 + wc * 16 + 4 * fq;
        const float* bg = bgu + (size_t)u.e * 4096;
#pragma unroll
        for (int bj = 0; bj < 2; ++bj) { const int f = f0 + bj * 64; const f32x4 bgate = *(const f32x4*)(bg + f), bup = *(const f32x4*)(bg + 2048 + f);
#pragma unroll
            for (int ai = 0; ai < 2; ++ai)
#pragma unroll
                for (int m = 0; m < 4; ++m) { const f32x4 g4 = acc[ai][bj][m][0] * 0.015625f + bgate, u4 = acc[ai][bj][m][1] * 0.015625f + bup; float r[4];
#pragma unroll
                    for (int q = 0; q < 4; ++q) { const float g = fminf(g4[q], 7.0f), up = fminf(fmaxf(u4[q], -7.0f), 7.0f); r[q] = (up + 1.0f) * g * sigmoidf_(1.702f * g); }
                    *(unsigned*)(act + (size_t)(row0 + ai * HALF + m * 16) * DM + f) = pk4_fp8(r[0], r[1], r[2], r[3]); } }
    }
};
struct EpiDown {
    static constexpr bool PERM = true;
    const float* bdn; const int* list_dst; const float* list_w; const LAS int* tab; bf16* ys;
    __device__ __forceinline__ void operator()(const f32x4 (&acc)[2][2][4][2], const Unit& u, int wr, int wc, int fr, int fq) const {
        const int cnt = tab[u.e]; const int col0 = u.pn * BM + wc * 32 + 8 * fq; const float* bd = bdn + (size_t)u.e * DM + col0;
        f32x4 bv[2][2];
#pragma unroll
        for (int bj = 0; bj < 2; ++bj)
#pragma unroll
            for (int n = 0; n < 2; ++n) bv[bj][n] = *(const f32x4*)(bd + bj * HALF + 4 * n);
#pragma unroll
        for (int ai = 0; ai < 2; ++ai)
#pragma unroll
            for (int m = 0; m < 4; ++m) { const int j = u.ml * BM + ai * HALF + wr * 64 + m * 16 + fr;
                if (j < cnt) { const int dst = list_dst[u.e * 16384 + j]; const float w = list_w[u.e * 16384 + j]; bf16* rowp = ys + (size_t)dst * DM + col0;
#pragma unroll
                    for (int bj = 0; bj < 2; ++bj) { const f32x4 v0 = (acc[ai][bj][m][0] * 0.015625f + bv[bj][0]) * w, v1 = (acc[ai][bj][m][1] * 0.015625f + bv[bj][1]) * w;
                        u32x4 o; o.x = cvt_pk_bf16(v0[0], v0[1]); o.y = cvt_pk_bf16(v0[2], v0[3]); o.z = cvt_pk_bf16(v1[0], v1[1]); o.w = cvt_pk_bf16(v1[2], v1[3]);
                        *(u32x4*)(rowp + bj * HALF) = o; } } }
    }
};
}
namespace att {
constexpr int NW = 8, QBLK = 32, KVBLK = 64, QB = NW * QBLK;
constexpr int SHM_V = KVBLK * 128 * 2, SHM_K = KVBLK * 64 * 2;
constexpr int LDS_BYTES = 2 * SHM_V + 2 * SHM_K + NW * 64 * 4;
constexpr int QP = 2048, OP = 4096;
constexpr float SCALE = 0.125f, THR = 8.f;
#define KSWZ(row, colB) ((row) * 128 + ((colB) ^ ((((row) >> 1) & 7) << 4)))
__device__ __forceinline__ int v_st(int k, int c) { const int kk = (k & ~0xC) | ((k & 4) << 1) | ((k & 8) >> 1); return ((kk >> 3) * 4 + (c >> 5)) * 512 + ((kk & 7) * 32 + (c & 31)) * 2; }
__device__ __forceinline__ int v_rd_base(int lane) { return ((lane & 3) << 3) | (((lane >> 2) & 3) << 6) | (((lane >> 4) & 1) << 5) | (((lane >> 5) & 1) << 8); }
constexpr int v_rd_off(int d0, int ks, int half) { return d0 * 512 + ks * 4096 + half * 2048; }
__device__ __forceinline__ int crow(int r, int hi) { return (r & 3) + 8 * (r >> 2) + 4 * hi; }
__device__ __forceinline__ unsigned cvtpk(float lo, float hi) { unsigned r; asm volatile("v_cvt_pk_bf16_f32 %0, %1, %2" : "=v"(r) : "v"(lo), "v"(hi)); return r; }
__device__ __forceinline__ bf16x8 load8(const bf16* p) { return *reinterpret_cast<const bf16x8*>(p); }
__device__ __forceinline__ void mask_tile(f32x16& p0, f32x16& p1, int dq) {
    const float NEG = -__builtin_inff();
#pragma unroll
    for (int r = 0; r < 16; ++r) {
        const int c = (r & 3) + 8 * (r >> 2);
        if (dq - c < 0) p0[r] = NEG;
        if (dq - c - 32 < 0) p1[r] = NEG;
    }
}
__device__ __forceinline__ void partialSM(f32x16& p0, f32x16& p1, float& m_reg, float& mn, float& alpha) {
    float pmax = p0[0];
#pragma unroll
    for (int r = 1; r < 16; ++r) pmax = fmaxf(pmax, p0[r]);
#pragma unroll
    for (int r = 0; r < 16; ++r) pmax = fmaxf(pmax, p1[r]);
    { auto rr = __builtin_amdgcn_permlane32_swap(__float_as_uint(pmax), __float_as_uint(pmax), false, false);
      pmax = fmaxf(__uint_as_float(rr[0]), __uint_as_float(rr[1])); }
    constexpr float C2 = 1.4426950408889634f * SCALE;
    if (__builtin_expect(__all((pmax - m_reg) * SCALE <= THR), 1)) { mn = m_reg; alpha = 1.f; }
    else { mn = fmaxf(m_reg, pmax); alpha = __builtin_amdgcn_exp2f((m_reg - mn) * C2); m_reg = mn; }
    const float mnL = -mn * C2;
#pragma unroll
    for (int r = 0; r < 16; ++r) p0[r] = fmaf(p0[r], C2, mnL);
#pragma unroll
    for (int r = 0; r < 16; ++r) p1[r] = fmaf(p1[r], C2, mnL);
#pragma unroll
    for (int r = 0; r < 16; ++r) p0[r] = __builtin_amdgcn_exp2f(p0[r]);
}
__device__ __forceinline__ void finishSM(f32x16& p0, f32x16& p1, float alpha, float& l_reg, bf16x8& pa0, bf16x8& pa1, bf16x8& pa2, bf16x8& pa3) {
#pragma unroll
    for (int r = 0; r < 16; ++r) p1[r] = __builtin_amdgcn_exp2f(p1[r]);
    float ps = 0;
#pragma unroll
    for (int r = 0; r < 16; ++r) ps += p0[r];
#pragma unroll
    for (int r = 0; r < 16; ++r) ps += p1[r];
    { auto rr = __builtin_amdgcn_permlane32_swap(__float_as_uint(ps), __float_as_uint(ps), false, false);
      ps = __uint_as_float(rr[0]) + __uint_as_float(rr[1]); }
    l_reg = l_reg * alpha + ps;
#define PK4(P, B_, OUT) do { unsigned a0 = cvtpk(P[B_+0], P[B_+1]), a1 = cvtpk(P[B_+2], P[B_+3]);                          \
        unsigned b0 = cvtpk(P[B_+4], P[B_+5]), b1 = cvtpk(P[B_+6], P[B_+7]);                                             \
        auto r0 = __builtin_amdgcn_permlane32_swap(a0, b0, false, false); auto r1 = __builtin_amdgcn_permlane32_swap(a1, b1, false, false); \
        u32x4 w = {r0[0], r1[0], r0[1], r1[1]}; OUT = *reinterpret_cast<bf16x8*>(&w); } while (0)
    PK4(p0, 0, pa0); PK4(p0, 8, pa1); PK4(p1, 0, pa2); PK4(p1, 8, pa3);
#undef PK4
}
template <int KB>
__device__ __forceinline__ void qkt(f32x16& p0, f32x16& p1, const char* K_lds, int r32, int hi, const bf16x8* qr) {
    p0 = f32x16{}; p1 = f32x16{};
#pragma unroll
    for (int d0 = 0; d0 < 4; ++d0) { const char* a = K_lds + KB * SHM_K + KSWZ(r32, (d0 * 2 + hi) * 16);
        bf16x8 b0 = *reinterpret_cast<const bf16x8*>(a);
        bf16x8 b1 = *reinterpret_cast<const bf16x8*>(a + 32 * 128);
        p0 = __builtin_amdgcn_mfma_f32_32x32x16_bf16(b0, qr[d0], p0, 0, 0, 0);
        p1 = __builtin_amdgcn_mfma_f32_32x32x16_bf16(b1, qr[d0], p1, 0, 0, 0); }
}
template <int VB>
__device__ __forceinline__ void pv_tile(f32x16* o, int vb0, bf16x8 pa0, bf16x8 pa1, bf16x8 pa2, bf16x8 pa3) {
#define TRRD(dst, off) asm volatile("ds_read_b64_tr_b16 %0, %1 offset:%2" : "=&v"(dst) : "v"(vb0), "i"(off) : "memory")
#define PV_D0(d0) do { s16x4 l0, l1, l2, l3, h0, h1, h2, h3; constexpr int b_ = VB * SHM_V + v_rd_off(d0, 0, 0); \
        TRRD(l0, b_); TRRD(h0, b_ + 2048); TRRD(l1, b_ + 4096); TRRD(h1, b_ + 6144); TRRD(l2, b_ + 8192); TRRD(h2, b_ + 10240); TRRD(l3, b_ + 12288); TRRD(h3, b_ + 14336); \
        asm volatile("s_waitcnt lgkmcnt(0)" ::: "memory"); SBAR();   \
        o[d0] = __builtin_amdgcn_mfma_f32_32x32x16_bf16(pa0, (bf16x8){l0[0], l0[1], l0[2], l0[3], h0[0], h0[1], h0[2], h0[3]}, o[d0], 0, 0, 0);   \
        o[d0] = __builtin_amdgcn_mfma_f32_32x32x16_bf16(pa1, (bf16x8){l1[0], l1[1], l1[2], l1[3], h1[0], h1[1], h1[2], h1[3]}, o[d0], 0, 0, 0);   \
        o[d0] = __builtin_amdgcn_mfma_f32_32x32x16_bf16(pa2, (bf16x8){l2[0], l2[1], l2[2], l2[3], h2[0], h2[1], h2[2], h2[3]}, o[d0], 0, 0, 0);   \
        o[d0] = __builtin_amdgcn_mfma_f32_32x32x16_bf16(pa3, (bf16x8){l3[0], l3[1], l3[2], l3[3], h3[0], h3[1], h3[2], h3[3]}, o[d0], 0, 0, 0); } while (0)
    PV_D0(0); PV_D0(1); PV_D0(2); PV_D0(3);
#undef PV_D0
#undef TRRD
}
struct BlockRef { const bf16* Q; const bf16* K; const bf16* V; bf16* O; int P0; };
struct Seam { bf16x8 qr[4]; bf16x8 st_v0, st_v1, st_k0; };
#define VMW() asm volatile("s_waitcnt vmcnt(0)" ::: "memory")
#define VMWN(n) asm volatile("s_waitcnt vmcnt(%0)" :: "i"(n) : "memory")
#define SLOAD_H(Kp, Vp, k0) do { S.st_v0 = load8((Vp) + (size_t)((k0) + sr) * QP + sc); S.st_v1 = load8((Vp) + (size_t)((k0) + 32 + sr) * QP + sc);              \
                                 S.st_k0 = load8((Kp) + (size_t)((k0) + krow) * QP + kc); } while (0)
#define SWRITE_HK(bf) do { *(bf16x8*)(K_lds + (bf) * SHM_K + kws) = S.st_k0; } while (0)
#define SWRITE_HV(bf) do { *(bf16x8*)(V_lds + (bf) * SHM_V + vst0) = S.st_v0; *(bf16x8*)(V_lds + (bf) * SHM_V + vst1) = S.st_v1; } while (0)
#define SWRITE_H(bf) do { SWRITE_HV(bf); SWRITE_HK(bf); } while (0)
__device__ __forceinline__ void attn_prime(const BlockRef& cur, char* lds, Seam& S) {
    const int tid = threadIdx.x, wid = __builtin_amdgcn_readfirstlane(tid >> 6), lane = tid & 63, r32 = lane & 31, hi = lane >> 5;
    const int sr = tid >> 4, sc = (tid & 15) * 8, krow = tid >> 3, kc = (tid & 7) * 8, kws = KSWZ(krow, kc * 2); char* K_lds = lds + 2 * SHM_V;
#pragma unroll
    for (int d0 = 0; d0 < 4; ++d0) S.qr[d0] = load8(cur.Q + (size_t)(wid * QBLK + r32) * QP + d0 * 16 + hi * 8);
    SLOAD_H(cur.K, cur.V, 0); VMW(); SWRITE_HK(0);
    __syncthreads();
}
__device__ __forceinline__ void attn_block(const BlockRef& cur, const BlockRef& nxt, char* lds, Seam& S) {
    const int tid = threadIdx.x, wid = __builtin_amdgcn_readfirstlane(tid >> 6), lane = tid & 63, r32 = lane & 31, hi = lane >> 5;
    const int NT = (cur.P0 + QB - 1) / KVBLK + 1;
    const int qlo = cur.P0 + wid * QBLK, qm = qlo + r32 - 4 * hi;
    char* V_lds = lds; char* K_lds = lds + 2 * SHM_V;
    float* ws = (float*)(lds + 2 * SHM_V + 2 * SHM_K) + wid * 64; float* li_l = ws, * al_l = ws + 32;
    float m_reg = -1e30f, l_reg = 0; f32x16 o[4] = {};
    const int sr = tid >> 4, sc = (tid & 15) * 8, vst0 = v_st(sr, sc), vst1 = v_st(32 + sr, sc);
    const int krow = tid >> 3, kc = (tid & 7) * 8, kws = KSWZ(krow, kc * 2);
    const int vb0 = (int)(uintptr_t)V_lds + v_rd_base(lane);
    const bf16* Kh = cur.K; const bf16* Vh = cur.V;
#define RESC(a) do { if (__any((a) < 1.f)) { if (hi == 0) al_l[r32] = (a); asm volatile("s_waitcnt lgkmcnt(0)" ::: "memory");              \
                     for (int d_ = 0; d_ < 4; ++d_) for (int r = 0; r < 16; ++r) o[d_][r] *= al_l[crow(r, hi)]; } } while (0)
#define KBASE(t) ((t) * KVBLK)
#define MASKT(P0_, P1_, t) do { const int kb_ = KBASE(t); if (kb_ + KVBLK - 1 > qlo) mask_tile(P0_, P1_, qm - kb_); } while (0)
    constexpr int NQL = 4;
#define SEAM_K0() do { VMWN(NQL); SWRITE_HK(0); SBAR(); } while (0)
    f32x16 pA0, pA1, pB0, pB1; float mnA, mnB, alA, alB; bf16x8 pa0, pa1, pa2, pa3;
    SWRITE_HV(0); SBAR();
    SLOAD_H(Kh, Vh, KBASE(1));
    SBAR(); qkt<0>(pA0, pA1, K_lds, r32, hi, S.qr);
    MASKT(pA0, pA1, 0); partialSM(pA0, pA1, m_reg, mnA, alA);
    VMW(); SWRITE_H(1);
    __syncthreads();
#define HALF_STEP(PX0, PX1, mnX, alX, PY0, PY1, alY, t, KB, VB, SB) do {                                                      \
        SBAR(); qkt<KB>(PX0, PX1, K_lds, r32, hi, S.qr);                                             \
        finishSM(PY0, PY1, alY, l_reg, pa0, pa1, pa2, pa3); SBAR();                                                           \
        if ((t) + 1 < NT) { SLOAD_H(Kh, Vh, KBASE((t) + 1)); SBAR(); }                                               \
        pv_tile<VB>(o, vb0, pa0, pa1, pa2, pa3); MASKT(PX0, PX1, (t)); partialSM(PX0, PX1, m_reg, mnX, alX);                                        \
        __syncthreads();                                                                                                      \
        if ((t) + 1 < NT) { VMW(); SWRITE_H(SB); }                                                                          \
        RESC(alX); __syncthreads(); } while (0)
    for (int t = 1; t + 1 < NT; t += 2) {
        HALF_STEP(pB0, pB1, mnB, alB, pA0, pA1, alA, t, 1, 0, 0);
        HALF_STEP(pA0, pA1, mnA, alA, pB0, pB1, alB, t + 1, 0, 1, 1);
    }
    const bool even = (NT & 1) == 0;
    if (even) { SBAR(); qkt<1>(pB0, pB1, K_lds, r32, hi, S.qr); SBAR(); }
    SLOAD_H(nxt.K, nxt.V, 0); SBAR();
#pragma unroll
    for (int d0 = 0; d0 < 4; ++d0) S.qr[d0] = load8(nxt.Q + (size_t)(wid * QBLK + r32) * QP + d0 * 16 + hi * 8);
    SBAR();
    finishSM(pA0, pA1, alA, l_reg, pa0, pa1, pa2, pa3); SBAR();
    pv_tile<0>(o, vb0, pa0, pa1, pa2, pa3);
    if (even) { MASKT(pB0, pB1, NT - 1); partialSM(pB0, pB1, m_reg, mnB, alB); __syncthreads(); RESC(alB);
        finishSM(pB0, pB1, alB, l_reg, pa0, pa1, pa2, pa3); SBAR(); pv_tile<1>(o, vb0, pa0, pa1, pa2, pa3); }
    SBAR(); SEAM_K0();
    if (hi == 0) li_l[r32] = l_reg; asm volatile("s_waitcnt lgkmcnt(0)" ::: "memory");
    float rli[16];
#pragma unroll
    for (int r = 0; r < 16; ++r) rli[r] = __builtin_amdgcn_rcpf(li_l[crow(r, hi)]);
    bf16* Ow = cur.O + (size_t)(wid * QBLK) * OP;
#pragma unroll
    for (int r = 0; r < 16; ++r) { const int orow = crow(r, hi);
#pragma unroll
        for (int d0 = 0; d0 < 4; ++d0) { const float v = o[d0][r] * rli[r];
            const float vn = __shfl_xor(v, 1);
            if ((r32 & 1) == 0) *(unsigned*)(Ow + (size_t)orow * OP + d0 * 32 + r32) = cvtpk(v, vn); } }
    __syncthreads();
#undef RESC
#undef KBASE
#undef MASKT
#undef SEAM_K0
#undef HALF_STEP
}
#undef VMW
#undef VMWN
#undef SLOAD_H
#undef SWRITE_HK
#undef SWRITE_HV
#undef SWRITE_H
#undef KSWZ
__device__ __forceinline__ BlockRef make_ref(int L, int pass, const bf16* Q, const bf16* K, const bf16* V, bf16* O) {
    const int bh = L >> 3, x = L & 7, qb = pass ? 15 - x : x, b = bh >> 5, map = bh & 31;
    const size_t seq0 = (size_t)b * SEQ, row0 = seq0 + (size_t)qb * QB;
    BlockRef r; r.Q = Q + row0 * QP + map * 64; r.K = K + seq0 * QP + map * 64; r.V = V + seq0 * QP + (map >> 1) * 128; r.O = O + row0 * OP + map * 128; r.P0 = qb * QB; return r;
}
__device__ __forceinline__ void attn_phase(char* lds, const bf16* Q, const bf16* K, const bf16* V, bf16* O, int first, int stride) {
    constexpr int total = NB * 32 * 8;
    int L = first; if (L >= total) return;
    int pass = 0;
    BlockRef cur = make_ref(L, 0, Q, K, V, O);
    Seam S;
    attn_prime(cur, lds, S);
    for (;;) {
        const bool more_pass = pass == 0, more_item = L + stride < total, last = !more_pass && !more_item;
        int passn = pass + 1, Ln = L;
        if (!more_pass) { passn = 0; Ln = more_item ? L + stride : L; }
        const BlockRef nxt = last ? cur : make_ref(Ln, passn, Q, K, V, O);
        attn_block(cur, nxt, lds, S);
        if (last) break;
        cur = nxt; pass = passn; L = Ln;
    }
}
}
struct Args { const float* in[29]; float* out; unsigned char* ws; int ph_lo, ph_hi; };
enum { I_X = 0, I_C, I_WADA, I_BADA, I_GPREMIX, I_GPOSTMIX, I_GPREFFN, I_GPOSTFFN, I_WIN, I_CONVW, I_CONVB, I_DTBIAS, I_ALOG, I_DSKIP, I_SSDNW,
       I_LQ1, I_LK1, I_LQ2, I_LK2, I_SUBLN, I_WBS, I_WBA, I_WOUT, I_WR, I_BR, I_WGU, I_BGU, I_WDN, I_BDN };
#define WSP(T, off) ((T*)(a.ws + (off) * MiB))

__device__ __forceinline__ void ph_mod(const Args& a, LAS unsigned char* lds) {
    LAS float* sc = (LAS float*)lds;
    LAS float* part = (LAS float*)(lds + 32768);
    const int tid = threadIdx.x; const float* c = a.in[I_C]; const float* W = a.in[I_WADA]; const float* bada = a.in[I_BADA]; float* mod = WSP(float, WS_MOD);
    for (int i = tid; i < NB * DM; i += NTHR) sc[i] = siluf_(c[i]);
    __syncthreads();
    for (int cb = blockIdx.x; cb < 256; cb += gridDim.x) {
        const int ks = tid / 12, quad = tid % 12;
        f32x4 acc[4] = {{0.f, 0.f, 0.f, 0.f}, {0.f, 0.f, 0.f, 0.f}, {0.f, 0.f, 0.f, 0.f}, {0.f, 0.f, 0.f, 0.f}};
        if (ks < 42) {
#pragma unroll 4
            for (int k = ks; k < DM; k += 42) { const f32x4 w = *(const f32x4*)(W + (size_t)k * 12288 + cb * 48 + quad * 4);
#pragma unroll
                for (int b = 0; b < 4; ++b) acc[b] += w * sc[b * DM + k]; }
#pragma unroll
            for (int b = 0; b < 4; ++b) *(LAS f32x4*)(part + (ks * 12 + quad) * 16 + b * 4) = acc[b];
        }
        __syncthreads();
        if (tid < 192) { const int col = tid % 48, b = tid / 48; float s = 0.f;
            for (int k2 = 0; k2 < 42; ++k2) s += part[(k2 * 12 + (col >> 2)) * 16 + b * 4 + (col & 3)];
            mod[b * 12288 + cb * 48 + col] = s + bada[cb * 48 + col]; }
        __syncthreads();
    }
}

constexpr int TRP = 68;
struct TrSrc { const float* p[4]; bool zero; };
__device__ __forceinline__ const float* tr_src(const float* W, int N, int k0, int d0, int kind, int lane, bool& zero) {
    const int j4 = (lane & 15) * 4; int scol; zero = false;
    if (kind == 0) scol = d0 + j4;
    else if (kind == 1) { const int r = d0 + j4;
        if (r < 5120) scol = r; else if (r < 15360) scol = r + 32; else if (r < 15392) scol = 5120 + (r - 15360); else { scol = 0; zero = true; } }
    else { const int a32 = (d0 >> 6) * 32; scol = (j4 < 32) ? a32 + j4 : 2048 + a32 + (j4 - 32); }
    return W + (size_t)(k0 + (lane >> 4)) * N + scol;
}
__device__ __forceinline__ void tr_load8(const float* src, int N, bool zero, int half, f32x4 (&v)[8]) {
#pragma unroll
    for (int i = 0; i < 8; ++i) v[i] = zero ? (f32x4){0.f, 0.f, 0.f, 0.f} : *(const f32x4*)(src + (size_t)(4 * (8 * half + i)) * N);
}
__device__ __forceinline__ void tr_put8(const f32x4 (&v)[8], int half, LAS bf16* scr, int lane) {
#pragma unroll
    for (int i = 0; i < 8; ++i) { const int k = (lane >> 4) + 4 * (8 * half + i); u32x2 w; w.x = cvt_pk_bf16(v[i][0], v[i][1]); w.y = cvt_pk_bf16(v[i][2], v[i][3]);
        *(LAS u32x2*)(scr + k * TRP + (lane & 15) * 4) = w; }
}
__device__ __forceinline__ void tr_flush(bf16* WT, int K, int k0, int d0, int kind, const LAS bf16* scr, int lane) {
    typedef short v4i16_t __attribute__((ext_vector_type(4)));
    const int g = lane >> 4, i16 = lane & 15, q = (lane >> 2) & 3, pp = lane & 3;
#pragma unroll
    for (int nb = 0; nb < 4; ++nb) { const int lc = 16 * nb + i16;
        const int r = (kind == 2) ? ((lc < 32) ? ((lc >> 2) * 8 + (lc & 3)) : (((lc - 32) >> 2) * 8 + 4 + (lc & 3))) : lc;
#pragma unroll
        for (int j = 0; j < 2; ++j) { const int kc = 8 * (g + 4 * j);
            const LAS bf16* a0 = scr + (kc + q) * TRP + 16 * nb + 4 * pp;
            const v4i16_t lo = __builtin_amdgcn_ds_read_tr16_b64_v4i16((LAS v4i16_t*)a0);
            const v4i16_t hi = __builtin_amdgcn_ds_read_tr16_b64_v4i16((LAS v4i16_t*)(a0 + 4 * TRP));
            u32x4 o; o.x = (unsigned)(unsigned short)lo[0] | ((unsigned)(unsigned short)lo[1] << 16); o.y = (unsigned)(unsigned short)lo[2] | ((unsigned)(unsigned short)lo[3] << 16);
            o.z = (unsigned)(unsigned short)hi[0] | ((unsigned)(unsigned short)hi[1] << 16); o.w = (unsigned)(unsigned short)hi[2] | ((unsigned)(unsigned short)hi[3] << 16);
            *(u32x4*)(WT + (size_t)(d0 + r) * K + k0 + kc) = o; } }
}
__device__ __forceinline__ void tr_flush8(unsigned char* WT, int K, int k0, int d0, int kind, const LAS bf16* scr, int lane) {
    typedef short v4i16_t __attribute__((ext_vector_type(4)));
    const int g = lane >> 4, i16 = lane & 15, q = (lane >> 2) & 3, pp = lane & 3;
#pragma unroll
    for (int nb = 0; nb < 4; ++nb) { const int lc = 16 * nb + i16;
        const int r = (kind == 2) ? ((lc < 32) ? ((lc >> 2) * 8 + (lc & 3)) : (((lc - 32) >> 2) * 8 + 4 + (lc & 3))) : lc;
        const LAS bf16* a0 = scr + (16 * g + q) * TRP + 16 * nb + 4 * pp; unsigned o[4];
#pragma unroll
        for (int j = 0; j < 4; ++j) { const v4i16_t v = __builtin_amdgcn_ds_read_tr16_b64_v4i16((LAS v4i16_t*)(a0 + 4 * j * TRP));
            o[j] = pk4_fp8(bf2f((unsigned short)v[0]) * 64.f, bf2f((unsigned short)v[1]) * 64.f, bf2f((unsigned short)v[2]) * 64.f, bf2f((unsigned short)v[3]) * 64.f); }
        *(u32x4*)(WT + (size_t)(d0 + r) * K + k0 + 16 * g) = (u32x4){o[0], o[1], o[2], o[3]}; }
}
struct TrItem { const float* W; bf16* WT; int N, k0, d0, kind; bool fp8; };
__device__ __forceinline__ bool tr_decode(const Args& a, int it, TrItem& t) {
    constexpr int I_IN = (DM / 64) * (NPROJ / 64), I_SQ = (DM / 64) * (DM / 64), I_GU = (DM / 64) * (4096 / 64), I_DN = I_SQ;
    constexpr int NITEMS = I_IN + 3 * I_SQ + NE * I_GU + NE * I_DN;
    if (it >= NITEMS) return false;
    int r = it;
    if (r < I_IN) { constexpr int nblk = NPROJ / 64; t = TrItem{a.in[I_WIN], WSP(bf16, WS_WT_IN), 15392, 64 * (r / nblk), 64 * (r % nblk), 1, false}; return true; } r -= I_IN;
    if (r < I_SQ) { t = TrItem{a.in[I_WBS], WSP(bf16, WS_WT_BS), DM, 64 * (r / 32), 64 * (r % 32), 0, false}; return true; } r -= I_SQ;
    if (r < I_SQ) { t = TrItem{a.in[I_WBA], WSP(bf16, WS_WT_BA), DM, 64 * (r / 32), 64 * (r % 32), 0, false}; return true; } r -= I_SQ;
    if (r < I_SQ) { t = TrItem{a.in[I_WOUT], WSP(bf16, WS_WT_OUT), DM, 64 * (r / 32), 64 * (r % 32), 0, false}; return true; } r -= I_SQ;
    if (r < NE * I_GU) { const int e = r / I_GU, q = r % I_GU; t = TrItem{a.in[I_WGU] + (size_t)e * DM * 4096, (bf16*)(WSP(unsigned char, WS_WT_GU) + (size_t)e * 4096 * DM), 4096, 64 * (q / 64), 64 * (q % 64), 2, true}; return true; } r -= NE * I_GU;
    { const int e = r / I_DN, q = r % I_DN; t = TrItem{a.in[I_WDN] + (size_t)e * DM * DM, (bf16*)(WSP(unsigned char, WS_WT_DN) + (size_t)e * DM * DM), DM, 64 * (q / 32), 64 * (q % 32), 0, true}; return true; }
}
__device__ __forceinline__ void tr_all(const Args& a, LAS bf16* scr, int gw, int NGW, int lane) {
    TrItem cur; if (!tr_decode(a, gw, cur)) return;
    bool zc; const float* sc = tr_src(cur.W, cur.N, cur.k0, cur.d0, cur.kind, lane, zc);
    f32x4 v0[8], v1[8];
    tr_load8(sc, cur.N, zc, 0, v0);
    for (int it = gw;; ) {
        tr_load8(sc, cur.N, zc, 1, v1);
        tr_put8(v0, 0, scr, lane);
        const int itn = it + NGW; TrItem nxt; const bool more = tr_decode(a, itn, nxt);
        bool zn = zc; const float* sn = sc; if (more) sn = tr_src(nxt.W, nxt.N, nxt.k0, nxt.d0, nxt.kind, lane, zn);
        if (more) tr_load8(sn, nxt.N, zn, 0, v0);
        tr_put8(v1, 1, scr, lane);
        if (cur.fp8) tr_flush8((unsigned char*)cur.WT, DM, cur.k0, cur.d0, cur.kind, scr, lane); else tr_flush(cur.WT, DM, cur.k0, cur.d0, cur.kind, scr, lane);
        if (!more) break;
        cur = nxt; sc = sn; zc = zn; it = itn;
    }
}
__device__ __forceinline__ void sincos_acc(float angf, float& s_out, float& c_out) {
    const double ang = (double)angf; const double twopi = 6.283185307179586476925, inv2pi = 0.159154943091895335769;
    double q = ang * inv2pi; q = q - (double)(long long)(q + 0.5);
    const double r = q * twopi * 0.25, r2 = r * r;
    double s = r * (1.0 + r2 * (-1.0 / 6 + r2 * (1.0 / 120 + r2 * (-1.0 / 5040 + r2 * (1.0 / 362880 + r2 * (-1.0 / 39916800 + r2 * (1.0 / 6227020800.0)))))));
    double c = 1.0 + r2 * (-0.5 + r2 * (1.0 / 24 + r2 * (-1.0 / 720 + r2 * (1.0 / 40320 + r2 * (-1.0 / 3628800 + r2 * (1.0 / 479001600.0))))));
    double s2 = 2 * s * c, c2 = c * c - s * s; s = 2 * s2 * c2; c = c2 * c2 - s2 * s2;
    s_out = (float)s; c_out = (float)c;
}
__device__ __forceinline__ void rms_row_to_bf16(const float* xrow, const float* g, const float* scv, const float* shv, bf16* orow, int lane, float eps) {
    f32x4 v[8]; float s = 0.f;
#pragma unroll
    for (int j = 0; j < 8; ++j) { v[j] = *((const f32x4*)xrow + lane + 64 * j); s += (v[j].x * v[j].x + v[j].y * v[j].y) + (v[j].z * v[j].z + v[j].w * v[j].w); }
    const float rstd = 1.0f / sqrtf(wave_sum(s) * (1.0f / DM) + eps);
#pragma unroll
    for (int j = 0; j < 8; ++j) { const int o4 = lane + 64 * j; const f32x4 gg = *((const f32x4*)g + o4), s1 = *((const f32x4*)scv + o4), s0 = *((const f32x4*)shv + o4);
        const f32x4 y = v[j] * rstd * gg * (s1 + 1.0f) + s0;
        u32x2 w; w.x = pk2(y.x, y.y); w.y = pk2(y.z, y.w); *((u32x2*)orow + o4) = w; }
}
__device__ __forceinline__ void ph_prep(const Args& a, LAS unsigned char* lds, int vcu, int G) {
    const int tid = threadIdx.x, lane = tid & 63, wave = __builtin_amdgcn_readfirstlane(tid >> 6);
    const int gw = vcu * NWAVES + wave, NGW = G * NWAVES, gt = vcu * NTHR + tid, NGT = G * NTHR;
    const float* mod = WSP(float, WS_MOD);
    { float* rope = WSP(float, WS_ROPE);
      const float invf[8] = {1.0f, 0.19392274f, 0.03760603f, 0.0072926646f, 0.0014142136f, 0.0002742482f, 5.3182957e-05f, 1.0313385e-05f};
      for (int i = gt; i < SEQ * 8; i += NGT) { const int pos = i >> 3, j = i & 7; float fr_ = 1.0f;
#pragma unroll
          for (int q = 0; q < 8; ++q) fr_ = (j == q) ? invf[q] : fr_;
          const float ang = (float)pos * fr_; float s, c; sincos_acc(ang, s, c); rope[pos * 16 + j] = c; rope[pos * 16 + 8 + j] = s; } }
    { float* wr = WSP(float, WS_WR); const float* Wr = a.in[I_WR]; const float* g = a.in[I_GPREFFN];
      for (int i = gt; i < NB * DM * NE; i += NGT) { const int b = i / (DM * NE), r = i % (DM * NE), k = r / NE; wr[i] = g[k] * (1.0f + mod[b * 12288 + 8192 + k]) * Wr[r]; }
      if (vcu == 0 && tid < NB * NE) { const int b = tid / NE, e = tid % NE; float s = 0.f; for (int k = 0; k < DM; ++k) s += mod[b * 12288 + 6144 + k] * Wr[k * NE + e];
          ((float*)(a.ws + WS_MOD * MiB + MOD_CB))[tid] = s + a.in[I_BR][e]; } }
    { const float* x = a.in[I_X]; bf16* H = WSP(bf16, WS_H); const float* g = a.in[I_GPREMIX];
      for (int m = gw; m < MT; m += NGW) { const int b = m / SEQ; rms_row_to_bf16(x + (size_t)m * DM, g, mod + b * 12288 + 2048, mod + b * 12288, H + (size_t)m * DM, lane, 1e-6f); } }
    tr_all(a, (LAS bf16*)(lds + wave * 16384), gw, NGW, lane);
}

__device__ __forceinline__ void ph_conv(const Args& a, int vcu, int G) {
    const int gt = vcu * NTHR + threadIdx.x, NGT = G * NTHR;
    { const bf16* X = WSP(bf16, WS_XBC); bf16* Y = WSP(bf16, WS_XBCC); const float* cw = a.in[I_CONVW]; const float* cbias = a.in[I_CONVB];
      for (int it = gt; it < (XBCW / 8) * (MT / 64); it += NGT) { const int cg = it % (XBCW / 8), seg = it / (XBCW / 8), c0 = cg * 8, t0 = seg * 64;
          float w[4][8], bb[8];
#pragma unroll
          for (int k = 0; k < 4; ++k) { const f32x4 w0 = *(const f32x4*)(cw + k * XBCW + c0), w1 = *(const f32x4*)(cw + k * XBCW + c0 + 4);
#pragma unroll
              for (int q = 0; q < 4; ++q) { w[k][q] = w0[q]; w[k][4 + q] = w1[q]; } }
          { const f32x4 b0 = *(const f32x4*)(cbias + c0), b1 = *(const f32x4*)(cbias + c0 + 4);
#pragma unroll
            for (int q = 0; q < 4; ++q) { bb[q] = b0[q]; bb[4 + q] = b1[q]; } }
          float hs[3][8];
          const bool seqstart = (t0 % SEQ) == 0;
#pragma unroll
          for (int r = 0; r < 3; ++r) { u32x4 v = {0u, 0u, 0u, 0u}; if (!seqstart) v = *(const u32x4*)(X + (size_t)(t0 - 3 + r) * XBCW + c0);
              hs[r][0] = bflo(v.x); hs[r][1] = bfhi(v.x); hs[r][2] = bflo(v.y); hs[r][3] = bfhi(v.y); hs[r][4] = bflo(v.z); hs[r][5] = bfhi(v.z); hs[r][6] = bflo(v.w); hs[r][7] = bfhi(v.w); }
#pragma unroll 4
          for (int t = 0; t < 64; ++t) { const u32x4 v = *(const u32x4*)(X + (size_t)(t0 + t) * XBCW + c0);
              float xc[8] = {bflo(v.x), bfhi(v.x), bflo(v.y), bfhi(v.y), bflo(v.z), bfhi(v.z), bflo(v.w), bfhi(v.w)}; float y[8];
#pragma unroll
              for (int q = 0; q < 8; ++q) { const float s = bb[q] + w[0][q] * hs[0][q] + w[1][q] * hs[1][q] + w[2][q] * hs[2][q] + w[3][q] * xc[q]; y[q] = siluf_(s); hs[0][q] = hs[1][q]; hs[1][q] = hs[2][q]; hs[2][q] = xc[q]; }
              u32x4 o; o.x = pk2(y[0], y[1]); o.y = pk2(y[2], y[3]); o.z = pk2(y[4], y[5]); o.w = pk2(y[6], y[7]);
              *(u32x4*)(Y + (size_t)(t0 + t) * XBCW + c0) = o; } } }
    { const float* dr = WSP(float, WS_DTRAW); float* dt = WSP(float, WS_DT); const float* bias = a.in[I_DTBIAS];
      for (int i = gt; i < MT * 32; i += NGT) { const float x = dr[i] + bias[i & 31]; dt[i] = (x > 20.f) ? x : log1pf(__expf(x)); } }
    { const float* rope = WSP(float, WS_ROPE);
      for (int it = gt; it < MT * 32 * 2; it += NGT) { const int which = it / (MT * 32), r = it % (MT * 32), t = r >> 5, hd = r & 31; bf16* p = (which ? WSP(bf16, WS_K) : WSP(bf16, WS_Q)) + (size_t)t * DM + hd * 64;
          const u32x4 v1 = *(const u32x4*)p, v2 = *(const u32x4*)(p + 8); const float* rp = rope + (t % SEQ) * 16;
          const f32x4 c0 = *(const f32x4*)rp, c1 = *(const f32x4*)(rp + 4), s0 = *(const f32x4*)(rp + 8), s1 = *(const f32x4*)(rp + 12);
          const float x1[8] = {bflo(v1.x), bfhi(v1.x), bflo(v1.y), bfhi(v1.y), bflo(v1.z), bfhi(v1.z), bflo(v1.w), bfhi(v1.w)};
          const float x2[8] = {bflo(v2.x), bfhi(v2.x), bflo(v2.y), bfhi(v2.y), bflo(v2.z), bfhi(v2.z), bflo(v2.w), bfhi(v2.w)};
          const float cc[8] = {c0[0], c0[1], c0[2], c0[3], c1[0], c1[1], c1[2], c1[3]}, ss[8] = {s0[0], s0[1], s0[2], s0[3], s1[0], s1[1], s1[2], s1[3]};
          float y1[8], y2[8];
#pragma unroll
          for (int q = 0; q < 8; ++q) { y1[q] = x1[q] * cc[q] - x2[q] * ss[q]; y2[q] = x2[q] * cc[q] + x1[q] * ss[q]; }
          u32x4 o1, o2; o1.x = pk2(y1[0], y1[1]); o1.y = pk2(y1[2], y1[3]); o1.z = pk2(y1[4], y1[5]); o1.w = pk2(y1[6], y1[7]);
          o2.x = pk2(y2[0], y2[1]); o2.y = pk2(y2[2], y2[3]); o2.z = pk2(y2[4], y2[5]); o2.w = pk2(y2[6], y2[7]);
          *(u32x4*)p = o1; *(u32x4*)(p + 8) = o2; } }
}
constexpr int SP = 136;
#define SSD_FRAG(base, row, k0) (*(const LAS bf16x8*)((base) + (row) * SP + (k0)))
template <bool ALSO_T> __device__ __forceinline__ void ssd_stage128(const bf16* X, int t0, int col0, LAS bf16* dst, LAS bf16* dstT, int tid) {
#pragma unroll
    for (int i = 0; i < 4; ++i) { const int q = tid + NTHR * i, row = q >> 4, ch = q & 15;
        const u32x4 v = *(const u32x4*)(X + (size_t)(t0 + row) * XBCW + col0 + ch * 8);
        *(LAS u32x4*)(dst + row * SP + ch * 8) = v;
        if constexpr (ALSO_T) { const unsigned w[4] = {v.x, v.y, v.z, v.w};
#pragma unroll
            for (int j = 0; j < 4; ++j) { dstT[(ch * 8 + 2 * j) * SP + row] = (bf16)(w[j] & 0xffffu); dstT[(ch * 8 + 2 * j + 1) * SP + row] = (bf16)(w[j] >> 16); } } }
}
__device__ __forceinline__ void ph_ssd1(const Args& a, LAS unsigned char* lds, int first, int stride) {
    const int tid = threadIdx.x, lane = tid & 63, w = __builtin_amdgcn_readfirstlane(tid >> 6), l15 = lane & 15, lq = lane >> 4;
    LAS bf16* R1 = (LAS bf16*)lds;
    LAS bf16* R2 = (LAS bf16*)(lds + 34816);
    LAS bf16* R3 = (LAS bf16*)(lds + 69632);
    LAS float* acs = (LAS float*)(lds + 104448);
    LAS float* dts = (LAS float*)(lds + 108544);
    const bf16* X = WSP(bf16, WS_XBCC); const float* DT = WSP(float, WS_DT); float* ACS = WSP(float, WS_ACS); float* YD = WSP(float, WS_YDIAG); float* ST = WSP(float, WS_STATES);
    for (int u = first; u < NB * 32 * 4; u += stride) {
        const int g = u & 3, bc = u >> 2, t0 = bc * 128;
        ssd_stage128<false>(X, t0, 2560 + g * 128, R1, nullptr, tid);
        ssd_stage128<true>(X, t0, 2048 + g * 128, R2, R3, tid);
        { const int h = g * 8 + w; const float Ah = -__expf(a.in[I_ALOG][h]);
          const float d0 = DT[(size_t)(t0 + 2 * lane) * 32 + h], d1 = DT[(size_t)(t0 + 2 * lane + 1) * 32 + h];
          const float a0 = d0 * Ah, a1 = d1 * Ah; float s = a0 + a1;
#pragma unroll
          for (int o = 1; o < 64; o <<= 1) { const float t = __shfl_up(s, o); if (lane >= o) s += t; }
          acs[w * 128 + 2 * lane] = s - a1; acs[w * 128 + 2 * lane + 1] = s; dts[w * 128 + 2 * lane] = d0; dts[w * 128 + 2 * lane + 1] = d1;
          float* ag = ACS + ((size_t)bc * 32 + h) * 128; ag[2 * lane] = s - a1; ag[2 * lane + 1] = s; }
        __syncthreads();
        f32x4 S[8];
#pragma unroll
        for (int mt = 0; mt < 8; ++mt) { S[mt] = (f32x4){0.f, 0.f, 0.f, 0.f};
#pragma unroll
            for (int ks = 0; ks < 4; ++ks) S[mt] = __builtin_amdgcn_mfma_f32_16x16x32_bf16(SSD_FRAG(R2, 16 * mt + l15, 32 * ks + 8 * lq), SSD_FRAG(R1, 16 * w + l15, 32 * ks + 8 * lq), S[mt], 0, 0, 0); }
        __syncthreads();
        LAS bf16* G = R1; LAS bf16* Xt = R2; LAS bf16* Xwt = R2 + 64 * SP;
#pragma unroll 1
        for (int hh = 0; hh < 8; ++hh) {
            const int h = g * 8 + hh; const LAS float* ac = acs + hh * 128; const float aend = ac[127];
#pragma unroll
            for (int i = 0; i < 2; ++i) { const int q = tid + NTHR * i, l = q >> 3, ch = q & 7;
                const u32x4 v = *(const u32x4*)(X + (size_t)(t0 + l) * XBCW + h * 64 + ch * 8); const float dl = dts[hh * 128 + l], wl = dl * __expf(aend - ac[l]);
                const float xv[8] = {bflo(v.x), bfhi(v.x), bflo(v.y), bfhi(v.y), bflo(v.z), bfhi(v.z), bflo(v.w), bfhi(v.w)};
#pragma unroll
                for (int j = 0; j < 8; ++j) { Xt[(ch * 8 + j) * SP + l] = (bf16)f2bf(xv[j] * dl); Xwt[(ch * 8 + j) * SP + l] = (bf16)f2bf(xv[j] * wl); } }
            { const int l = 16 * w + l15; const float al = ac[l];
#pragma unroll
              for (int mt = 0; mt < 8; ++mt) { float gv[4];
#pragma unroll
                  for (int r = 0; r < 4; ++r) { const int s = 16 * mt + 4 * lq + r; gv[r] = (s <= l) ? S[mt][r] * __expf(al - ac[s]) : 0.f; }
                  u32x2 pk; pk.x = pk2(gv[0], gv[1]); pk.y = pk2(gv[2], gv[3]);
                  *(LAS u32x2*)(G + l * SP + 16 * mt + 4 * lq) = pk; } }
            __syncthreads();
#pragma unroll
            for (int pt = 0; pt < 4; ++pt) { f32x4 acc = {0.f, 0.f, 0.f, 0.f};
#pragma unroll
                for (int ks = 0; ks < 4; ++ks) acc = __builtin_amdgcn_mfma_f32_16x16x32_bf16(SSD_FRAG(Xt, 16 * pt + l15, 32 * ks + 8 * lq), SSD_FRAG(G, 16 * w + l15, 32 * ks + 8 * lq), acc, 0, 0, 0);
                *(f32x4*)(YD + (size_t)(t0 + 16 * w + l15) * DM + h * 64 + 16 * pt + 4 * lq) = acc; }
#pragma unroll
            for (int pt = 0; pt < 4; ++pt) { f32x4 acc = {0.f, 0.f, 0.f, 0.f};
#pragma unroll
                for (int ks = 0; ks < 4; ++ks) acc = __builtin_amdgcn_mfma_f32_16x16x32_bf16(SSD_FRAG(R3, 16 * w + l15, 32 * ks + 8 * lq), SSD_FRAG(Xwt, 16 * pt + l15, 32 * ks + 8 * lq), acc, 0, 0, 0);
                *(f32x4*)(ST + (((size_t)bc * 32 + h) * 64 + 16 * pt + l15) * 128 + 16 * w + 4 * lq) = acc; }
            __syncthreads();
        }
    }
}
__device__ __forceinline__ void ph_ssd2(const Args& a, int vcu, int G) {
    const int gt = vcu * NTHR + threadIdx.x, NGT = G * NTHR; float* ST = WSP(float, WS_STATES); const float* ACS = WSP(float, WS_ACS);
    for (int it = gt; it < NB * 32 * 2048; it += NGT) { const int q = it & 2047, bh = it >> 11, b = bh >> 5, h = bh & 31;
        f32x4 run = {0.f, 0.f, 0.f, 0.f};
#pragma unroll 4
        for (int c = 0; c < 32; ++c) { const size_t bc = (size_t)b * 32 + c; f32x4* p = (f32x4*)(ST + (bc * 32 + h) * 8192) + q; const f32x4 s = *p; const float dec = __expf(ACS[(bc * 32 + h) * 128 + 127]);
            *p = run; run = run * dec + s; } }
}
__device__ __forceinline__ void ph_ssd3(const Args& a, LAS unsigned char* lds, int first, int stride) {
    const int tid = threadIdx.x, lane = tid & 63, w = __builtin_amdgcn_readfirstlane(tid >> 6), l15 = lane & 15, lq = lane >> 4;
    LAS bf16* Cs = (LAS bf16*)lds; LAS bf16* Pv = (LAS bf16*)(lds + 34816); LAS float* acs = (LAS float*)(lds + 104448);
    const bf16* X = WSP(bf16, WS_XBCC); const float* ACS = WSP(float, WS_ACS); const float* YD = WSP(float, WS_YDIAG); const float* ST = WSP(float, WS_STATES);
    const bf16* Z = WSP(bf16, WS_Z); bf16* YB = WSP(bf16, WS_YBUF); const float* dskip = a.in[I_DSKIP]; const float* nw = a.in[I_SSDNW];
    for (int u = first; u < NB * 32 * 4; u += stride) {
        const int g = u & 3, bc = u >> 2, t0 = bc * 128;
        ssd_stage128<false>(X, t0, 2560 + g * 128, Cs, nullptr, tid);
#pragma unroll
        for (int i = 0; i < 2; ++i) { const int q = tid + NTHR * i; acs[q] = ACS[((size_t)bc * 32 + g * 8 + (q >> 7)) * 128 + (q & 127)]; }
        __syncthreads();
        const int l = 16 * w + l15; const size_t t = (size_t)t0 + l; float ss = 0.f;
#pragma unroll 1
        for (int hh = 0; hh < 8; ++hh) {
            const int h = g * 8 + hh;
#pragma unroll
            for (int i = 0; i < 4; ++i) { const int q = tid + NTHR * i, p = q >> 5, n4 = (q & 31) * 4;
                const f32x4 v = *(const f32x4*)(ST + ((size_t)bc * 32 + h) * 8192 + p * 128 + n4); u32x2 pk; pk.x = pk2(v[0], v[1]); pk.y = pk2(v[2], v[3]);
                *(LAS u32x2*)(Pv + p * SP + n4) = pk; }
            __syncthreads();
            const float ea = __expf(acs[hh * 128 + l]), dsk = dskip[h];
#pragma unroll
            for (int pt = 0; pt < 4; ++pt) { f32x4 acc = {0.f, 0.f, 0.f, 0.f};
#pragma unroll
                for (int ks = 0; ks < 4; ++ks) acc = __builtin_amdgcn_mfma_f32_16x16x32_bf16(SSD_FRAG(Pv, 16 * pt + l15, 32 * ks + 8 * lq), SSD_FRAG(Cs, 16 * w + l15, 32 * ks + 8 * lq), acc, 0, 0, 0);
                const int col = h * 64 + 16 * pt + 4 * lq;
                const f32x4 yd = *(const f32x4*)(YD + t * DM + col); const u32x2 xs = *(const u32x2*)(X + t * XBCW + col), zz = *(const u32x2*)(Z + t * DM + col);
                const float xv[4] = {bflo(xs.x), bfhi(xs.x), bflo(xs.y), bfhi(xs.y)}, zv[4] = {bflo(zz.x), bfhi(zz.x), bflo(zz.y), bfhi(zz.y)}; float uu[4];
#pragma unroll
                for (int r = 0; r < 4; ++r) { const float y = yd[r] + ea * acc[r] + dsk * xv[r]; uu[r] = y * siluf_(zv[r]); ss += uu[r] * uu[r]; }
                u32x2 pk; pk.x = pk2(uu[0], uu[1]); pk.y = pk2(uu[2], uu[3]); *(u32x2*)(YB + t * DM + col) = pk; }
            __syncthreads();
        }
        ss += __shfl_xor(ss, 16); ss += __shfl_xor(ss, 32);
        const float rstd = 1.0f / sqrtf(ss * (1.0f / 512.0f) + 1e-5f);
        VM_WAIT();
#pragma unroll 1
        for (int hh = 0; hh < 8; ++hh)
#pragma unroll
            for (int pt = 0; pt < 4; ++pt) { const int col = (g * 8 + hh) * 64 + 16 * pt + 4 * lq; u32x2* p = (u32x2*)(YB + t * DM + col); const u32x2 v = *p; const f32x4 wv = *(const f32x4*)(nw + col);
                u32x2 pk; pk.x = pk2(bflo(v.x) * rstd * wv[0], bfhi(v.x) * rstd * wv[1]); pk.y = pk2(bflo(v.y) * rstd * wv[2], bfhi(v.y) * rstd * wv[3]); *p = pk; }
        __syncthreads();
    }
}
__device__ __forceinline__ void ph_attn_combine(const Args& a, int vcu, int G) {
    const int tid = threadIdx.x, lane = tid & 63, wave = __builtin_amdgcn_readfirstlane(tid >> 6), gw = vcu * NWAVES + wave, NGW = G * NWAVES;
    float d1 = a.in[I_LQ1][lane] * a.in[I_LK1][lane], d2 = a.in[I_LQ2][lane] * a.in[I_LK2][lane]; d1 = wave_sum(d1); d2 = wave_sum(d2);
    const float lam = __expf(d1) - __expf(d2) + 0.2f;
    const bf16* OA = WSP(bf16, WS_OATT); bf16* OF = WSP(bf16, WS_OFIN); const float* sw = a.in[I_SUBLN];
    const int head = lane >> 2, dq = (lane & 3) * 32;
    for (int m = gw; m < MT; m += NGW) { const bf16* p0 = OA + (size_t)m * 4096 + (2 * head) * 128 + dq; const bf16* p1 = p0 + 128; float d[32]; float ss = 0.f;
#pragma unroll
        for (int i = 0; i < 4; ++i) { const u32x4 x = *(const u32x4*)(p0 + 8 * i), y = *(const u32x4*)(p1 + 8 * i);
            const unsigned xa[4] = {x.x, x.y, x.z, x.w}, ya[4] = {y.x, y.y, y.z, y.w};
#pragma unroll
            for (int j = 0; j < 4; ++j) { const float v0 = bflo(xa[j]) - lam * bflo(ya[j]), v1 = bfhi(xa[j]) - lam * bfhi(ya[j]); d[8 * i + 2 * j] = v0; d[8 * i + 2 * j + 1] = v1; ss += v0 * v0 + v1 * v1; } }
        ss += __shfl_xor(ss, 1); ss += __shfl_xor(ss, 2);
        const float rstd = 0.8f / sqrtf(ss * (1.0f / 128.0f) + 1e-5f);
        bf16* o = OF + (size_t)m * DM + head * 128 + dq;
#pragma unroll
        for (int i = 0; i < 4; ++i) { const f32x4 w0 = *(const f32x4*)(sw + dq + 8 * i), w1 = *(const f32x4*)(sw + dq + 8 * i + 4);
            u32x4 pk; pk.x = pk2(d[8 * i] * rstd * w0[0], d[8 * i + 1] * rstd * w0[1]); pk.y = pk2(d[8 * i + 2] * rstd * w0[2], d[8 * i + 3] * rstd * w0[3]);
            pk.z = pk2(d[8 * i + 4] * rstd * w1[0], d[8 * i + 5] * rstd * w1[1]); pk.w = pk2(d[8 * i + 6] * rstd * w1[2], d[8 * i + 7] * rstd * w1[3]);
            *(u32x4*)(o + 8 * i) = pk; } }
}
__device__ __forceinline__ void ph_rows1(const Args& a, int vcu, int G) {
    const int tid = threadIdx.x, lane = tid & 63, wave = __builtin_amdgcn_readfirstlane(tid >> 6), gw = vcu * NWAVES + wave, NGW = G * NWAVES;
    const float* mod = WSP(float, WS_MOD); const float* x = a.in[I_X]; const float* mix = WSP(float, WS_MIX); float* X1 = WSP(float, WS_X1); unsigned char* H2 = WSP(unsigned char, WS_H2); float* RS = WSP(float, WS_RSTD);
    const float* gpm = a.in[I_GPOSTMIX]; const float* gpf = a.in[I_GPREFFN];
    for (int m = gw; m < MT; m += NGW) { const int b = m / SEQ; const float* mb = mod + b * 12288;
        f32x4 v[8]; float s = 0.f;
#pragma unroll
        for (int j = 0; j < 8; ++j) { v[j] = *((const f32x4*)(mix + (size_t)m * DM) + lane + 64 * j); s += (v[j].x * v[j].x + v[j].y * v[j].y) + (v[j].z * v[j].z + v[j].w * v[j].w); }
        const float rstdm = 1.0f / sqrtf(wave_sum(s) * (1.0f / DM) + 1e-6f); float s1 = 0.f;
#pragma unroll
        for (int j = 0; j < 8; ++j) { const int o4 = lane + 64 * j; const f32x4 xx = *((const f32x4*)(x + (size_t)m * DM) + o4), gg = *((const f32x4*)gpm + o4), gt = *((const f32x4*)(mb + 4096) + o4);
            v[j] = xx + gt * (v[j] * rstdm * gg); *((f32x4*)(X1 + (size_t)m * DM) + o4) = v[j]; s1 += (v[j].x * v[j].x + v[j].y * v[j].y) + (v[j].z * v[j].z + v[j].w * v[j].w); }
        const float rstd1 = 1.0f / sqrtf(wave_sum(s1) * (1.0f / DM) + 1e-6f);
        if (lane == 0) RS[m] = rstd1;
#pragma unroll
        for (int j = 0; j < 8; ++j) { const int o4 = lane + 64 * j; const f32x4 gg = *((const f32x4*)gpf + o4), sc = *((const f32x4*)(mb + 8192) + o4), sh = *((const f32x4*)(mb + 6144) + o4);
            const f32x4 y = v[j] * rstd1 * gg * (sc + 1.0f) + sh; *((unsigned*)(H2 + (size_t)m * DM) + o4) = pk4_fp8(y.x, y.y, y.z, y.w); } }
}
__device__ __forceinline__ void ph_router(const Args& a, LAS unsigned char* lds, int first, int stride) {
    const int tid = threadIdx.x, lane = tid & 63, w = __builtin_amdgcn_readfirstlane(tid >> 6), r32 = lane & 31, hi = lane >> 5;
    LAS float* part = (LAS float*)lds;
    LAS float* lg = (LAS float*)(lds + 8 * 32 * 33 * 4);
    const float* X1 = WSP(float, WS_X1); const float* WR = WSP(float, WS_WR); const float* RS = WSP(float, WS_RSTD); const float* CB = (const float*)(a.ws + WS_MOD * MiB + MOD_CB);
    unsigned* cnt = (unsigned*)(a.ws + WS_CTL * MiB) + CW_CNT;
    int* ltok = (int*)(a.ws + WS_LISTS * MiB); float* lw = (float*)(a.ws + WS_LISTS * MiB + LIST_STRIDE); int* ldst = (int*)(a.ws + WS_LISTS * MiB + 2 * LIST_STRIDE);
    for (int tile = first; tile < MT / 32; tile += stride) {
        const int tok0 = tile * 32, b = tok0 / SEQ; const int kb = w * 256;
        const float* xr = X1 + (size_t)(tok0 + r32) * DM + kb; const float* wb = WR + ((size_t)b * DM + kb) * NE;
        f32x16 acc = {};
#pragma unroll 4
        for (int q = 0; q < 64; ++q) { const f32x4 xv = *(const f32x4*)(xr + 4 * q);
            const float a0 = hi ? xv[1] : xv[0], a1 = hi ? xv[3] : xv[2];
            const float b0 = wb[(4 * q + hi) * NE + r32], b1 = wb[(4 * q + 2 + hi) * NE + r32];
            acc = __builtin_amdgcn_mfma_f32_32x32x2f32(a0, b0, acc, 0, 0, 0);
            acc = __builtin_amdgcn_mfma_f32_32x32x2f32(a1, b1, acc, 0, 0, 0); }
#pragma unroll
        for (int r = 0; r < 16; ++r) part[(w * 32 + (r & 3) + 8 * (r >> 2) + 4 * hi) * 33 + r32] = acc[r];
        __syncthreads();
#pragma unroll
        for (int i = 0; i < 2; ++i) { const int o = tid + NTHR * i, tk = o >> 5, e = o & 31; float s = 0.f;
#pragma unroll
            for (int ww = 0; ww < 8; ++ww) s += part[(ww * 32 + tk) * 33 + e];
            lg[tk * 33 + e] = s * RS[tok0 + tk] + CB[b * NE + e]; }
        __syncthreads();
        if (tid < 32) { const int tk = tok0 + tid; float v[4]; int ix[4]; unsigned used = 0u;
#pragma unroll
            for (int k = 0; k < 4; ++k) { float best = -__builtin_inff(); int bi = 0;
                for (int e = 0; e < NE; ++e) { const float x = lg[tid * 33 + e]; if (!((used >> e) & 1u) && x > best) { best = x; bi = e; } }
                v[k] = best; ix[k] = bi; used |= 1u << bi; }
            float p[4], sum = 0.f;
#pragma unroll
            for (int k = 0; k < 4; ++k) { p[k] = __expf(v[k] - v[0]); sum += p[k]; }
            const float inv = 1.0f / sum;
#pragma unroll
            for (int k = 0; k < 4; ++k) { const int e = ix[k]; const unsigned pos = __hip_atomic_fetch_add(cnt + 64 * e, 1u, RLX_AGENT);
                ltok[e * 16384 + pos] = tk; lw[e * 16384 + pos] = p[k] * inv; ldst[e * 16384 + pos] = tk * 4 + k; } }
        __syncthreads();
    }
}
__device__ __forceinline__ void ph_final(const Args& a, int vcu, int G) {
    const int tid = threadIdx.x, lane = tid & 63, wave = __builtin_amdgcn_readfirstlane(tid >> 6), gw = vcu * NWAVES + wave, NGW = G * NWAVES;
    const float* mod = WSP(float, WS_MOD); const float* X1 = WSP(float, WS_X1); const bf16* YS = WSP(bf16, WS_YS); const float* gp = a.in[I_GPOSTFFN];
    for (int m = gw; m < MT; m += NGW) { const int b = m / SEQ; const float* mb = mod + b * 12288;
        f32x4 f[8]; float s = 0.f;
#pragma unroll
        for (int j = 0; j < 8; ++j) { f[j] = (f32x4){0.f, 0.f, 0.f, 0.f};
#pragma unroll
            for (int k = 0; k < 4; ++k) { const u32x2 v = *((const u32x2*)(YS + ((size_t)m * 4 + k) * DM) + lane + 64 * j); f[j] += (f32x4){bflo(v.x), bfhi(v.x), bflo(v.y), bfhi(v.y)}; }
            s += (f[j].x * f[j].x + f[j].y * f[j].y) + (f[j].z * f[j].z + f[j].w * f[j].w); }
        const float rstd = 1.0f / sqrtf(wave_sum(s) * (1.0f / DM) + 1e-6f);
#pragma unroll
        for (int j = 0; j < 8; ++j) { const int o4 = lane + 64 * j; const f32x4 xx = *((const f32x4*)(X1 + (size_t)m * DM) + o4), gg = *((const f32x4*)gp + o4), gt = *((const f32x4*)(mb + 10240) + o4);
            *((f32x4*)(a.out + (size_t)m * DM) + o4) = xx + gt * (f[j] * rstd * gg); } }
}
__device__ __forceinline__ void moe_table(const Args& a, LAS unsigned char* lds) {
    LAS int* tab = (LAS int*)(lds + TAB_OFF); const unsigned* cnt = (const unsigned*)(a.ws + WS_CTL * MiB) + CW_CNT;
    __syncthreads();
    if (threadIdx.x < 32) tab[threadIdx.x] = (int)__hip_atomic_load(cnt + 64 * threadIdx.x, RLX_AGENT);
    __syncthreads();
    if (threadIdx.x == 0) { int s = 0; for (int e = 0; e < 32; ++e) { tab[32 + e] = s; s += (tab[e] + 255) >> 8; } tab[64] = s; }
    __syncthreads();
}

__global__ void __launch_bounds__(NTHR, 2) hybrid_fwd(Args a) {
    extern __shared__ __attribute__((aligned(16))) unsigned char lds_raw[];
    LAS unsigned char* lds = (LAS unsigned char*)lds_raw;
    volatile LAS unsigned* MISC = (volatile LAS unsigned*)(lds + MISC_OFF);
    const int tid = threadIdx.x; const int G = gridDim.x; const int bx = blockIdx.x;
    const int vcu = (G % 8 == 0) ? (bx % 8) * (G / 8) + bx / 8 : bx;
    for (int u = tid; u < (LDS_BYTES - MISC_OFF) / 4; u += NTHR) ((LAS unsigned*)(lds + MISC_OFF))[u] = 0u;
    __syncthreads();
    unsigned* ctl = (unsigned*)(a.ws + WS_CTL * MiB);
    XcdBarrier bar; bar.bar = ctl + CW_BAR; bar.x = 0; bar.st = nullptr;
    const int lo = a.ph_lo, hi = a.ph_hi;
    const bool fused = (hi - lo) > 1;
    if (fused) bar = xcd_barrier_post(ctl + CW_BAR, MISC + 8);
#define IN(k) (lo <= (k) && (k) < hi)
#define REPEAT(n, body) do { body; if constexpr ((n) > 1) { if (fused) xcd_barrier(bar); else __syncthreads(); body; } } while (0)
#define SEAM(k) do { if (IN(k) && IN((k) + 1)) xcd_barrier(bar); } while (0)

    if (IN(0)) { REPEAT(REP_MOD, ph_mod(a, lds)); } SEAM(0);
    if (IN(1)) { REPEAT(REP_PREP, ph_prep(a, lds, vcu, G)); } SEAM(1);
    if (IN(2)) {
        pg8::ProbDense P; P.init(WSP(bf16, WS_H), WSP(bf16, WS_WT_IN), MT, NPROJ, DM, G, bx);
        pg8::EpiInProj E{a.ws};
        REPEAT(REP_INPROJ, (pg8::gemm_phase<pg8::EpiInProj, pg8::ProbDense, true>(lds, P, E)));
    } SEAM(2);
    if (IN(3)) { ph_conv(a, vcu, G); } SEAM(3);
    if (IN(4)) {
        REPEAT(REP_SSD1, ph_ssd1(a, lds, bx, G));
        __syncthreads();
        REPEAT(REP_ATTN, att::attn_phase((char*)lds_raw, WSP(bf16, WS_Q), WSP(bf16, WS_K), WSP(bf16, WS_V), WSP(bf16, WS_OATT), bx, G));
    } SEAM(4);
    if (IN(5)) { ph_ssd2(a, vcu, G); REPEAT(REP_COMB, ph_attn_combine(a, vcu, G)); } SEAM(5);
    if (IN(6)) { REPEAT(REP_SSD3, ph_ssd3(a, lds, bx, G)); } SEAM(6);
    if (IN(7)) {
#define BR_BODY do { \
        { pg8::ProbDense P; P.init(WSP(bf16, WS_YBUF), WSP(bf16, WS_WT_BS), MT, DM, DM, G, bx); \
          pg8::EpiBr1 E{WSP(bf16, WS_SGS), WSP(float, WS_M1)}; \
          pg8::gemm_phase<pg8::EpiBr1, pg8::ProbDense, true>(lds, P, E); } \
        __syncthreads(); \
        { pg8::ProbDense P; P.init(WSP(bf16, WS_OFIN), WSP(bf16, WS_WT_BA), MT, DM, DM, G, bx); \
          pg8::EpiBr2 E{WSP(bf16, WS_SGA), WSP(float, WS_M1), WSP(bf16, WS_MERGED)}; \
          pg8::gemm_phase<pg8::EpiBr2, pg8::ProbDense, true>(lds, P, E); } } while (0)
        REPEAT(REP_BR, BR_BODY);
#undef BR_BODY
    } SEAM(7);
    if (IN(8)) {
        pg8::ProbDense P; P.init(WSP(bf16, WS_MERGED), WSP(bf16, WS_WT_OUT), MT, DM, DM, G, bx);
        pg8::EpiF32 E{WSP(float, WS_MIX), DM};
        REPEAT(REP_OUT, (pg8::gemm_phase<pg8::EpiF32, pg8::ProbDense, true>(lds, P, E)));
    } SEAM(8);
    if (IN(9)) { REPEAT(REP_ROWS1, ph_rows1(a, vcu, G)); } SEAM(9);
    if (IN(10)) { ph_router(a, lds, bx, G); } SEAM(10);
    if (IN(11)) {
        moe_table(a, lds);
        pg8::ProbMoE<true> P; P.A = (const char*)WSP(bf16, WS_H2); P.Bt = (const char*)WSP(bf16, WS_WT_GU); P.rb = DM; P.nN = 16; P.estride = (size_t)4096 * DM;
        P.list_tok = (const int*)(a.ws + WS_LISTS * MiB); P.tab = (const LAS int*)(lds + TAB_OFF); P.G = G; P.c = bx;
        pg8::EpiGateUp E{a.in[I_BGU], WSP(unsigned char, WS_ACT)};
        REPEAT(REP_GU, (pg8::gemm_phase<pg8::EpiGateUp, pg8::ProbMoE<true>, true, true, 127>(lds, P, E)));
    } SEAM(11);
    if (IN(12)) {
        moe_table(a, lds);
        pg8::ProbMoE<false> P; P.A = (const char*)WSP(bf16, WS_ACT); P.Bt = (const char*)WSP(bf16, WS_WT_DN); P.rb = DM; P.nN = 8; P.estride = (size_t)DM * DM;
        P.list_tok = nullptr; P.tab = (const LAS int*)(lds + TAB_OFF); P.G = G; P.c = bx;
        pg8::EpiDown E{a.in[I_BDN], (const int*)(a.ws + WS_LISTS * MiB + 2 * LIST_STRIDE), (const float*)(a.ws + WS_LISTS * MiB + LIST_STRIDE), (const LAS int*)(lds + TAB_OFF), WSP(bf16, WS_YS)};
        REPEAT(REP_DN, (pg8::gemm_phase<pg8::EpiDown, pg8::ProbMoE<false>, true, true, 127>(lds, P, E)));
    } SEAM(12);
    if (IN(13)) { REPEAT(REP_FINAL, ph_final(a, vcu, G)); }
#undef IN
#undef SEAM
#undef REPEAT
}

extern "C" void kernel_launch(void* const* d_in, const int* in_sizes, int n_in, void* d_out, int out_size, void* d_ws, size_t ws_size, hipStream_t stream) {
    static int grid = 0;
    if (grid == 0) {
        if (n_in != 29 || in_sizes[0] != MT * DM || out_size != MT * DM || ws_size < WS_END * MiB) {
            fprintf(stderr, "kernel_launch: unexpected shapes (n_in %d, in0 %d, out %d, ws %zu); nothing launched\n", n_in, n_in > 0 ? in_sizes[0] : -1, out_size, ws_size); grid = -1; return; }
        int dev = 0, cus = 0, per_cu = 0;
        if (hipGetDevice(&dev) != hipSuccess || hipDeviceGetAttribute(&cus, hipDeviceAttributeMultiprocessorCount, dev) != hipSuccess) { grid = -1; return; }
        if (hipFuncSetAttribute((const void*)hybrid_fwd, hipFuncAttributeMaxDynamicSharedMemorySize, LDS_BYTES) != hipSuccess) { fprintf(stderr, "kernel_launch: hipFuncSetAttribute failed\n"); grid = -1; return; }
        if (hipOccupancyMaxActiveBlocksPerMultiprocessor(&per_cu, (const void*)hybrid_fwd, NTHR, LDS_BYTES) != hipSuccess || per_cu < 1)
            fprintf(stderr, "kernel_launch: note: occupancy query reports %d workgroups per CU\n", per_cu);
        (void)hipGetLastError();
        grid = cus;
    }
    if (grid < 0) return;
    (void)hipMemsetAsync((char*)d_ws + WS_CTL * MiB, 0, CTL_ZERO_BYTES, stream);
    Args a{};
    for (int i = 0; i < 29; ++i) a.in[i] = (const float*)d_in[i];
    a.out = (float*)d_out; a.ws = (unsigned char*)d_ws;
#if MK_PER_PHASE
    for (int k = 0; k < NPH; ++k) { a.ph_lo = k; a.ph_hi = k + 1; hipLaunchKernelGGL(hybrid_fwd, dim3(grid), dim3(NTHR), LDS_BYTES, stream, a); }
#else
    a.ph_lo = 0; a.ph_hi = NPH;
    hipLaunchKernelGGL(hybrid_fwd, dim3(grid), dim3(NTHR), LDS_BYTES, stream, a);
#endif
    const hipError_t le = hipPeekAtLastError();
    if (le != hipSuccess) fprintf(stderr, "kernel_launch: launch failed: %s\n", hipGetErrorName(le));
}
```

```cpp
#include <hip/hip_runtime.h>
#include <cstdio>
#include <cstdint>

#define LAS __attribute__((address_space(3)))
#define GAS __attribute__((address_space(1)))
typedef unsigned short bf16;
typedef short bf16x8 __attribute__((ext_vector_type(8)));
typedef short s16x4 __attribute__((ext_vector_type(4)));
typedef float f32x2 __attribute__((ext_vector_type(2)));
typedef float f32x4 __attribute__((ext_vector_type(4)));
typedef float f32x16 __attribute__((ext_vector_type(16)));
typedef unsigned u32x2 __attribute__((ext_vector_type(2)));
typedef unsigned u32x4 __attribute__((ext_vector_type(4)));

#ifndef REP_MOD
#define REP_MOD 1
#endif
#ifndef REP_PREP
#define REP_PREP 1
#endif
#ifndef REP_INPROJ
#define REP_INPROJ 1
#endif
#ifndef REP_SSD1
#define REP_SSD1 1
#endif
#ifndef REP_ATTN
#define REP_ATTN 1
#endif
#ifndef REP_COMB
#define REP_COMB 1
#endif
#ifndef REP_SSD3
#define REP_SSD3 1
#endif
#ifndef REP_BR
#define REP_BR 1
#endif
#ifndef REP_OUT
#define REP_OUT 1
#endif
#ifndef REP_ROWS1
#define REP_ROWS1 1
#endif
#ifndef REP_GU
#define REP_GU 1
#endif
#ifndef REP_DN
#define REP_DN 1
#endif
#ifndef REP_FINAL
#define REP_FINAL 1
#endif

#ifndef KREP_GU
#define KREP_GU 1
#endif
#ifndef EREP_GU
#define EREP_GU 1
#endif
#ifndef KREP_DN
#define KREP_DN 1
#endif
#ifndef EREP_DN
#define EREP_DN 1
#endif
#ifndef KREP_IN
#define KREP_IN 1
#endif
#ifndef EREP_IN
#define EREP_IN 1
#endif
#ifndef MK_PER_PHASE
#define MK_PER_PHASE 0
#endif

constexpr int DM = 2048, NB = 4, SEQ = 4096, MT = NB * SEQ;
constexpr int NE = 32, TOPK = 4, NSLOT_ROWS = MT * TOPK + NE * 256;
constexpr int NPROJ_T = 61, NPROJ = NPROJ_T * 256;
constexpr int XBCW = 3072;
constexpr int NWAVES = 8, NTHR = 512;
constexpr int NPH = 14;

constexpr size_t MiB = 1u << 20;
constexpr size_t WS_CTL = 0, CTL_ZERO_BYTES = 1 * MiB;
constexpr size_t WS_MOD = 1, WS_ROPE = 2, WS_WR = 3, WS_RSTD = 4, WS_LISTS = 8, WS_ACS = 16, WS_DT = 18, WS_DTRAW = 20;
constexpr size_t WS_WT_IN = 32, WS_WT_BS = 96, WS_WT_BA = 104, WS_WT_OUT = 112, WS_WT_GU = 128, WS_WT_DN = 640;
constexpr size_t WS_H = 896, WS_Z = 960, WS_XBC = 1024, WS_Q = 1120, WS_K = 1184, WS_V = 1248, WS_SGS = 1312, WS_SGA = 1376, WS_XBCC = 1440;
constexpr size_t WS_YDIAG = 1536, WS_STATES = 1664, WS_YBUF = 1792, WS_OATT = 1856, WS_OFIN = 1984, WS_M1 = 2048, WS_MERGED = 2176, WS_MIX = 2240;
constexpr size_t WS_X1 = 2368, WS_H2 = 2496, WS_ACT = 2560, WS_YS = 2848, WS_END = 3104;
constexpr int CW_BAR = 4096;
constexpr int CW_CNT = 16384;
constexpr size_t MOD_CB = 256 * 1024;
constexpr size_t LIST_STRIDE = 2 * MiB;

constexpr int RING_BYTES = 131072;
constexpr int TAB_OFF = RING_BYTES;
constexpr int MISC_OFF = RING_BYTES + 1024;
constexpr int LDS_BYTES = 147456;

#define RLX_AGENT __ATOMIC_RELAXED, __HIP_MEMORY_SCOPE_AGENT
#define LDS_WAIT() asm volatile("s_waitcnt lgkmcnt(0)" ::: "memory")
#define VM_WAIT() asm volatile("s_waitcnt vmcnt(0)" ::: "memory")
#define SBAR() __builtin_amdgcn_sched_barrier(0)
__device__ __forceinline__ unsigned f2bf(float f) { unsigned u = __builtin_bit_cast(unsigned, f); return (u + 0x7fffu + ((u >> 16) & 1u)) >> 16; }

__device__ __forceinline__ float bf2f(unsigned short b) { return __builtin_bit_cast(float, (unsigned)b << 16); }
__device__ __forceinline__ float bflo(unsigned w) { return __builtin_bit_cast(float, w << 16); }
__device__ __forceinline__ float bfhi(unsigned w) { return __builtin_bit_cast(float, w & 0xffff0000u); }
__device__ __forceinline__ unsigned cvt_pk_bf16(float lo, float hi) { unsigned r; asm("v_cvt_pk_bf16_f32 %0, %1, %2" : "=v"(r) : "v"(lo), "v"(hi)); return r; }
__device__ __forceinline__ unsigned pk2(float lo, float hi) { return cvt_pk_bf16(lo, hi); }
__device__ __forceinline__ unsigned pk4_fp8(float a, float b, float c, float d) { int w = __builtin_amdgcn_cvt_pk_fp8_f32(a, b, 0, false); w = __builtin_amdgcn_cvt_pk_fp8_f32(c, d, w, true); return (unsigned)w; }
__device__ __forceinline__ float sigmoidf_(float x) { return 1.0f / (1.0f + __expf(-x)); }
__device__ __forceinline__ float siluf_(float x) { return x / (1.0f + __expf(-x)); }
__device__ __forceinline__ float wave_sum(float v) {
#pragma unroll
    for (int o = 1; o < 64; o <<= 1) v += __shfl_xor(v, o);
    return v;
}

#define XB_TMO      128
#define XB_XCNT(j)  (256  + 64 * (j))
#define XB_XSUB(j)  (1280 + 64 * (j))
#define XB_XGEN(j)  (2304 + 64 * (j))
#define XB_TOP      3328
#define XB_TOPGEN   3392
#define XCD_BAR_WORDS 3456
#define XB_SPIN_CAP (1u << 18)
__device__ __forceinline__ unsigned xb_ld(unsigned* p)              { return __hip_atomic_load(p, __ATOMIC_RELAXED, __HIP_MEMORY_SCOPE_AGENT); }
__device__ __forceinline__ unsigned xb_add(unsigned* p, unsigned v) { return __hip_atomic_fetch_add(p, v, __ATOMIC_RELAXED, __HIP_MEMORY_SCOPE_AGENT); }
__device__ __forceinline__ unsigned xb_xcc_id() { return (unsigned)__builtin_amdgcn_s_getreg((3 << 11) | 20) & 0xFu; }
#define XB_SPIN(cond, bar) do { unsigned _sp = 0; while (cond) { __builtin_amdgcn_s_sleep(1); \
    if ((++_sp & 255u) == 0u) { if (xb_ld(&(bar)[XB_TMO])) break; if (_sp > XB_SPIN_CAP) { atomicAdd(&(bar)[XB_TMO], 1u); break; } } } } while (0)
struct XcdBarrier { unsigned* bar; unsigned x; volatile LAS unsigned* st; };
__device__ __forceinline__ XcdBarrier xcd_barrier_post(unsigned* bar, volatile LAS unsigned* st) {
    XcdBarrier b; b.bar = bar; b.x = xb_xcc_id(); b.st = st;
    if (threadIdx.x == 0) (void)xb_add(&bar[XB_XCNT(b.x)], 1u);
    return b;
}
__device__ __forceinline__ void xcd_barrier_complete(unsigned* bar, unsigned x, unsigned& nloc, unsigned& nx) {
    const unsigned G = gridDim.x * gridDim.y * gridDim.z;
    unsigned sum, cnt, mine, sp = 0u;
    for (;;) {
        sum = 0u; cnt = 0u; mine = 0u;
#pragma unroll
        for (unsigned j = 0; j < 16; ++j) { const unsigned c = xb_ld(&bar[XB_XCNT(j)]); sum += c; cnt += (c > 0u) ? 1u : 0u; mine = (j == x) ? c : mine; }
        if (sum == G) break;
        __builtin_amdgcn_s_sleep(1);
        if ((++sp & 255u) == 0u) { if (xb_ld(&bar[XB_TMO])) break; if (sp > XB_SPIN_CAP) { atomicAdd(&bar[XB_TMO], 1u); break; } }
    }
    nloc = mine > 0u ? mine : 1u; nx = cnt > 0u ? cnt : 1u;
}
__device__ __forceinline__ void xcd_barrier(const XcdBarrier& b) {
    asm volatile("s_waitcnt vmcnt(0)" ::: "memory");
    __syncthreads();
    if (threadIdx.x == 0) {
        unsigned* bar = b.bar;
        __builtin_amdgcn_s_waitcnt(0);
        unsigned nloc = b.st[0], nx = b.st[1];
        if (nloc == 0u) { xcd_barrier_complete(bar, b.x, nloc, nx); b.st[0] = nloc; b.st[1] = nx; }
        const unsigned old = xb_add(&bar[XB_XSUB(b.x)], 1u);
        const unsigned gen = old / nloc;
        if (old + 1u == (gen + 1u) * nloc) {
            __builtin_amdgcn_fence(__ATOMIC_RELEASE, "agent");
            asm volatile("s_waitcnt vmcnt(0)" ::: "memory");
            const unsigned og = xb_add(&bar[XB_TOP], 1u);
            const unsigned tg = og / nx;
            if (og + 1u == (tg + 1u) * nx) xb_add(&bar[XB_TOPGEN], 1u);
            else XB_SPIN(xb_ld(&bar[XB_TOPGEN]) == tg, bar);
            __builtin_amdgcn_fence(__ATOMIC_ACQUIRE, "agent");
            xb_add(&bar[XB_XGEN(b.x)], 1u);
            asm volatile("s_waitcnt vmcnt(0)" ::: "memory");
        } else {
            XB_SPIN(xb_ld(&bar[XB_XGEN(b.x)]) == gen, bar);
            __builtin_amdgcn_fence(__ATOMIC_ACQUIRE, "agent");
            asm volatile("s_waitcnt vmcnt(0)" ::: "memory");
        }
    }
    __syncthreads();
}
namespace pg8 {
constexpr int BM = 256, BK = 64, HALF = 128, HTB = HALF * BK * 2, STAGE_BYTES = 8 * HTB, NXCD = 8;
#ifndef PG8_WGM
#define PG8_WGM 8
#endif
constexpr int WGM = PG8_WGM;
__host__ __device__ __forceinline__ int lds_byte(int r, int c) { const int st = (r >> 4) * 2 + (c >> 5), rr = r & 15, cc = c & 31, ob = rr * 64 + cc * 2; return st * 1024 + (ob ^ (((ob >> 9) & 1) << 5)); }
__host__ __device__ __forceinline__ void stage_rc(int b, int& R, int& C) { const int st = b / 1024, sb = b % 1024, swz = sb ^ (((sb >> 9) & 1) << 5); R = (st >> 1) * 16 + swz / 64; C = (st & 1) * 32 + (swz % 64) / 2; }
__host__ __device__ __forceinline__ int perm32(int rho) { const int n = rho >> 4, i = rho & 15; return 8 * (i >> 2) + 4 * n + (i & 3); }

struct Unit { int pm, pn, e, ml; };

struct ProbDense {
    static constexpr bool PRELOAD = false;
    const char* A; const char* Bt; int rb;
    int nM, nN, nwg, G, c;
    __device__ __forceinline__ void init(const void* A_, const void* Bt_, int M, int N, int K_, int G_, int c_) { A = (const char*)A_; Bt = (const char*)Bt_; rb = K_ * 2; nM = M / BM; nN = N / BM; nwg = nM * nN; G = G_; c = c_; }
    __device__ __forceinline__ bool next(int i, Unit& u) const {
        const long L = (long)i * G + c; if (L >= nwg) return false;
        int wgid = (int)L; { const int q = nwg / NXCD, r = nwg % NXCD, xcd = wgid % NXCD, off = wgid / NXCD; wgid = (xcd < r ? xcd * (q + 1) : r * (q + 1) + (xcd - r) * q) + off; }
        const int nig = WGM * nN, gid = wgid / nig, fm = gid * WGM, gsz = (nM - fm) < WGM ? (nM - fm) : WGM;
        u.pm = fm + ((wgid % nig) % gsz); u.pn = (wgid % nig) / gsz; u.e = 0; u.ml = 0; return true;
    }
    __device__ __forceinline__ unsigned b_off(const Unit& u) const { return (unsigned)(u.pn * BM * rb); }
    __device__ __forceinline__ void a_offs(const Unit& u, int tid_, unsigned (&off)[2][2]) const {
        asm volatile("" : "+v"(tid_)); int R[2], C[2]; stage_rc(tid_ * 16, R[0], C[0]); stage_rc(tid_ * 16 + 8192, R[1], C[1]);
#pragma unroll
        for (int h = 0; h < 2; ++h)
#pragma unroll
            for (int i = 0; i < 2; ++i) off[h][i] = (unsigned)((u.pm * BM + h * HALF + R[i]) * rb + C[i] * 2);
    }
};

template <bool GATHER> struct ProbMoE {
    static constexpr bool PRELOAD = GATHER;
    const char* A; const char* Bt; int rb, nN; size_t estride;
    const int* list_tok; const LAS int* tab; int G, c;
    __device__ __forceinline__ bool next(int i, Unit& u) const {
        const int L = i * G + c; const int NT = __builtin_amdgcn_readfirstlane(tab[64]);
        if (L >= NT * nN) return false;
        int e = 0;
#pragma unroll 1
        for (int j = 1; j < 32; ++j) if (L >= tab[32 + j] * nN) e = j;
        const int tb = tab[32 + e], ntile = tab[33 + e] - tb, Lp = L - tb * nN;
        u.e = __builtin_amdgcn_readfirstlane(e); u.pn = __builtin_amdgcn_readfirstlane(Lp / ntile); u.ml = __builtin_amdgcn_readfirstlane(Lp % ntile); u.pm = __builtin_amdgcn_readfirstlane(tb + Lp % ntile); return true;
    }
    __device__ __forceinline__ unsigned b_off(const Unit& u) const { return (unsigned)(u.e * (unsigned)estride + u.pn * BM * rb); }
    __device__ __forceinline__ void a_offs(const Unit& u, int tid_, unsigned (&off)[2][2]) const {
        asm volatile("" : "+v"(tid_)); int R[2], C[2]; stage_rc(tid_ * 16, R[0], C[0]); stage_rc(tid_ * 16 + 8192, R[1], C[1]);
        if constexpr (GATHER) {
            const int cnt = __builtin_amdgcn_readfirstlane(tab[u.e]);
#pragma unroll
            for (int h = 0; h < 2; ++h)
#pragma unroll
                for (int i = 0; i < 2; ++i) { const int j = u.ml * BM + h * HALF + R[i]; const int tok = (j < cnt) ? list_tok[u.e * 16384 + j] : 0; off[h][i] = (unsigned)(tok * rb + C[i] * 2); }
        } else {
#pragma unroll
            for (int h = 0; h < 2; ++h)
#pragma unroll
                for (int i = 0; i < 2; ++i) off[h][i] = (unsigned)((u.pm * BM + h * HALF + R[i]) * rb + C[i] * 2);
        }
    }
};

typedef int v8i32 __attribute__((ext_vector_type(8)));
typedef int v4i32 __attribute__((ext_vector_type(4)));
__device__ __forceinline__ v8i32 cat8(bf16x8 a, bf16x8 b) { const v4i32 x = __builtin_bit_cast(v4i32, a), y = __builtin_bit_cast(v4i32, b); return __builtin_shufflevector(x, y, 0, 1, 2, 3, 4, 5, 6, 7); }
template <class Epi, class Prob, bool ALIGN_EPI, bool FP8 = false, int WSCALE = 127, int KREP = 1, int EREP = 1>
__device__ __forceinline__ void gemm_phase(LAS unsigned char* lds, const Prob& P, const Epi& E) {
    const int tid = threadIdx.x, wid = __builtin_amdgcn_readfirstlane(tid >> 6), lane = tid & 63, wr = wid >> 2, wc = wid & 3, fr = lane & 15, fq = lane >> 4;
    const int rb = P.rb, nt = rb / 128;
    unsigned voffB; { int R, C; stage_rc(tid * 16, R, C); const int Rb = Epi::PERM ? ((R & ~31) + perm32(R & 31)) : R; voffB = (unsigned)(Rb * rb + C * 2); }
    const unsigned qstep = (unsigned)(64 * rb);
    const unsigned kstep = 128u;
    const unsigned hstep = (unsigned)(HALF * rb);
    const __amdgpu_buffer_rsrc_t rA = __builtin_amdgcn_make_buffer_rsrc((void*)P.A, 0, 0x7fffffff, 0x00020000), rB = __builtin_amdgcn_make_buffer_rsrc((void*)P.Bt, 0, 0x7fffffff, 0x00020000);
    const unsigned ldsw = (unsigned)wid * 1024u;
    const int aoff = lds_byte(wr * 64 + fr, fq * 8), boff = lds_byte(wc * 32 + fr, fq * 8);
#define PG8_SA(b, h) (((b) * 2 + (h)) * HTB)
#define PG8_SB(b, h) ((4 + (b) * 2 + (h)) * HTB)
#define PG8_STAGE_B(bufoff, soff) do { _Pragma("unroll") for (int _i = 0; _i < 2; ++_i) \
        __builtin_amdgcn_raw_ptr_buffer_load_lds(rB, (LAS void*)(lds + (bufoff) + ldsw + _i * 8192), 16, voffB, (int)((soff) + _i * qstep), 0, 0); } while (0)
#define PG8_STAGE_A(bufoff, h, soff) do { _Pragma("unroll") for (int _i = 0; _i < 2; ++_i) { \
        if constexpr (Prob::PRELOAD) __builtin_amdgcn_raw_ptr_buffer_load_lds(rA, (LAS void*)(lds + (bufoff) + ldsw + _i * 8192), 16, offA[h][_i], (int)(soff), 0, 0); \
        else __builtin_amdgcn_raw_ptr_buffer_load_lds(rA, (LAS void*)(lds + (bufoff) + ldsw + _i * 8192), 16, offA[0][0], (int)((soff) + (h) * hstep + _i * qstep), 0, 0); } } while (0)
#define PG8_LDA(dst, b, h) do { _Pragma("unroll") for (int m = 0; m < 4; ++m) _Pragma("unroll") for (int k = 0; k < 2; ++k) dst[m][k] = *(const LAS bf16x8*)(lds + PG8_SA(b, h) + aoff + m * 2048 + k * 1024); } while (0)
#define PG8_LDB(dst, b, h) do { _Pragma("unroll") for (int n = 0; n < 2; ++n) _Pragma("unroll") for (int k = 0; k < 2; ++k) dst[n][k] = *(const LAS bf16x8*)(lds + PG8_SB(b, h) + boff + n * 2048 + k * 1024); } while (0)
#define PG8_MMA(ai, bj, At, Bt) do { __builtin_amdgcn_s_setprio(1); _Pragma("unroll") for (int m = 0; m < 4; ++m) _Pragma("unroll") for (int n = 0; n < 2; ++n) { \
        if constexpr (FP8) acc[ai][bj][m][n] = __builtin_amdgcn_mfma_scale_f32_16x16x128_f8f6f4(cat8(Bt[n][0], Bt[n][1]), cat8(At[m][0], At[m][1]), acc[ai][bj][m][n], 0, 0, 0, WSCALE, 0, 127); \
        else { _Pragma("unroll") for (int k = 0; k < 2; ++k) acc[ai][bj][m][n] = __builtin_amdgcn_mfma_f32_16x16x32_bf16(Bt[n][k], At[m][k], acc[ai][bj][m][n], 0, 0, 0); } } \
        __builtin_amdgcn_s_setprio(0); } while (0)
#define PG8_WAIT_V(n) asm volatile("s_waitcnt vmcnt(" #n ")" ::: "memory")
#define PG8_WAIT_L(n) asm volatile("s_waitcnt lgkmcnt(" #n ")" ::: "memory")
#define PG8_BAR __builtin_amdgcn_s_barrier()
    Unit cur, nxt; int ui = 0;
    if (!P.next(0, cur)) return;
    f32x4 acc[2][2][4][2];
#pragma unroll
    for (int a = 0; a < 2; ++a)
#pragma unroll
        for (int b = 0; b < 2; ++b)
#pragma unroll
            for (int m = 0; m < 4; ++m)
#pragma unroll
                for (int n = 0; n < 2; ++n) acc[a][b][m][n] = (f32x4){0.f, 0.f, 0.f, 0.f};
    bf16x8 At[4][2], B0[2][2], B1[2][2];
    unsigned offA[2][2], noffA[2][2];
    P.a_offs(cur, tid, offA);
    unsigned cB = P.b_off(cur);
    PG8_STAGE_B(PG8_SB(0, 0), cB); PG8_STAGE_B(PG8_SB(0, 1), cB + hstep); PG8_STAGE_A(PG8_SA(0, 0), 0, 0u); PG8_STAGE_A(PG8_SA(0, 1), 1, 0u);
    if (wr == 1) PG8_BAR;
    PG8_WAIT_V(2); PG8_BAR;
    PG8_STAGE_B(PG8_SB(1, 0), cB + kstep); PG8_STAGE_A(PG8_SA(1, 0), 0, kstep); PG8_STAGE_B(PG8_SB(1, 1), cB + hstep + kstep);
    PG8_WAIT_V(6); PG8_BAR;
    for (;;) {
        const bool has_next = P.next(ui + 1, nxt);
        if constexpr (Prob::PRELOAD) {
            if (has_next) P.a_offs(nxt, tid, noffA);
            else {
#pragma unroll
                for (int h = 0; h < 2; ++h)
#pragma unroll
                    for (int i = 0; i < 2; ++i) noffA[h][i] = offA[h][i];
            }
        }
        Unit nu = has_next ? nxt : cur;
        const unsigned nB = has_next ? P.b_off(nxt) : cB;
        for (int kr = 0; kr < KREP; ++kr) {
        if (KREP > 1 && kr > 0) {
#pragma unroll
            for (int a = 0; a < 2; ++a)
#pragma unroll
                for (int b = 0; b < 2; ++b)
#pragma unroll
                    for (int m = 0; m < 4; ++m)
#pragma unroll
                        for (int n = 0; n < 2; ++n) acc[a][b][m][n] = (f32x4){0.f, 0.f, 0.f, 0.f};
        }
        const bool fin = (kr == KREP - 1);
        for (int t = 0; t < nt; t += 2) {
            const bool last = (t == nt - 2);
            const unsigned a1 = (unsigned)(t + 1) * kstep;
            const unsigned a2 = last ? 0u : (unsigned)(t + 2) * kstep, b2 = last ? (fin ? nB : cB) : cB + (unsigned)(t + 2) * kstep;
            const unsigned a3 = a2 + kstep, b3 = b2 + kstep;
            PG8_LDB(B0, 0, 0); PG8_LDB(B1, 0, 1); SBAR(); PG8_LDA(At, 0, 0); PG8_STAGE_A(PG8_SA(1, 1), 1, a1);
            PG8_WAIT_V(8); PG8_WAIT_L(0); PG8_BAR; PG8_MMA(0, 0, At, B0); PG8_MMA(0, 1, At, B1); PG8_BAR; SBAR();
            if constexpr (Prob::PRELOAD) {
#pragma unroll
                for (int h = 0; h < 2; ++h)
#pragma unroll
                    for (int i = 0; i < 2; ++i) offA[h][i] = (last && fin) ? noffA[h][i] : offA[h][i];
            } else {
                const unsigned dlt = (last && fin) ? (unsigned)((nu.pm - cur.pm) * BM * rb) : 0u;
                offA[0][0] += dlt;
            }
            PG8_LDA(At, 0, 1); PG8_STAGE_B(PG8_SB(0, 0), b2); PG8_STAGE_B(PG8_SB(0, 1), b2 + hstep); PG8_STAGE_A(PG8_SA(0, 0), 0, a2);
            PG8_WAIT_V(8); PG8_WAIT_L(0); PG8_BAR; PG8_MMA(1, 0, At, B0); PG8_MMA(1, 1, At, B1); PG8_BAR; SBAR();
            PG8_LDB(B0, 1, 0); PG8_LDB(B1, 1, 1); SBAR(); PG8_LDA(At, 1, 0); PG8_STAGE_A(PG8_SA(0, 1), 1, a2);
            PG8_WAIT_V(8); PG8_WAIT_L(0); PG8_BAR; PG8_MMA(0, 0, At, B0); PG8_MMA(0, 1, At, B1); PG8_BAR; SBAR();
            PG8_LDA(At, 1, 1); PG8_STAGE_B(PG8_SB(1, 0), b3); PG8_STAGE_B(PG8_SB(1, 1), b3 + hstep); PG8_STAGE_A(PG8_SA(1, 0), 0, a3);
            PG8_WAIT_V(8); PG8_WAIT_L(0); PG8_BAR; PG8_MMA(1, 0, At, B0); PG8_MMA(1, 1, At, B1); PG8_BAR; SBAR();
        }
        }
        if constexpr (ALIGN_EPI) { if (wr == 0) PG8_BAR; }
        { int fr_ = fr, fq_ = fq; asm volatile("" : "+v"(fr_), "+v"(fq_)); E(acc, cur, wr, wc, fr_, fq_); if constexpr (EREP > 1) { asm volatile("" : "+v"(fr_), "+v"(fq_)); E(acc, cur, wr, wc, fr_, fq_); } }
        if (!has_next) break;
#pragma unroll
        for (int a = 0; a < 2; ++a)
#pragma unroll
            for (int b = 0; b < 2; ++b)
#pragma unroll
                for (int m = 0; m < 4; ++m)
#pragma unroll
                    for (int n = 0; n < 2; ++n) acc[a][b][m][n] = (f32x4){0.f, 0.f, 0.f, 0.f};
        cur = nxt; cB = nB; ++ui;
        if constexpr (ALIGN_EPI) { if (wr == 1) PG8_BAR; }
    }
    PG8_WAIT_V(0);
    if constexpr (!ALIGN_EPI) { if (wr == 0) PG8_BAR; }
    PG8_BAR;
#undef PG8_SA
#undef PG8_SB
#undef PG8_STAGE_A
#undef PG8_STAGE_B
#undef PG8_LDA
#undef PG8_LDB
#undef PG8_MMA
#undef PG8_WAIT_V
#undef PG8_WAIT_L
#undef PG8_BAR
}
}
namespace pg8 {
struct EpiInProj {
    static constexpr bool PERM = true;
    unsigned char* ws;
    __device__ __forceinline__ void operator()(const f32x4 (&acc)[2][2][4][2], const Unit& u, int wr, int wc, int fr, int fq) const {
        const int pn = u.pn; const int row0 = u.pm * BM + wr * 64 + fr;
        if (pn == 60) {
            if (wc == 0) { float* dst = (float*)(ws + WS_DTRAW * MiB);
#pragma unroll
                for (int ai = 0; ai < 2; ++ai)
#pragma unroll
                    for (int m = 0; m < 4; ++m) { float* rp = dst + (size_t)(row0 + ai * HALF + m * 16) * 32 + 8 * fq;
                        *(f32x4*)rp = acc[ai][0][m][0]; *(f32x4*)(rp + 4) = acc[ai][0][m][1]; } }
            return;
        }
        bf16* base; int ldc, colt; bool sig = false;
        if (pn < 8)       { base = (bf16*)(ws + WS_Z * MiB);   ldc = DM;   colt = pn * BM; }
        else if (pn < 20) { base = (bf16*)(ws + WS_XBC * MiB); ldc = XBCW; colt = (pn - 8) * BM; }
        else if (pn < 28) { base = (bf16*)(ws + WS_Q * MiB);   ldc = DM;   colt = (pn - 20) * BM; }
        else if (pn < 36) { base = (bf16*)(ws + WS_K * MiB);   ldc = DM;   colt = (pn - 28) * BM; }
        else if (pn < 44) { base = (bf16*)(ws + WS_V * MiB);   ldc = DM;   colt = (pn - 36) * BM; }
        else if (pn < 52) { base = (bf16*)(ws + WS_SGS * MiB); ldc = DM;   colt = (pn - 44) * BM; sig = true; }
        else              { base = (bf16*)(ws + WS_SGA * MiB); ldc = DM;   colt = (pn - 52) * BM; sig = true; }
        const int col0 = colt + wc * 32 + 8 * fq;
#pragma unroll
        for (int ai = 0; ai < 2; ++ai)
#pragma unroll
            for (int m = 0; m < 4; ++m) { bf16* rowp = base + (size_t)(row0 + ai * HALF + m * 16) * ldc + col0;
#pragma unroll
                for (int bj = 0; bj < 2; ++bj) { f32x4 v0 = acc[ai][bj][m][0], v1 = acc[ai][bj][m][1];
                    if (sig) {
#pragma unroll
                        for (int q = 0; q < 4; ++q) { v0[q] = sigmoidf_(v0[q]); v1[q] = sigmoidf_(v1[q]); } }
                    u32x4 w; w.x = cvt_pk_bf16(v0[0], v0[1]); w.y = cvt_pk_bf16(v0[2], v0[3]); w.z = cvt_pk_bf16(v1[0], v1[1]); w.w = cvt_pk_bf16(v1[2], v1[3]);
                    *(u32x4*)(rowp + bj * HALF) = w; } }
    }
};
struct EpiBr1 {
    static constexpr bool PERM = false;
    const bf16* sg; float* m1;
    __device__ __forceinline__ void operator()(const f32x4 (&acc)[2][2][4][2], const Unit& u, int wr, int wc, int fr, int fq) const {
        const int row0 = u.pm * BM + wr * 64 + fr, col0 = u.pn * BM + wc * 32 + 4 * fq;
#pragma unroll
        for (int ai = 0; ai < 2; ++ai)
#pragma unroll
            for (int m = 0; m < 4; ++m) { const size_t off = (size_t)(row0 + ai * HALF + m * 16) * DM + col0;
#pragma unroll
                for (int bj = 0; bj < 2; ++bj)
#pragma unroll
                    for (int n = 0; n < 2; ++n) { const u32x2 g = *(const u32x2*)(sg + off + bj * HALF + n * 16); const f32x4 a = acc[ai][bj][m][n];
                        *(f32x4*)(m1 + off + bj * HALF + n * 16) = (f32x4){a[0] * bflo(g.x), a[1] * bfhi(g.x), a[2] * bflo(g.y), a[3] * bfhi(g.y)}; } }
    }
};
struct EpiBr2 {
    static constexpr bool PERM = false;
    const bf16* sg; const float* m1; bf16* out;
    __device__ __forceinline__ void operator()(const f32x4 (&acc)[2][2][4][2], const Unit& u, int wr, int wc, int fr, int fq) const {
        const int row0 = u.pm * BM + wr * 64 + fr, col0 = u.pn * BM + wc * 32 + 4 * fq;
#pragma unroll
        for (int ai = 0; ai < 2; ++ai)
#pragma unroll
            for (int m = 0; m < 4; ++m) { const size_t off = (size_t)(row0 + ai * HALF + m * 16) * DM + col0;
#pragma unroll
                for (int bj = 0; bj < 2; ++bj)
#pragma unroll
                    for (int n = 0; n < 2; ++n) { const size_t o2 = off + bj * HALF + n * 16; const u32x2 g = *(const u32x2*)(sg + o2); const f32x4 a = acc[ai][bj][m][n]; const f32x4 p = *(const f32x4*)(m1 + o2);
                        u32x2 w; w.x = cvt_pk_bf16(p[0] + a[0] * bflo(g.x), p[1] + a[1] * bfhi(g.x)); w.y = cvt_pk_bf16(p[2] + a[2] * bflo(g.y), p[3] + a[3] * bfhi(g.y));
                        *(u32x2*)(out + o2) = w; } }
    }
};
struct EpiF32 {
    static constexpr bool PERM = false;
    float* out; int ldc;
    __device__ __forceinline__ void operator()(const f32x4 (&acc)[2][2][4][2], const Unit& u, int wr, int wc, int fr, int fq) const {
        const int row0 = u.pm * BM + wr * 64 + fr, col0 = u.pn * BM + wc * 32 + 4 * fq;
#pragma unroll
        for (int ai = 0; ai < 2; ++ai)
#pragma unroll
            for (int m = 0; m < 4; ++m) { const size_t off = (size_t)(row0 + ai * HALF + m * 16) * ldc + col0;
#pragma unroll
                for (int bj = 0; bj < 2; ++bj)
#pragma unroll
                    for (int n = 0; n < 2; ++n) *(f32x4*)(out + off + bj * HALF + n * 16) = acc[ai][bj][m][n]; }
    }
};
struct EpiGateUp {
    static constexpr bool PERM = true;
    const float* bgu; unsigned char* act;
    __device__ __forceinline__ void operator()(const f32x4 (&acc)[2][2][4][2], const Unit& u, int wr, int wc, int fr, int fq) const {
        const int row0 = u.pm * BM + wr * 64 + fr; const int f0 = u.pn * 128 + wc * 16 + 4 * fq;
        const float* bg = bgu + (size_t)u.e * 4096;
#pragma unroll
        for (int bj = 0; bj < 2; ++bj) { const int f = f0 + bj * 64; const f32x4 bgate = *(const f32x4*)(bg + f), bup = *(const f32x4*)(bg + 2048 + f);
#pragma unroll
            for (int ai = 0; ai < 2; ++ai)
#pragma unroll
                for (int m = 0; m < 4; ++m) { const f32x4 g4 = acc[ai][bj][m][0] * 0.015625f + bgate, u4 = acc[ai][bj][m][1] * 0.015625f + bup; float r[4];
#pragma unroll
                    for (int q = 0; q < 4; ++q) { const float g = fminf(g4[q], 7.0f), up = fminf(fmaxf(u4[q], -7.0f), 7.0f); r[q] = (up + 1.0f) * g * sigmoidf_(1.702f * g); }
                    *(unsigned*)(act + (size_t)(row0 + ai * HALF + m * 16) * DM + f) = pk4_fp8(r[0], r[1], r[2], r[3]); } }
    }
};
struct EpiDown {
    static constexpr bool PERM = true;
    const float* bdn; const int* list_dst; const float* list_w; const LAS int* tab; bf16* ys;
    __device__ __forceinline__ void operator()(const f32x4 (&acc)[2][2][4][2], const Unit& u, int wr, int wc, int fr, int fq) const {
        const int cnt = __builtin_amdgcn_readfirstlane(tab[u.e]); const int col0 = u.pn * BM + wc * 32 + 8 * fq; const float* bd = bdn + (size_t)u.e * DM + col0;
#pragma unroll
        for (int ai = 0; ai < 2; ++ai)
#pragma unroll
            for (int m = 0; m < 4; ++m) { const int j = u.ml * BM + ai * HALF + wr * 64 + m * 16 + fr;
                if (j < cnt) { const int dst = list_dst[u.e * 16384 + j]; const float w = list_w[u.e * 16384 + j]; bf16* rowp = ys + (size_t)dst * DM + col0;
#pragma unroll
                    for (int bj = 0; bj < 2; ++bj) { const f32x4 b0 = *(const f32x4*)(bd + bj * HALF), b1 = *(const f32x4*)(bd + bj * HALF + 4);
                        const f32x4 v0 = (acc[ai][bj][m][0] * 0.015625f + b0) * w, v1 = (acc[ai][bj][m][1] * 0.015625f + b1) * w;
                        u32x4 o; o.x = cvt_pk_bf16(v0[0], v0[1]); o.y = cvt_pk_bf16(v0[2], v0[3]); o.z = cvt_pk_bf16(v1[0], v1[1]); o.w = cvt_pk_bf16(v1[2], v1[3]);
                        *(u32x4*)(rowp + bj * HALF) = o; } } }
    }
};
}
namespace att {
constexpr int NW = 8, QBLK = 32, KVBLK = 64, QB = NW * QBLK;
constexpr int SHM_V = KVBLK * 128 * 2, SHM_K = KVBLK * 64 * 2;
constexpr int LDS_BYTES = 2 * SHM_V + 2 * SHM_K + NW * 64 * 4;
constexpr int QP = 2048, OP = 4096;
constexpr float SCALE = 0.125f, THR = 8.f;
#define KSWZ(row, colB) ((row) * 128 + ((colB) ^ ((((row) >> 1) & 7) << 4)))
__device__ __forceinline__ int v_st(int k, int c) { const int kk = (k & ~0xC) | ((k & 4) << 1) | ((k & 8) >> 1); return ((kk >> 3) * 4 + (c >> 5)) * 512 + ((kk & 7) * 32 + (c & 31)) * 2; }
__device__ __forceinline__ int v_rd_base(int lane) { return ((lane & 3) << 3) | (((lane >> 2) & 3) << 6) | (((lane >> 4) & 1) << 5) | (((lane >> 5) & 1) << 8); }
constexpr int v_rd_off(int d0, int ks, int half) { return d0 * 512 + ks * 4096 + half * 2048; }
__device__ __forceinline__ int crow(int r, int hi) { return (r & 3) + 8 * (r >> 2) + 4 * hi; }
__device__ __forceinline__ unsigned cvtpk(float lo, float hi) { unsigned r; asm volatile("v_cvt_pk_bf16_f32 %0, %1, %2" : "=v"(r) : "v"(lo), "v"(hi)); return r; }
__device__ __forceinline__ bf16x8 load8(const bf16* p) { return *reinterpret_cast<const bf16x8*>(p); }
__device__ __forceinline__ void mask_tile(f32x16& p0, f32x16& p1, int dq) {
    const float NEG = -__builtin_inff();
#pragma unroll
    for (int r = 0; r < 16; ++r) {
        const int c = (r & 3) + 8 * (r >> 2);
        if (dq - c < 0) p0[r] = NEG;
        if (dq - c - 32 < 0) p1[r] = NEG;
    }
}
__device__ __forceinline__ void partialSM(f32x16& p0, f32x16& p1, float& m_reg, float& mn, float& alpha) {
    float pmax = p0[0];
#pragma unroll
    for (int r = 1; r < 16; ++r) pmax = fmaxf(pmax, p0[r]);
#pragma unroll
    for (int r = 0; r < 16; ++r) pmax = fmaxf(pmax, p1[r]);
    { auto rr = __builtin_amdgcn_permlane32_swap(__float_as_uint(pmax), __float_as_uint(pmax), false, false);
      pmax = fmaxf(__uint_as_float(rr[0]), __uint_as_float(rr[1])); }
    constexpr float C2 = 1.4426950408889634f * SCALE;
    if (__builtin_expect(__all((pmax - m_reg) * SCALE <= THR), 1)) { mn = m_reg; alpha = 1.f; }
    else { mn = fmaxf(m_reg, pmax); alpha = __builtin_amdgcn_exp2f((m_reg - mn) * C2); m_reg = mn; }
    const float mnL = -mn * C2;
#pragma unroll
    for (int r = 0; r < 16; ++r) p0[r] = fmaf(p0[r], C2, mnL);
#pragma unroll
    for (int r = 0; r < 16; ++r) p1[r] = fmaf(p1[r], C2, mnL);
#pragma unroll
    for (int r = 0; r < 16; ++r) p0[r] = __builtin_amdgcn_exp2f(p0[r]);
}
__device__ __forceinline__ void finishSM(f32x16& p0, f32x16& p1, float alpha, float& l_reg, bf16x8& pa0, bf16x8& pa1, bf16x8& pa2, bf16x8& pa3) {
#pragma unroll
    for (int r = 0; r < 16; ++r) p1[r] = __builtin_amdgcn_exp2f(p1[r]);
    float ps = 0;
#pragma unroll
    for (int r = 0; r < 16; ++r) ps += p0[r];
#pragma unroll
    for (int r = 0; r < 16; ++r) ps += p1[r];
    { auto rr = __builtin_amdgcn_permlane32_swap(__float_as_uint(ps), __float_as_uint(ps), false, false);
      ps = __uint_as_float(rr[0]) + __uint_as_float(rr[1]); }
    l_reg = l_reg * alpha + ps;
#define PK4(P, B_, OUT) do { unsigned a0 = cvtpk(P[B_+0], P[B_+1]), a1 = cvtpk(P[B_+2], P[B_+3]);                          \
        unsigned b0 = cvtpk(P[B_+4], P[B_+5]), b1 = cvtpk(P[B_+6], P[B_+7]);                                             \
        auto r0 = __builtin_amdgcn_permlane32_swap(a0, b0, false, false); auto r1 = __builtin_amdgcn_permlane32_swap(a1, b1, false, false); \
        u32x4 w = {r0[0], r1[0], r0[1], r1[1]}; OUT = *reinterpret_cast<bf16x8*>(&w); } while (0)
    PK4(p0, 0, pa0); PK4(p0, 8, pa1); PK4(p1, 0, pa2); PK4(p1, 8, pa3);
#undef PK4
}
template <int KB>
__device__ __forceinline__ void qkt(f32x16& p0, f32x16& p1, const char* K_lds, int r32, int hi, const bf16x8* qr) {
    p0 = f32x16{}; p1 = f32x16{};
#pragma unroll
    for (int d0 = 0; d0 < 4; ++d0) { const char* a = K_lds + KB * SHM_K + KSWZ(r32, (d0 * 2 + hi) * 16);
        bf16x8 b0 = *reinterpret_cast<const bf16x8*>(a);
        bf16x8 b1 = *reinterpret_cast<const bf16x8*>(a + 32 * 128);
        p0 = __builtin_amdgcn_mfma_f32_32x32x16_bf16(b0, qr[d0], p0, 0, 0, 0);
        p1 = __builtin_amdgcn_mfma_f32_32x32x16_bf16(b1, qr[d0], p1, 0, 0, 0); }
}
template <int VB>
__device__ __forceinline__ void pv_tile(f32x16* o, int vb0, bf16x8 pa0, bf16x8 pa1, bf16x8 pa2, bf16x8 pa3) {
#define TRRD(dst, off) asm volatile("ds_read_b64_tr_b16 %0, %1 offset:%2" : "=&v"(dst) : "v"(vb0), "i"(off) : "memory")
#define PV_D0(d0) do { s16x4 l0, l1, l2, l3, h0, h1, h2, h3; constexpr int b_ = VB * SHM_V + v_rd_off(d0, 0, 0); \
        TRRD(l0, b_); TRRD(h0, b_ + 2048); TRRD(l1, b_ + 4096); TRRD(h1, b_ + 6144); TRRD(l2, b_ + 8192); TRRD(h2, b_ + 10240); TRRD(l3, b_ + 12288); TRRD(h3, b_ + 14336); \
        asm volatile("s_waitcnt lgkmcnt(0)" ::: "memory"); SBAR();   \
        o[d0] = __builtin_amdgcn_mfma_f32_32x32x16_bf16(pa0, (bf16x8){l0[0], l0[1], l0[2], l0[3], h0[0], h0[1], h0[2], h0[3]}, o[d0], 0, 0, 0);   \
        o[d0] = __builtin_amdgcn_mfma_f32_32x32x16_bf16(pa1, (bf16x8){l1[0], l1[1], l1[2], l1[3], h1[0], h1[1], h1[2], h1[3]}, o[d0], 0, 0, 0);   \
        o[d0] = __builtin_amdgcn_mfma_f32_32x32x16_bf16(pa2, (bf16x8){l2[0], l2[1], l2[2], l2[3], h2[0], h2[1], h2[2], h2[3]}, o[d0], 0, 0, 0);   \
        o[d0] = __builtin_amdgcn_mfma_f32_32x32x16_bf16(pa3, (bf16x8){l3[0], l3[1], l3[2], l3[3], h3[0], h3[1], h3[2], h3[3]}, o[d0], 0, 0, 0); } while (0)
    PV_D0(0); PV_D0(1); PV_D0(2); PV_D0(3);
#undef PV_D0
#undef TRRD
}
struct BlockRef { const bf16* Q; const bf16* K; const bf16* V; bf16* O; int P0; };
struct Seam { bf16x8 qr[4]; bf16x8 st_v0, st_v1, st_k0; };
#define VMW() asm volatile("s_waitcnt vmcnt(0)" ::: "memory")
#define VMWN(n) asm volatile("s_waitcnt vmcnt(%0)" :: "i"(n) : "memory")
#define SLOAD_H(Kp, Vp, k0) do { S.st_v0 = load8((Vp) + (size_t)((k0) + sr) * QP + sc); S.st_v1 = load8((Vp) + (size_t)((k0) + 32 + sr) * QP + sc);              \
                                 S.st_k0 = load8((Kp) + (size_t)((k0) + krow) * QP + kc); } while (0)
#define SWRITE_HK(bf) do { *(bf16x8*)(K_lds + (bf) * SHM_K + kws) = S.st_k0; } while (0)
#define SWRITE_HV(bf) do { *(bf16x8*)(V_lds + (bf) * SHM_V + vst0) = S.st_v0; *(bf16x8*)(V_lds + (bf) * SHM_V + vst1) = S.st_v1; } while (0)
#define SWRITE_H(bf) do { SWRITE_HV(bf); SWRITE_HK(bf); } while (0)
__device__ __forceinline__ void attn_prime(const BlockRef& cur, char* lds, Seam& S) {
    const int tid = threadIdx.x, wid = __builtin_amdgcn_readfirstlane(tid >> 6), lane = tid & 63, r32 = lane & 31, hi = lane >> 5;
    const int sr = tid >> 4, sc = (tid & 15) * 8, krow = tid >> 3, kc = (tid & 7) * 8, kws = KSWZ(krow, kc * 2); char* K_lds = lds + 2 * SHM_V;
#pragma unroll
    for (int d0 = 0; d0 < 4; ++d0) S.qr[d0] = load8(cur.Q + (size_t)(wid * QBLK + r32) * QP + d0 * 16 + hi * 8);
    SLOAD_H(cur.K, cur.V, 0); VMW(); SWRITE_HK(0);
    __syncthreads();
}
__device__ __forceinline__ void attn_block(const BlockRef& cur, const BlockRef& nxt, char* lds, Seam& S) {
    const int tid = threadIdx.x, wid = __builtin_amdgcn_readfirstlane(tid >> 6), lane = tid & 63, r32 = lane & 31, hi = lane >> 5;
    const int NT = (cur.P0 + QB - 1) / KVBLK + 1;
    const int qlo = cur.P0 + wid * QBLK, qm = qlo + r32 - 4 * hi;
    char* V_lds = lds; char* K_lds = lds + 2 * SHM_V;
    float* ws = (float*)(lds + 2 * SHM_V + 2 * SHM_K) + wid * 64; float* li_l = ws, * al_l = ws + 32;
    float m_reg = -1e30f, l_reg = 0; f32x16 o[4] = {};
    const int sr = tid >> 4, sc = (tid & 15) * 8, vst0 = v_st(sr, sc), vst1 = v_st(32 + sr, sc);
    const int krow = tid >> 3, kc = (tid & 7) * 8, kws = KSWZ(krow, kc * 2);
    const int vb0 = (int)(uintptr_t)V_lds + v_rd_base(lane);
    const bf16* Kh = cur.K; const bf16* Vh = cur.V;
#define RESC(a) do { if (__any((a) < 1.f)) { if (hi == 0) al_l[r32] = (a); asm volatile("s_waitcnt lgkmcnt(0)" ::: "memory");              \
                     for (int d_ = 0; d_ < 4; ++d_) for (int r = 0; r < 16; ++r) o[d_][r] *= al_l[crow(r, hi)]; } } while (0)
#define KBASE(t) ((t) * KVBLK)
#define MASKT(P0_, P1_, t) do { const int kb_ = KBASE(t); if (kb_ + KVBLK - 1 > qlo) mask_tile(P0_, P1_, qm - kb_); } while (0)
    constexpr int NQL = 4;
#define SEAM_K0() do { VMWN(NQL); SWRITE_HK(0); SBAR(); } while (0)
    f32x16 pA0, pA1, pB0, pB1; float mnA, mnB, alA, alB; bf16x8 pa0, pa1, pa2, pa3;
    SWRITE_HV(0); SBAR();
    SLOAD_H(Kh, Vh, KBASE(1));
    SBAR(); qkt<0>(pA0, pA1, K_lds, r32, hi, S.qr);
    MASKT(pA0, pA1, 0); partialSM(pA0, pA1, m_reg, mnA, alA);
    VMW(); SWRITE_H(1);
    __syncthreads();
#define HALF_STEP(PX0, PX1, mnX, alX, PY0, PY1, alY, t, KB, VB, SB) do {                                                      \
        SBAR(); qkt<KB>(PX0, PX1, K_lds, r32, hi, S.qr);                                             \
        finishSM(PY0, PY1, alY, l_reg, pa0, pa1, pa2, pa3); SBAR();                                                           \
        if ((t) + 1 < NT) { SLOAD_H(Kh, Vh, KBASE((t) + 1)); SBAR(); }                                               \
        pv_tile<VB>(o, vb0, pa0, pa1, pa2, pa3); MASKT(PX0, PX1, (t)); partialSM(PX0, PX1, m_reg, mnX, alX);                                        \
        __syncthreads();                                                                                                      \
        if ((t) + 1 < NT) { VMW(); SWRITE_H(SB); }                                                                          \
        RESC(alX); __syncthreads(); } while (0)
    for (int t = 1; t + 1 < NT; t += 2) {
        HALF_STEP(pB0, pB1, mnB, alB, pA0, pA1, alA, t, 1, 0, 0);
        HALF_STEP(pA0, pA1, mnA, alA, pB0, pB1, alB, t + 1, 0, 1, 1);
    }
    const bool even = (NT & 1) == 0;
    if (even) { SBAR(); qkt<1>(pB0, pB1, K_lds, r32, hi, S.qr); SBAR(); }
    SLOAD_H(nxt.K, nxt.V, 0); SBAR();
#pragma unroll
    for (int d0 = 0; d0 < 4; ++d0) S.qr[d0] = load8(nxt.Q + (size_t)(wid * QBLK + r32) * QP + d0 * 16 + hi * 8);
    SBAR();
    finishSM(pA0, pA1, alA, l_reg, pa0, pa1, pa2, pa3); SBAR();
    pv_tile<0>(o, vb0, pa0, pa1, pa2, pa3);
    if (even) { MASKT(pB0, pB1, NT - 1); partialSM(pB0, pB1, m_reg, mnB, alB); __syncthreads(); RESC(alB);
        finishSM(pB0, pB1, alB, l_reg, pa0, pa1, pa2, pa3); SBAR(); pv_tile<1>(o, vb0, pa0, pa1, pa2, pa3); }
    SBAR(); SEAM_K0();
    if (hi == 0) li_l[r32] = l_reg; asm volatile("s_waitcnt lgkmcnt(0)" ::: "memory");
    float rli[16];
#pragma unroll
    for (int r = 0; r < 16; ++r) rli[r] = __builtin_amdgcn_rcpf(li_l[crow(r, hi)]);
    bf16* Ow = cur.O + (size_t)(wid * QBLK) * OP;
#pragma unroll
    for (int r = 0; r < 16; ++r) { const int orow = crow(r, hi);
#pragma unroll
        for (int d0 = 0; d0 < 4; ++d0) { const float v = o[d0][r] * rli[r];
            const float vn = __shfl_xor(v, 1);
            if ((r32 & 1) == 0) *(unsigned*)(Ow + (size_t)orow * OP + d0 * 32 + r32) = cvtpk(v, vn); } }
    __syncthreads();
#undef RESC
#undef KBASE
#undef MASKT
#undef SEAM_K0
#undef HALF_STEP
}
#undef VMW
#undef VMWN
#undef SLOAD_H
#undef SWRITE_HK
#undef SWRITE_HV
#undef SWRITE_H
#undef KSWZ
__device__ __forceinline__ BlockRef make_ref(int L, int pass, const bf16* Q, const bf16* K, const bf16* V, bf16* O) {
    const int bh = L >> 3, x = L & 7, qb = pass ? 15 - x : x, b = bh >> 5, map = bh & 31;
    const size_t seq0 = (size_t)b * SEQ, row0 = seq0 + (size_t)qb * QB;
    BlockRef r; r.Q = Q + row0 * QP + map * 64; r.K = K + seq0 * QP + map * 64; r.V = V + seq0 * QP + (map >> 1) * 128; r.O = O + row0 * OP + map * 128; r.P0 = qb * QB; return r;
}
__device__ __forceinline__ void attn_phase(char* lds, const bf16* Q, const bf16* K, const bf16* V, bf16* O, int first, int stride) {
    constexpr int total = NB * 32 * 8;
    int L = first; if (L >= total) return;
    int pass = 0;
    BlockRef cur = make_ref(L, 0, Q, K, V, O);
    Seam S;
    attn_prime(cur, lds, S);
    for (;;) {
        const bool more_pass = pass == 0, more_item = L + stride < total, last = !more_pass && !more_item;
        int passn = pass + 1, Ln = L;
        if (!more_pass) { passn = 0; Ln = more_item ? L + stride : L; }
        const BlockRef nxt = last ? cur : make_ref(Ln, passn, Q, K, V, O);
        attn_block(cur, nxt, lds, S);
        if (last) break;
        cur = nxt; pass = passn; L = Ln;
    }
}
}
struct Args { const float* in[29]; float* out; unsigned char* ws; int ph_lo, ph_hi; };
enum { I_X = 0, I_C, I_WADA, I_BADA, I_GPREMIX, I_GPOSTMIX, I_GPREFFN, I_GPOSTFFN, I_WIN, I_CONVW, I_CONVB, I_DTBIAS, I_ALOG, I_DSKIP, I_SSDNW,
       I_LQ1, I_LK1, I_LQ2, I_LK2, I_SUBLN, I_WBS, I_WBA, I_WOUT, I_WR, I_BR, I_WGU, I_BGU, I_WDN, I_BDN };
#define WSP(T, off) ((T*)(a.ws + (off) * MiB))

__device__ __forceinline__ void ph_mod(const Args& a, LAS unsigned char* lds) {
    LAS float* sc = (LAS float*)lds;
    LAS float* part = (LAS float*)(lds + 32768);
    const int tid = threadIdx.x; const float* c = a.in[I_C]; const float* W = a.in[I_WADA]; const float* bada = a.in[I_BADA]; float* mod = WSP(float, WS_MOD);
    for (int i = tid; i < NB * DM; i += NTHR) sc[i] = siluf_(c[i]);
    __syncthreads();
    for (int cb = blockIdx.x; cb < 256; cb += gridDim.x) {
        const int ks = tid / 12, quad = tid % 12;
        f32x4 acc[4] = {{0.f, 0.f, 0.f, 0.f}, {0.f, 0.f, 0.f, 0.f}, {0.f, 0.f, 0.f, 0.f}, {0.f, 0.f, 0.f, 0.f}};
        if (ks < 42) {
#pragma unroll 4
            for (int k = ks; k < DM; k += 42) { const f32x4 w = *(const f32x4*)(W + (size_t)k * 12288 + cb * 48 + quad * 4);
#pragma unroll
                for (int b = 0; b < 4; ++b) acc[b] += w * sc[b * DM + k]; }
#pragma unroll
            for (int b = 0; b < 4; ++b) *(LAS f32x4*)(part + (ks * 12 + quad) * 16 + b * 4) = acc[b];
        }
        __syncthreads();
        if (tid < 192) { const int col = tid % 48, b = tid / 48; float s = 0.f;
            for (int k2 = 0; k2 < 42; ++k2) s += part[(k2 * 12 + (col >> 2)) * 16 + b * 4 + (col & 3)];
            mod[b * 12288 + cb * 48 + col] = s + bada[cb * 48 + col]; }
        __syncthreads();
    }
}

constexpr int TRP = 68;
struct TrSrc { const float* p[4]; bool zero; };
__device__ __forceinline__ const float* tr_src(const float* W, int N, int k0, int d0, int kind, int lane, bool& zero) {
    const int j4 = (lane & 15) * 4; int scol; zero = false;
    if (kind == 0) scol = d0 + j4;
    else if (kind == 1) { const int r = d0 + j4;
        if (r < 5120) scol = r; else if (r < 15360) scol = r + 32; else if (r < 15392) scol = 5120 + (r - 15360); else { scol = 0; zero = true; } }
    else { const int a32 = (d0 >> 6) * 32; scol = (j4 < 32) ? a32 + j4 : 2048 + a32 + (j4 - 32); }
    return W + (size_t)(k0 + (lane >> 4)) * N + scol;
}
__device__ __forceinline__ void tr_load8(const float* src, int N, bool zero, int half, f32x4 (&v)[8]) {
#pragma unroll
    for (int i = 0; i < 8; ++i) v[i] = zero ? (f32x4){0.f, 0.f, 0.f, 0.f} : *(const f32x4*)(src + (size_t)(4 * (8 * half + i)) * N);
}
__device__ __forceinline__ void tr_put8(const f32x4 (&v)[8], int half, LAS bf16* scr, int lane) {
#pragma unroll
    for (int i = 0; i < 8; ++i) { const int k = (lane >> 4) + 4 * (8 * half + i); u32x2 w; w.x = cvt_pk_bf16(v[i][0], v[i][1]); w.y = cvt_pk_bf16(v[i][2], v[i][3]);
        *(LAS u32x2*)(scr + k * TRP + (lane & 15) * 4) = w; }
}
__device__ __forceinline__ void tr_flush(bf16* WT, int K, int k0, int d0, int kind, const LAS bf16* scr, int lane) {
    typedef short v4i16_t __attribute__((ext_vector_type(4)));
    const int g = lane >> 4, i16 = lane & 15, q = (lane >> 2) & 3, pp = lane & 3;
#pragma unroll
    for (int nb = 0; nb < 4; ++nb) { const int lc = 16 * nb + i16;
        const int r = (kind == 2) ? ((lc < 32) ? ((lc >> 2) * 8 + (lc & 3)) : (((lc - 32) >> 2) * 8 + 4 + (lc & 3))) : lc;
#pragma unroll
        for (int j = 0; j < 2; ++j) { const int kc = 8 * (g + 4 * j);
            const LAS bf16* a0 = scr + (kc + q) * TRP + 16 * nb + 4 * pp;
            const v4i16_t lo = __builtin_amdgcn_ds_read_tr16_b64_v4i16((LAS v4i16_t*)a0);
            const v4i16_t hi = __builtin_amdgcn_ds_read_tr16_b64_v4i16((LAS v4i16_t*)(a0 + 4 * TRP));
            u32x4 o; o.x = (unsigned)(unsigned short)lo[0] | ((unsigned)(unsigned short)lo[1] << 16); o.y = (unsigned)(unsigned short)lo[2] | ((unsigned)(unsigned short)lo[3] << 16);
            o.z = (unsigned)(unsigned short)hi[0] | ((unsigned)(unsigned short)hi[1] << 16); o.w = (unsigned)(unsigned short)hi[2] | ((unsigned)(unsigned short)hi[3] << 16);
            *(u32x4*)(WT + (size_t)(d0 + r) * K + k0 + kc) = o; } }
}
__device__ __forceinline__ void tr_flush8(unsigned char* WT, int K, int k0, int d0, int kind, const LAS bf16* scr, int lane) {
    typedef short v4i16_t __attribute__((ext_vector_type(4)));
    const int g = lane >> 4, i16 = lane & 15, q = (lane >> 2) & 3, pp = lane & 3;
#pragma unroll
    for (int nb = 0; nb < 4; ++nb) { const int lc = 16 * nb + i16;
        const int r = (kind == 2) ? ((lc < 32) ? ((lc >> 2) * 8 + (lc & 3)) : (((lc - 32) >> 2) * 8 + 4 + (lc & 3))) : lc;
        const LAS bf16* a0 = scr + (16 * g + q) * TRP + 16 * nb + 4 * pp; unsigned o[4];
#pragma unroll
        for (int j = 0; j < 4; ++j) { const v4i16_t v = __builtin_amdgcn_ds_read_tr16_b64_v4i16((LAS v4i16_t*)(a0 + 4 * j * TRP));
            o[j] = pk4_fp8(bf2f((unsigned short)v[0]) * 64.f, bf2f((unsigned short)v[1]) * 64.f, bf2f((unsigned short)v[2]) * 64.f, bf2f((unsigned short)v[3]) * 64.f); }
        *(u32x4*)(WT + (size_t)(d0 + r) * K + k0 + 16 * g) = (u32x4){o[0], o[1], o[2], o[3]}; }
}
struct TrItem { const float* W; bf16* WT; int N, k0, d0, kind; bool fp8; };
__device__ __forceinline__ bool tr_decode(const Args& a, int it, TrItem& t) {
    constexpr int I_IN = (DM / 64) * (NPROJ / 64), I_SQ = (DM / 64) * (DM / 64), I_GU = (DM / 64) * (4096 / 64), I_DN = I_SQ;
    constexpr int NITEMS = I_IN + 3 * I_SQ + NE * I_GU + NE * I_DN;
    if (it >= NITEMS) return false;
    int r = it;
    if (r < I_IN) { constexpr int nblk = NPROJ / 64; t = TrItem{a.in[I_WIN], WSP(bf16, WS_WT_IN), 15392, 64 * (r / nblk), 64 * (r % nblk), 1, false}; return true; } r -= I_IN;
    if (r < I_SQ) { t = TrItem{a.in[I_WBS], WSP(bf16, WS_WT_BS), DM, 64 * (r / 32), 64 * (r % 32), 0, false}; return true; } r -= I_SQ;
    if (r < I_SQ) { t = TrItem{a.in[I_WBA], WSP(bf16, WS_WT_BA), DM, 64 * (r / 32), 64 * (r % 32), 0, false}; return true; } r -= I_SQ;
    if (r < I_SQ) { t = TrItem{a.in[I_WOUT], WSP(bf16, WS_WT_OUT), DM, 64 * (r / 32), 64 * (r % 32), 0, false}; return true; } r -= I_SQ;
    if (r < NE * I_GU) { const int e = r / I_GU, q = r % I_GU; t = TrItem{a.in[I_WGU] + (size_t)e * DM * 4096, (bf16*)(WSP(unsigned char, WS_WT_GU) + (size_t)e * 4096 * DM), 4096, 64 * (q / 64), 64 * (q % 64), 2, true}; return true; } r -= NE * I_GU;
    { const int e = r / I_DN, q = r % I_DN; t = TrItem{a.in[I_WDN] + (size_t)e * DM * DM, (bf16*)(WSP(unsigned char, WS_WT_DN) + (size_t)e * DM * DM), DM, 64 * (q / 32), 64 * (q % 32), 0, true}; return true; }
}
__device__ __forceinline__ void tr_all(const Args& a, LAS bf16* scr, int gw, int NGW, int lane) {
    TrItem cur; if (!tr_decode(a, gw, cur)) return;
    bool zc; const float* sc = tr_src(cur.W, cur.N, cur.k0, cur.d0, cur.kind, lane, zc);
    f32x4 v0[8], v1[8];
    tr_load8(sc, cur.N, zc, 0, v0);
    for (int it = gw;; ) {
        tr_load8(sc, cur.N, zc, 1, v1);
        tr_put8(v0, 0, scr, lane);
        const int itn = it + NGW; TrItem nxt; const bool more = tr_decode(a, itn, nxt);
        bool zn = zc; const float* sn = sc; if (more) sn = tr_src(nxt.W, nxt.N, nxt.k0, nxt.d0, nxt.kind, lane, zn);
        if (more) tr_load8(sn, nxt.N, zn, 0, v0);
        tr_put8(v1, 1, scr, lane);
        if (cur.fp8) tr_flush8((unsigned char*)cur.WT, DM, cur.k0, cur.d0, cur.kind, scr, lane); else tr_flush(cur.WT, DM, cur.k0, cur.d0, cur.kind, scr, lane);
        if (!more) break;
        cur = nxt; sc = sn; zc = zn; it = itn;
    }
}
__device__ __forceinline__ void sincos_acc(float angf, float& s_out, float& c_out) {
    const double ang = (double)angf; const double twopi = 6.283185307179586476925, inv2pi = 0.159154943091895335769;
    double q = ang * inv2pi; q = q - (double)(long long)(q + 0.5);
    const double r = q * twopi * 0.25, r2 = r * r;
    double s = r * (1.0 + r2 * (-1.0 / 6 + r2 * (1.0 / 120 + r2 * (-1.0 / 5040 + r2 * (1.0 / 362880 + r2 * (-1.0 / 39916800 + r2 * (1.0 / 6227020800.0)))))));
    double c = 1.0 + r2 * (-0.5 + r2 * (1.0 / 24 + r2 * (-1.0 / 720 + r2 * (1.0 / 40320 + r2 * (-1.0 / 3628800 + r2 * (1.0 / 479001600.0))))));
    double s2 = 2 * s * c, c2 = c * c - s * s; s = 2 * s2 * c2; c = c2 * c2 - s2 * s2;
    s_out = (float)s; c_out = (float)c;
}
__device__ __forceinline__ void rms_row_to_bf16(const float* xrow, const float* g, const float* scv, const float* shv, bf16* orow, int lane, float eps) {
    f32x4 v[8]; float s = 0.f;
#pragma unroll
    for (int j = 0; j < 8; ++j) { v[j] = *((const f32x4*)xrow + lane + 64 * j); s += (v[j].x * v[j].x + v[j].y * v[j].y) + (v[j].z * v[j].z + v[j].w * v[j].w); }
    const float rstd = 1.0f / sqrtf(wave_sum(s) * (1.0f / DM) + eps);
#pragma unroll
    for (int j = 0; j < 8; ++j) { const int o4 = lane + 64 * j; const f32x4 gg = *((const f32x4*)g + o4), s1 = *((const f32x4*)scv + o4), s0 = *((const f32x4*)shv + o4);
        const f32x4 y = v[j] * rstd * gg * (s1 + 1.0f) + s0;
        u32x2 w; w.x = pk2(y.x, y.y); w.y = pk2(y.z, y.w); *((u32x2*)orow + o4) = w; }
}
__device__ __forceinline__ void ph_prep(const Args& a, LAS unsigned char* lds, int vcu, int G) {
    const int tid = threadIdx.x, lane = tid & 63, wave = __builtin_amdgcn_readfirstlane(tid >> 6);
    const int gw = vcu * NWAVES + wave, NGW = G * NWAVES, gt = vcu * NTHR + tid, NGT = G * NTHR;
    const float* mod = WSP(float, WS_MOD);
    { float* rope = WSP(float, WS_ROPE);
      const float invf[8] = {1.0f, 0.19392274f, 0.03760603f, 0.0072926646f, 0.0014142136f, 0.0002742482f, 5.3182957e-05f, 1.0313385e-05f};
      for (int i = gt; i < SEQ * 8; i += NGT) { const int pos = i >> 3, j = i & 7; float fr_ = 1.0f;
#pragma unroll
          for (int q = 0; q < 8; ++q) fr_ = (j == q) ? invf[q] : fr_;
          const float ang = (float)pos * fr_; float s, c; sincos_acc(ang, s, c); rope[pos * 16 + j] = c; rope[pos * 16 + 8 + j] = s; } }
    { float* wr = WSP(float, WS_WR); const float* Wr = a.in[I_WR]; const float* g = a.in[I_GPREFFN];
      for (int i = gt; i < NB * DM * NE; i += NGT) { const int b = i / (DM * NE), r = i % (DM * NE), k = r / NE; wr[i] = g[k] * (1.0f + mod[b * 12288 + 8192 + k]) * Wr[r]; }
      if (vcu == 0 && tid < NB * NE) { const int b = tid / NE, e = tid % NE; float s = 0.f; for (int k = 0; k < DM; ++k) s += mod[b * 12288 + 6144 + k] * Wr[k * NE + e];
          ((float*)(a.ws + WS_MOD * MiB + MOD_CB))[tid] = s + a.in[I_BR][e]; } }
    { const float* x = a.in[I_X]; bf16* H = WSP(bf16, WS_H); const float* g = a.in[I_GPREMIX];
      for (int m = gw; m < MT; m += NGW) { const int b = m / SEQ; rms_row_to_bf16(x + (size_t)m * DM, g, mod + b * 12288 + 2048, mod + b * 12288, H + (size_t)m * DM, lane, 1e-6f); } }
    tr_all(a, (LAS bf16*)(lds + wave * 16384), gw, NGW, lane);
}

__device__ __forceinline__ void ph_conv(const Args& a, int vcu, int G) {
    const int gt = vcu * NTHR + threadIdx.x, NGT = G * NTHR;
    { const bf16* X = WSP(bf16, WS_XBC); bf16* Y = WSP(bf16, WS_XBCC); const float* cw = a.in[I_CONVW]; const float* cbias = a.in[I_CONVB];
      for (int it = gt; it < (XBCW / 8) * (MT / 64); it += NGT) { const int cg = it % (XBCW / 8), seg = it / (XBCW / 8), c0 = cg * 8, t0 = seg * 64;
          float w[4][8], bb[8];
#pragma unroll
          for (int k = 0; k < 4; ++k) { const f32x4 w0 = *(const f32x4*)(cw + k * XBCW + c0), w1 = *(const f32x4*)(cw + k * XBCW + c0 + 4);
#pragma unroll
              for (int q = 0; q < 4; ++q) { w[k][q] = w0[q]; w[k][4 + q] = w1[q]; } }
          { const f32x4 b0 = *(const f32x4*)(cbias + c0), b1 = *(const f32x4*)(cbias + c0 + 4);
#pragma unroll
            for (int q = 0; q < 4; ++q) { bb[q] = b0[q]; bb[4 + q] = b1[q]; } }
          float hs[3][8];
          const bool seqstart = (t0 % SEQ) == 0;
#pragma unroll
          for (int r = 0; r < 3; ++r) { u32x4 v = {0u, 0u, 0u, 0u}; if (!seqstart) v = *(const u32x4*)(X + (size_t)(t0 - 3 + r) * XBCW + c0);
              hs[r][0] = bflo(v.x); hs[r][1] = bfhi(v.x); hs[r][2] = bflo(v.y); hs[r][3] = bfhi(v.y); hs[r][4] = bflo(v.z); hs[r][5] = bfhi(v.z); hs[r][6] = bflo(v.w); hs[r][7] = bfhi(v.w); }
#pragma unroll 4
          for (int t = 0; t < 64; ++t) { const u32x4 v = *(const u32x4*)(X + (size_t)(t0 + t) * XBCW + c0);
              float xc[8] = {bflo(v.x), bfhi(v.x), bflo(v.y), bfhi(v.y), bflo(v.z), bfhi(v.z), bflo(v.w), bfhi(v.w)}; float y[8];
#pragma unroll
              for (int q = 0; q < 8; ++q) { const float s = bb[q] + w[0][q] * hs[0][q] + w[1][q] * hs[1][q] + w[2][q] * hs[2][q] + w[3][q] * xc[q]; y[q] = siluf_(s); hs[0][q] = hs[1][q]; hs[1][q] = hs[2][q]; hs[2][q] = xc[q]; }
              u32x4 o; o.x = pk2(y[0], y[1]); o.y = pk2(y[2], y[3]); o.z = pk2(y[4], y[5]); o.w = pk2(y[6], y[7]);
              *(u32x4*)(Y + (size_t)(t0 + t) * XBCW + c0) = o; } } }
    { const float* dr = WSP(float, WS_DTRAW); float* dt = WSP(float, WS_DT); const float* bias = a.in[I_DTBIAS];
      for (int i = gt; i < MT * 32; i += NGT) { const float x = dr[i] + bias[i & 31]; dt[i] = (x > 20.f) ? x : log1pf(__expf(x)); } }
    { const float* rope = WSP(float, WS_ROPE);
      for (int it = gt; it < MT * 32 * 2; it += NGT) { const int which = it / (MT * 32), r = it % (MT * 32), t = r >> 5, hd = r & 31; bf16* p = (which ? WSP(bf16, WS_K) : WSP(bf16, WS_Q)) + (size_t)t * DM + hd * 64;
          const u32x4 v1 = *(const u32x4*)p, v2 = *(const u32x4*)(p + 8); const float* rp = rope + (t % SEQ) * 16;
          const f32x4 c0 = *(const f32x4*)rp, c1 = *(const f32x4*)(rp + 4), s0 = *(const f32x4*)(rp + 8), s1 = *(const f32x4*)(rp + 12);
          const float x1[8] = {bflo(v1.x), bfhi(v1.x), bflo(v1.y), bfhi(v1.y), bflo(v1.z), bfhi(v1.z), bflo(v1.w), bfhi(v1.w)};
          const float x2[8] = {bflo(v2.x), bfhi(v2.x), bflo(v2.y), bfhi(v2.y), bflo(v2.z), bfhi(v2.z), bflo(v2.w), bfhi(v2.w)};
          const float cc[8] = {c0[0], c0[1], c0[2], c0[3], c1[0], c1[1], c1[2], c1[3]}, ss[8] = {s0[0], s0[1], s0[2], s0[3], s1[0], s1[1], s1[2], s1[3]};
          float y1[8], y2[8];
#pragma unroll
          for (int q = 0; q < 8; ++q) { y1[q] = x1[q] * cc[q] - x2[q] * ss[q]; y2[q] = x2[q] * cc[q] + x1[q] * ss[q]; }
          u32x4 o1, o2; o1.x = pk2(y1[0], y1[1]); o1.y = pk2(y1[2], y1[3]); o1.z = pk2(y1[4], y1[5]); o1.w = pk2(y1[6], y1[7]);
          o2.x = pk2(y2[0], y2[1]); o2.y = pk2(y2[2], y2[3]); o2.z = pk2(y2[4], y2[5]); o2.w = pk2(y2[6], y2[7]);
          *(u32x4*)p = o1; *(u32x4*)(p + 8) = o2; } }
}
constexpr int SP = 136;
#define SSD_FRAG(base, row, k0) (*(const LAS bf16x8*)((base) + (row) * SP + (k0)))
template <bool ALSO_T> __device__ __forceinline__ void ssd_stage128(const bf16* X, int t0, int col0, LAS bf16* dst, LAS bf16* dstT, int tid) {
#pragma unroll
    for (int i = 0; i < 4; ++i) { const int q = tid + NTHR * i, row = q >> 4, ch = q & 15;
        const u32x4 v = *(const u32x4*)(X + (size_t)(t0 + row) * XBCW + col0 + ch * 8);
        *(LAS u32x4*)(dst + row * SP + ch * 8) = v;
        if constexpr (ALSO_T) { const unsigned w[4] = {v.x, v.y, v.z, v.w};
#pragma unroll
            for (int j = 0; j < 4; ++j) { dstT[(ch * 8 + 2 * j) * SP + row] = (bf16)(w[j] & 0xffffu); dstT[(ch * 8 + 2 * j + 1) * SP + row] = (bf16)(w[j] >> 16); } } }
}
__device__ __forceinline__ void ph_ssd1(const Args& a, LAS unsigned char* lds, int first, int stride) {
    const int tid = threadIdx.x, lane = tid & 63, w = __builtin_amdgcn_readfirstlane(tid >> 6), l15 = lane & 15, lq = lane >> 4;
    LAS bf16* R1 = (LAS bf16*)lds;
    LAS bf16* R2 = (LAS bf16*)(lds + 34816);
    LAS bf16* R3 = (LAS bf16*)(lds + 69632);
    LAS float* acs = (LAS float*)(lds + 104448);
    LAS float* dts = (LAS float*)(lds + 108544);
    const bf16* X = WSP(bf16, WS_XBCC); const float* DT = WSP(float, WS_DT); float* ACS = WSP(float, WS_ACS); float* YD = WSP(float, WS_YDIAG); float* ST = WSP(float, WS_STATES);
    for (int u = first; u < NB * 32 * 4; u += stride) {
        const int g = u & 3, bc = u >> 2, t0 = bc * 128;
        ssd_stage128<false>(X, t0, 2560 + g * 128, R1, nullptr, tid);
        ssd_stage128<true>(X, t0, 2048 + g * 128, R2, R3, tid);
        { const int h = g * 8 + w; const float Ah = -__expf(a.in[I_ALOG][h]);
          const float d0 = DT[(size_t)(t0 + 2 * lane) * 32 + h], d1 = DT[(size_t)(t0 + 2 * lane + 1) * 32 + h];
          const float a0 = d0 * Ah, a1 = d1 * Ah; float s = a0 + a1;
#pragma unroll
          for (int o = 1; o < 64; o <<= 1) { const float t = __shfl_up(s, o); if (lane >= o) s += t; }
          acs[w * 128 + 2 * lane] = s - a1; acs[w * 128 + 2 * lane + 1] = s; dts[w * 128 + 2 * lane] = d0; dts[w * 128 + 2 * lane + 1] = d1;
          float* ag = ACS + ((size_t)bc * 32 + h) * 128; ag[2 * lane] = s - a1; ag[2 * lane + 1] = s; }
        __syncthreads();
        f32x4 S[8];
#pragma unroll
        for (int mt = 0; mt < 8; ++mt) { S[mt] = (f32x4){0.f, 0.f, 0.f, 0.f};
#pragma unroll
            for (int ks = 0; ks < 4; ++ks) S[mt] = __builtin_amdgcn_mfma_f32_16x16x32_bf16(SSD_FRAG(R2, 16 * mt + l15, 32 * ks + 8 * lq), SSD_FRAG(R1, 16 * w + l15, 32 * ks + 8 * lq), S[mt], 0, 0, 0); }
        __syncthreads();
        LAS bf16* G = R1; LAS bf16* Xt = R2; LAS bf16* Xwt = R2 + 64 * SP;
#pragma unroll 1
        for (int hh = 0; hh < 8; ++hh) {
            const int h = g * 8 + hh; const LAS float* ac = acs + hh * 128; const float aend = ac[127];
#pragma unroll
            for (int i = 0; i < 2; ++i) { const int q = tid + NTHR * i, l = q >> 3, ch = q & 7;
                const u32x4 v = *(const u32x4*)(X + (size_t)(t0 + l) * XBCW + h * 64 + ch * 8); const float dl = dts[hh * 128 + l], wl = dl * __expf(aend - ac[l]);
                const float xv[8] = {bflo(v.x), bfhi(v.x), bflo(v.y), bfhi(v.y), bflo(v.z), bfhi(v.z), bflo(v.w), bfhi(v.w)};
#pragma unroll
                for (int j = 0; j < 8; ++j) { Xt[(ch * 8 + j) * SP + l] = (bf16)f2bf(xv[j] * dl); Xwt[(ch * 8 + j) * SP + l] = (bf16)f2bf(xv[j] * wl); } }
            { const int l = 16 * w + l15; const float al = ac[l];
#pragma unroll
              for (int mt = 0; mt < 8; ++mt) { float gv[4];
#pragma unroll
                  for (int r = 0; r < 4; ++r) { const int s = 16 * mt + 4 * lq + r; gv[r] = (s <= l) ? S[mt][r] * __expf(al - ac[s]) : 0.f; }
                  u32x2 pk; pk.x = pk2(gv[0], gv[1]); pk.y = pk2(gv[2], gv[3]);
                  *(LAS u32x2*)(G + l * SP + 16 * mt + 4 * lq) = pk; } }
            __syncthreads();
#pragma unroll
            for (int pt = 0; pt < 4; ++pt) { f32x4 acc = {0.f, 0.f, 0.f, 0.f};
#pragma unroll
                for (int ks = 0; ks < 4; ++ks) acc = __builtin_amdgcn_mfma_f32_16x16x32_bf16(SSD_FRAG(Xt, 16 * pt + l15, 32 * ks + 8 * lq), SSD_FRAG(G, 16 * w + l15, 32 * ks + 8 * lq), acc, 0, 0, 0);
                *(f32x4*)(YD + (size_t)(t0 + 16 * w + l15) * DM + h * 64 + 16 * pt + 4 * lq) = acc; }
#pragma unroll
            for (int pt = 0; pt < 4; ++pt) { f32x4 acc = {0.f, 0.f, 0.f, 0.f};
#pragma unroll
                for (int ks = 0; ks < 4; ++ks) acc = __builtin_amdgcn_mfma_f32_16x16x32_bf16(SSD_FRAG(R3, 16 * w + l15, 32 * ks + 8 * lq), SSD_FRAG(Xwt, 16 * pt + l15, 32 * ks + 8 * lq), acc, 0, 0, 0);
                *(f32x4*)(ST + (((size_t)bc * 32 + h) * 64 + 16 * pt + l15) * 128 + 16 * w + 4 * lq) = acc; }
            __syncthreads();
        }
    }
}
__device__ __forceinline__ void ph_ssd2(const Args& a, int vcu, int G) {
    const int gt = vcu * NTHR + threadIdx.x, NGT = G * NTHR; float* ST = WSP(float, WS_STATES); const float* ACS = WSP(float, WS_ACS);
    for (int it = gt; it < NB * 32 * 2048; it += NGT) { const int q = it & 2047, bh = it >> 11, b = bh >> 5, h = bh & 31;
        f32x4 run = {0.f, 0.f, 0.f, 0.f};
#pragma unroll 4
        for (int c = 0; c < 32; ++c) { const size_t bc = (size_t)b * 32 + c; f32x4* p = (f32x4*)(ST + (bc * 32 + h) * 8192) + q; const f32x4 s = *p; const float dec = __expf(ACS[(bc * 32 + h) * 128 + 127]);
            *p = run; run = run * dec + s; } }
}
__device__ __forceinline__ void ph_ssd3(const Args& a, LAS unsigned char* lds, int first, int stride) {
    const int tid = threadIdx.x, lane = tid & 63, w = __builtin_amdgcn_readfirstlane(tid >> 6), l15 = lane & 15, lq = lane >> 4;
    LAS bf16* Cs = (LAS bf16*)lds; LAS bf16* Pv = (LAS bf16*)(lds + 34816); LAS float* acs = (LAS float*)(lds + 104448);
    const bf16* X = WSP(bf16, WS_XBCC); const float* ACS = WSP(float, WS_ACS); const float* YD = WSP(float, WS_YDIAG); const float* ST = WSP(float, WS_STATES);
    const bf16* Z = WSP(bf16, WS_Z); bf16* YB = WSP(bf16, WS_YBUF); const float* dskip = a.in[I_DSKIP]; const float* nw = a.in[I_SSDNW];
    for (int u = first; u < NB * 32 * 4; u += stride) {
        const int g = u & 3, bc = u >> 2, t0 = bc * 128;
        ssd_stage128<false>(X, t0, 2560 + g * 128, Cs, nullptr, tid);
#pragma unroll
        for (int i = 0; i < 2; ++i) { const int q = tid + NTHR * i; acs[q] = ACS[((size_t)bc * 32 + g * 8 + (q >> 7)) * 128 + (q & 127)]; }
        __syncthreads();
        const int l = 16 * w + l15; const size_t t = (size_t)t0 + l; float ss = 0.f;
#pragma unroll 1
        for (int hh = 0; hh < 8; ++hh) {
            const int h = g * 8 + hh;
#pragma unroll
            for (int i = 0; i < 4; ++i) { const int q = tid + NTHR * i, p = q >> 5, n4 = (q & 31) * 4;
                const f32x4 v = *(const f32x4*)(ST + ((size_t)bc * 32 + h) * 8192 + p * 128 + n4); u32x2 pk; pk.x = pk2(v[0], v[1]); pk.y = pk2(v[2], v[3]);
                *(LAS u32x2*)(Pv + p * SP + n4) = pk; }
            __syncthreads();
            const float ea = __expf(acs[hh * 128 + l]), dsk = dskip[h];
#pragma unroll
            for (int pt = 0; pt < 4; ++pt) { f32x4 acc = {0.f, 0.f, 0.f, 0.f};
#pragma unroll
                for (int ks = 0; ks < 4; ++ks) acc = __builtin_amdgcn_mfma_f32_16x16x32_bf16(SSD_FRAG(Pv, 16 * pt + l15, 32 * ks + 8 * lq), SSD_FRAG(Cs, 16 * w + l15, 32 * ks + 8 * lq), acc, 0, 0, 0);
                const int col = h * 64 + 16 * pt + 4 * lq;
                const f32x4 yd = *(const f32x4*)(YD + t * DM + col); const u32x2 xs = *(const u32x2*)(X + t * XBCW + col), zz = *(const u32x2*)(Z + t * DM + col);
                const float xv[4] = {bflo(xs.x), bfhi(xs.x), bflo(xs.y), bfhi(xs.y)}, zv[4] = {bflo(zz.x), bfhi(zz.x), bflo(zz.y), bfhi(zz.y)}; float uu[4];
#pragma unroll
                for (int r = 0; r < 4; ++r) { const float y = yd[r] + ea * acc[r] + dsk * xv[r]; uu[r] = y * siluf_(zv[r]); ss += uu[r] * uu[r]; }
                u32x2 pk; pk.x = pk2(uu[0], uu[1]); pk.y = pk2(uu[2], uu[3]); *(u32x2*)(YB + t * DM + col) = pk; }
            __syncthreads();
        }
        ss += __shfl_xor(ss, 16); ss += __shfl_xor(ss, 32);
        const float rstd = 1.0f / sqrtf(ss * (1.0f / 512.0f) + 1e-5f);
        VM_WAIT();
#pragma unroll 1
        for (int hh = 0; hh < 8; ++hh)
#pragma unroll
            for (int pt = 0; pt < 4; ++pt) { const int col = (g * 8 + hh) * 64 + 16 * pt + 4 * lq; u32x2* p = (u32x2*)(YB + t * DM + col); const u32x2 v = *p; const f32x4 wv = *(const f32x4*)(nw + col);
                u32x2 pk; pk.x = pk2(bflo(v.x) * rstd * wv[0], bfhi(v.x) * rstd * wv[1]); pk.y = pk2(bflo(v.y) * rstd * wv[2], bfhi(v.y) * rstd * wv[3]); *p = pk; }
        __syncthreads();
    }
}
__device__ __forceinline__ void ph_attn_combine(const Args& a, int vcu, int G) {
    const int tid = threadIdx.x, lane = tid & 63, wave = __builtin_amdgcn_readfirstlane(tid >> 6), gw = vcu * NWAVES + wave, NGW = G * NWAVES;
    float d1 = a.in[I_LQ1][lane] * a.in[I_LK1][lane], d2 = a.in[I_LQ2][lane] * a.in[I_LK2][lane]; d1 = wave_sum(d1); d2 = wave_sum(d2);
    const float lam = __expf(d1) - __expf(d2) + 0.2f;
    const bf16* OA = WSP(bf16, WS_OATT); bf16* OF = WSP(bf16, WS_OFIN); const float* sw = a.in[I_SUBLN];
    const int head = lane >> 2, dq = (lane & 3) * 32;
    for (int m = gw; m < MT; m += NGW) { const bf16* p0 = OA + (size_t)m * 4096 + (2 * head) * 128 + dq; const bf16* p1 = p0 + 128; float d[32]; float ss = 0.f;
#pragma unroll
        for (int i = 0; i < 4; ++i) { const u32x4 x = *(const u32x4*)(p0 + 8 * i), y = *(const u32x4*)(p1 + 8 * i);
            const unsigned xa[4] = {x.x, x.y, x.z, x.w}, ya[4] = {y.x, y.y, y.z, y.w};
#pragma unroll
            for (int j = 0; j < 4; ++j) { const float v0 = bflo(xa[j]) - lam * bflo(ya[j]), v1 = bfhi(xa[j]) - lam * bfhi(ya[j]); d[8 * i + 2 * j] = v0; d[8 * i + 2 * j + 1] = v1; ss += v0 * v0 + v1 * v1; } }
        ss += __shfl_xor(ss, 1); ss += __shfl_xor(ss, 2);
        const float rstd = 0.8f / sqrtf(ss * (1.0f / 128.0f) + 1e-5f);
        bf16* o = OF + (size_t)m * DM + head * 128 + dq;
#pragma unroll
        for (int i = 0; i < 4; ++i) { const f32x4 w0 = *(const f32x4*)(sw + dq + 8 * i), w1 = *(const f32x4*)(sw + dq + 8 * i + 4);
            u32x4 pk; pk.x = pk2(d[8 * i] * rstd * w0[0], d[8 * i + 1] * rstd * w0[1]); pk.y = pk2(d[8 * i + 2] * rstd * w0[2], d[8 * i + 3] * rstd * w0[3]);
            pk.z = pk2(d[8 * i + 4] * rstd * w1[0], d[8 * i + 5] * rstd * w1[1]); pk.w = pk2(d[8 * i + 6] * rstd * w1[2], d[8 * i + 7] * rstd * w1[3]);
            *(u32x4*)(o + 8 * i) = pk; } }
}
__device__ __forceinline__ void ph_rows1(const Args& a, int vcu, int G) {
    const int tid = threadIdx.x, lane = tid & 63, wave = __builtin_amdgcn_readfirstlane(tid >> 6), gw = vcu * NWAVES + wave, NGW = G * NWAVES;
    const float* mod = WSP(float, WS_MOD); const float* x = a.in[I_X]; const float* mix = WSP(float, WS_MIX); float* X1 = WSP(float, WS_X1); unsigned char* H2 = WSP(unsigned char, WS_H2); float* RS = WSP(float, WS_RSTD);
    const float* gpm = a.in[I_GPOSTMIX]; const float* gpf = a.in[I_GPREFFN];
    for (int m = gw; m < MT; m += NGW) { const int b = m / SEQ; const float* mb = mod + b * 12288;
        f32x4 v[8]; float s = 0.f;
#pragma unroll
        for (int j = 0; j < 8; ++j) { v[j] = *((const f32x4*)(mix + (size_t)m * DM) + lane + 64 * j); s += (v[j].x * v[j].x + v[j].y * v[j].y) + (v[j].z * v[j].z + v[j].w * v[j].w); }
        const float rstdm = 1.0f / sqrtf(wave_sum(s) * (1.0f / DM) + 1e-6f); float s1 = 0.f;
#pragma unroll
        for (int j = 0; j < 8; ++j) { const int o4 = lane + 64 * j; const f32x4 xx = *((const f32x4*)(x + (size_t)m * DM) + o4), gg = *((const f32x4*)gpm + o4), gt = *((const f32x4*)(mb + 4096) + o4);
            v[j] = xx + gt * (v[j] * rstdm * gg); *((f32x4*)(X1 + (size_t)m * DM) + o4) = v[j]; s1 += (v[j].x * v[j].x + v[j].y * v[j].y) + (v[j].z * v[j].z + v[j].w * v[j].w); }
        const float rstd1 = 1.0f / sqrtf(wave_sum(s1) * (1.0f / DM) + 1e-6f);
        if (lane == 0) RS[m] = rstd1;
#pragma unroll
        for (int j = 0; j < 8; ++j) { const int o4 = lane + 64 * j; const f32x4 gg = *((const f32x4*)gpf + o4), sc = *((const f32x4*)(mb + 8192) + o4), sh = *((const f32x4*)(mb + 6144) + o4);
            const f32x4 y = v[j] * rstd1 * gg * (sc + 1.0f) + sh; *((unsigned*)(H2 + (size_t)m * DM) + o4) = pk4_fp8(y.x, y.y, y.z, y.w); } }
}
__device__ __forceinline__ void ph_router(const Args& a, LAS unsigned char* lds, int first, int stride) {
    const int tid = threadIdx.x, lane = tid & 63, w = __builtin_amdgcn_readfirstlane(tid >> 6), r32 = lane & 31, hi = lane >> 5;
    LAS float* part = (LAS float*)lds;
    LAS float* lg = (LAS float*)(lds + 8 * 32 * 33 * 4);
    const float* X1 = WSP(float, WS_X1); const float* WR = WSP(float, WS_WR); const float* RS = WSP(float, WS_RSTD); const float* CB = (const float*)(a.ws + WS_MOD * MiB + MOD_CB);
    unsigned* cnt = (unsigned*)(a.ws + WS_CTL * MiB) + CW_CNT;
    int* ltok = (int*)(a.ws + WS_LISTS * MiB); float* lw = (float*)(a.ws + WS_LISTS * MiB + LIST_STRIDE); int* ldst = (int*)(a.ws + WS_LISTS * MiB + 2 * LIST_STRIDE);
    for (int tile = first; tile < MT / 32; tile += stride) {
        const int tok0 = tile * 32, b = tok0 / SEQ; const int kb = w * 256;
        const float* xr = X1 + (size_t)(tok0 + r32) * DM + kb; const float* wb = WR + ((size_t)b * DM + kb) * NE;
        f32x16 acc = {};
#pragma unroll 4
        for (int q = 0; q < 64; ++q) { const f32x4 xv = *(const f32x4*)(xr + 4 * q);
            const float a0 = hi ? xv[1] : xv[0], a1 = hi ? xv[3] : xv[2];
            const float b0 = wb[(4 * q + hi) * NE + r32], b1 = wb[(4 * q + 2 + hi) * NE + r32];
            acc = __builtin_amdgcn_mfma_f32_32x32x2f32(a0, b0, acc, 0, 0, 0);
            acc = __builtin_amdgcn_mfma_f32_32x32x2f32(a1, b1, acc, 0, 0, 0); }
#pragma unroll
        for (int r = 0; r < 16; ++r) part[(w * 32 + (r & 3) + 8 * (r >> 2) + 4 * hi) * 33 + r32] = acc[r];
        __syncthreads();
#pragma unroll
        for (int i = 0; i < 2; ++i) { const int o = tid + NTHR * i, tk = o >> 5, e = o & 31; float s = 0.f;
#pragma unroll
            for (int ww = 0; ww < 8; ++ww) s += part[(ww * 32 + tk) * 33 + e];
            lg[tk * 33 + e] = s * RS[tok0 + tk] + CB[b * NE + e]; }
        __syncthreads();
        if (tid < 32) { const int tk = tok0 + tid; float v[4]; int ix[4]; unsigned used = 0u;
#pragma unroll
            for (int k = 0; k < 4; ++k) { float best = -__builtin_inff(); int bi = 0;
                for (int e = 0; e < NE; ++e) { const float x = lg[tid * 33 + e]; if (!((used >> e) & 1u) && x > best) { best = x; bi = e; } }
                v[k] = best; ix[k] = bi; used |= 1u << bi; }
            float p[4], sum = 0.f;
#pragma unroll
            for (int k = 0; k < 4; ++k) { p[k] = __expf(v[k] - v[0]); sum += p[k]; }
            const float inv = 1.0f / sum;
#pragma unroll
            for (int k = 0; k < 4; ++k) { const int e = ix[k]; const unsigned pos = __hip_atomic_fetch_add(cnt + 64 * e, 1u, RLX_AGENT);
                ltok[e * 16384 + pos] = tk; lw[e * 16384 + pos] = p[k] * inv; ldst[e * 16384 + pos] = tk * 4 + k; } }
        __syncthreads();
    }
}
__device__ __forceinline__ void ph_final(const Args& a, int vcu, int G) {
    const int tid = threadIdx.x, lane = tid & 63, wave = __builtin_amdgcn_readfirstlane(tid >> 6), gw = vcu * NWAVES + wave, NGW = G * NWAVES;
    const float* mod = WSP(float, WS_MOD); const float* X1 = WSP(float, WS_X1); const bf16* YS = WSP(bf16, WS_YS); const float* gp = a.in[I_GPOSTFFN];
    for (int m = gw; m < MT; m += NGW) { const int b = m / SEQ; const float* mb = mod + b * 12288;
        f32x4 f[8]; float s = 0.f;
#pragma unroll
        for (int j = 0; j < 8; ++j) { f[j] = (f32x4){0.f, 0.f, 0.f, 0.f};
#pragma unroll
            for (int k = 0; k < 4; ++k) { const u32x2 v = *((const u32x2*)(YS + ((size_t)m * 4 + k) * DM) + lane + 64 * j); f[j] += (f32x4){bflo(v.x), bfhi(v.x), bflo(v.y), bfhi(v.y)}; }
            s += (f[j].x * f[j].x + f[j].y * f[j].y) + (f[j].z * f[j].z + f[j].w * f[j].w); }
        const float rstd = 1.0f / sqrtf(wave_sum(s) * (1.0f / DM) + 1e-6f);
#pragma unroll
        for (int j = 0; j < 8; ++j) { const int o4 = lane + 64 * j; const f32x4 xx = *((const f32x4*)(X1 + (size_t)m * DM) + o4), gg = *((const f32x4*)gp + o4), gt = *((const f32x4*)(mb + 10240) + o4);
            *((f32x4*)(a.out + (size_t)m * DM) + o4) = xx + gt * (f[j] * rstd * gg); } }
}
__device__ __forceinline__ void moe_table(const Args& a, LAS unsigned char* lds) {
    LAS int* tab = (LAS int*)(lds + TAB_OFF); const unsigned* cnt = (const unsigned*)(a.ws + WS_CTL * MiB) + CW_CNT;
    __syncthreads();
    if (threadIdx.x < 32) tab[threadIdx.x] = (int)__hip_atomic_load(cnt + 64 * threadIdx.x, RLX_AGENT);
    __syncthreads();
    if (threadIdx.x == 0) { int s = 0; for (int e = 0; e < 32; ++e) { tab[32 + e] = s; s += (tab[e] + 255) >> 8; } tab[64] = s; }
    __syncthreads();
}

__global__ void __launch_bounds__(NTHR, 2) hybrid_fwd(Args a0) {
    typedef const __attribute__((address_space(4))) Args* kargp_t;
    Args a = a0;
#if defined(__HIP_DEVICE_COMPILE__)
#define ARGS() do { kargp_t q_ = (kargp_t)__builtin_amdgcn_kernarg_segment_ptr(); asm volatile("" : "+s"(q_)); a = *q_; } while (0)
#else
#define ARGS() do { } while (0)
#endif
    extern __shared__ __attribute__((aligned(16))) unsigned char lds_raw[];
    LAS unsigned char* lds = (LAS unsigned char*)lds_raw;
    volatile LAS unsigned* MISC = (volatile LAS unsigned*)(lds + MISC_OFF);
    const int tid = threadIdx.x; const int G = gridDim.x; const int bx = blockIdx.x;
    const int vcu = (G % 8 == 0) ? (bx % 8) * (G / 8) + bx / 8 : bx;
    for (int u = tid; u < (LDS_BYTES - MISC_OFF) / 4; u += NTHR) ((LAS unsigned*)(lds + MISC_OFF))[u] = 0u;
    __syncthreads();
    unsigned* ctl = (unsigned*)(a.ws + WS_CTL * MiB);
    XcdBarrier bar; bar.bar = ctl + CW_BAR; bar.x = 0; bar.st = nullptr;
    const int lo = a.ph_lo, hi = a.ph_hi;
    const bool fused = (hi - lo) > 1;
    if (fused) bar = xcd_barrier_post(ctl + CW_BAR, MISC + 8);
#ifndef ONLY_PHASE
#define ONLY_PHASE -1
#endif
#define IN(k) ((ONLY_PHASE < 0 || ONLY_PHASE == (k)) && lo <= (k) && (k) < hi)
#define REPEAT(n, body) do { body; if constexpr ((n) > 1) { if (fused) xcd_barrier(bar); else __syncthreads(); body; } } while (0)
#define SEAM(k) do { if (IN(k) && IN((k) + 1)) xcd_barrier(bar); } while (0)

    if (IN(0)) { ARGS(); REPEAT(REP_MOD, ph_mod(a, lds)); } SEAM(0);
    if (IN(1)) { ARGS(); REPEAT(REP_PREP, ph_prep(a, lds, vcu, G)); } SEAM(1);
    if (IN(2)) { ARGS();
        pg8::ProbDense P; P.init(WSP(bf16, WS_H), WSP(bf16, WS_WT_IN), MT, NPROJ, DM, G, bx);
        pg8::EpiInProj E{a.ws};
        REPEAT(REP_INPROJ, (pg8::gemm_phase<pg8::EpiInProj, pg8::ProbDense, true, false, 127, KREP_IN, EREP_IN>(lds, P, E)));
    } SEAM(2);
    if (IN(3)) { ARGS(); ph_conv(a, vcu, G); } SEAM(3);
    if (IN(4)) { ARGS();
        REPEAT(REP_SSD1, ph_ssd1(a, lds, bx, G));
        __syncthreads();
        REPEAT(REP_ATTN, att::attn_phase((char*)lds_raw, WSP(bf16, WS_Q), WSP(bf16, WS_K), WSP(bf16, WS_V), WSP(bf16, WS_OATT), bx, G));
    } SEAM(4);
    if (IN(5)) { ARGS(); ph_ssd2(a, vcu, G); REPEAT(REP_COMB, ph_attn_combine(a, vcu, G)); } SEAM(5);
    if (IN(6)) { ARGS(); REPEAT(REP_SSD3, ph_ssd3(a, lds, bx, G)); } SEAM(6);
    if (IN(7)) { ARGS();
#define BR_BODY do { \
        { pg8::ProbDense P; P.init(WSP(bf16, WS_YBUF), WSP(bf16, WS_WT_BS), MT, DM, DM, G, bx); \
          pg8::EpiBr1 E{WSP(bf16, WS_SGS), WSP(float, WS_M1)}; \
          pg8::gemm_phase<pg8::EpiBr1, pg8::ProbDense, true>(lds, P, E); } \
        __syncthreads(); \
        { pg8::ProbDense P; P.init(WSP(bf16, WS_OFIN), WSP(bf16, WS_WT_BA), MT, DM, DM, G, bx); \
          pg8::EpiBr2 E{WSP(bf16, WS_SGA), WSP(float, WS_M1), WSP(bf16, WS_MERGED)}; \
          pg8::gemm_phase<pg8::EpiBr2, pg8::ProbDense, true>(lds, P, E); } } while (0)
        REPEAT(REP_BR, BR_BODY);
#undef BR_BODY
    } SEAM(7);
    if (IN(8)) { ARGS();
        pg8::ProbDense P; P.init(WSP(bf16, WS_MERGED), WSP(bf16, WS_WT_OUT), MT, DM, DM, G, bx);
        pg8::EpiF32 E{WSP(float, WS_MIX), DM};
        REPEAT(REP_OUT, (pg8::gemm_phase<pg8::EpiF32, pg8::ProbDense, true>(lds, P, E)));
    } SEAM(8);
    if (IN(9)) { ARGS(); REPEAT(REP_ROWS1, ph_rows1(a, vcu, G)); } SEAM(9);
    if (IN(10)) { ARGS(); ph_router(a, lds, bx, G); } SEAM(10);
    if (IN(11)) { ARGS();
        moe_table(a, lds);
        pg8::ProbMoE<true> P; P.A = (const char*)WSP(bf16, WS_H2); P.Bt = (const char*)WSP(bf16, WS_WT_GU); P.rb = DM; P.nN = 16; P.estride = (size_t)4096 * DM;
        P.list_tok = (const int*)(a.ws + WS_LISTS * MiB); P.tab = (const LAS int*)(lds + TAB_OFF); P.G = G; P.c = vcu;
        pg8::EpiGateUp E{a.in[I_BGU], WSP(unsigned char, WS_ACT)};
        REPEAT(REP_GU, (pg8::gemm_phase<pg8::EpiGateUp, pg8::ProbMoE<true>, true, true, 127, KREP_GU, EREP_GU>(lds, P, E)));
    } SEAM(11);
    if (IN(12)) { ARGS();
        moe_table(a, lds);
        pg8::ProbMoE<false> P; P.A = (const char*)WSP(bf16, WS_ACT); P.Bt = (const char*)WSP(bf16, WS_WT_DN); P.rb = DM; P.nN = 8; P.estride = (size_t)DM * DM;
        P.list_tok = nullptr; P.tab = (const LAS int*)(lds + TAB_OFF); P.G = G; P.c = vcu;
        pg8::EpiDown E{a.in[I_BDN], (const int*)(a.ws + WS_LISTS * MiB + 2 * LIST_STRIDE), (const float*)(a.ws + WS_LISTS * MiB + LIST_STRIDE), (const LAS int*)(lds + TAB_OFF), WSP(bf16, WS_YS)};
        REPEAT(REP_DN, (pg8::gemm_phase<pg8::EpiDown, pg8::ProbMoE<false>, true, true, 127, KREP_DN, EREP_DN>(lds, P, E)));
    } SEAM(12);
    if (IN(13)) { ARGS(); REPEAT(REP_FINAL, ph_final(a, vcu, G)); }
#undef IN
#undef SEAM
#undef REPEAT
#undef ARGS
}

extern "C" void kernel_launch(void* const* d_in, const int* in_sizes, int n_in, void* d_out, int out_size, void* d_ws, size_t ws_size, hipStream_t stream) {
    static int grid = 0;
    if (grid == 0) {
        if (n_in != 29 || in_sizes[0] != MT * DM || out_size != MT * DM || ws_size < WS_END * MiB) {
            fprintf(stderr, "kernel_launch: unexpected shapes (n_in %d, in0 %d, out %d, ws %zu); nothing launched\n", n_in, n_in > 0 ? in_sizes[0] : -1, out_size, ws_size); grid = -1; return; }
        int dev = 0, cus = 0, per_cu = 0;
        if (hipGetDevice(&dev) != hipSuccess || hipDeviceGetAttribute(&cus, hipDeviceAttributeMultiprocessorCount, dev) != hipSuccess) { grid = -1; return; }
        if (hipFuncSetAttribute((const void*)hybrid_fwd, hipFuncAttributeMaxDynamicSharedMemorySize, LDS_BYTES) != hipSuccess) { fprintf(stderr, "kernel_launch: hipFuncSetAttribute failed\n"); grid = -1; return; }
        if (hipOccupancyMaxActiveBlocksPerMultiprocessor(&per_cu, (const void*)hybrid_fwd, NTHR, LDS_BYTES) != hipSuccess || per_cu < 1)
            fprintf(stderr, "kernel_launch: note: occupancy query reports %d workgroups per CU\n", per_cu);
        (void)hipGetLastError();
        grid = cus;
    }
    if (grid < 0) return;
    (void)hipMemsetAsync((char*)d_ws + WS_CTL * MiB, 0, CTL_ZERO_BYTES, stream);
    Args a{};
    for (int i = 0; i < 29; ++i) a.in[i] = (const float*)d_in[i];
    a.out = (float*)d_out; a.ws = (unsigned char*)d_ws;
#if MK_PER_PHASE
    for (int k = 0; k < NPH; ++k) { a.ph_lo = k; a.ph_hi = k + 1; hipLaunchKernelGGL(hybrid_fwd, dim3(grid), dim3(NTHR), LDS_BYTES, stream, a); }
#else
    a.ph_lo = 0; a.ph_hi = NPH;
    hipLaunchKernelGGL(hybrid_fwd, dim3(grid), dim3(NTHR), LDS_BYTES, stream, a);
#endif
    const hipError_t le = hipPeekAtLastError();
    if (le != hipSuccess) fprintf(stderr, "kernel_launch: launch failed: %s\n", hipGetErrorName(le));
}
```

```cpp
#include <hip/hip_runtime.h>
#include <cstdio>
#include <cstdint>

#define LAS __attribute__((address_space(3)))
#define GAS __attribute__((address_space(1)))
typedef unsigned short bf16;
typedef short bf16x8 __attribute__((ext_vector_type(8)));
typedef short s16x4 __attribute__((ext_vector_type(4)));
typedef float f32x2 __attribute__((ext_vector_type(2)));
typedef float f32x4 __attribute__((ext_vector_type(4)));
typedef float f32x16 __attribute__((ext_vector_type(16)));
typedef unsigned u32x2 __attribute__((ext_vector_type(2)));
typedef unsigned u32x4 __attribute__((ext_vector_type(4)));

#ifndef REP_MOD
#define REP_MOD 1
#endif
#ifndef REP_PREP
#define REP_PREP 1
#endif
#ifndef REP_INPROJ
#define REP_INPROJ 1
#endif
#ifndef REP_SSD1
#define REP_SSD1 1
#endif
#ifndef REP_ATTN
#define REP_ATTN 1
#endif
#ifndef REP_COMB
#define REP_COMB 1
#endif
#ifndef REP_SSD3
#define REP_SSD3 1
#endif
#ifndef REP_BR
#define REP_BR 1
#endif
#ifndef REP_OUT
#define REP_OUT 1
#endif
#ifndef REP_ROWS1
#define REP_ROWS1 1
#endif
#ifndef REP_GU
#define REP_GU 1
#endif
#ifndef REP_DN
#define REP_DN 1
#endif
#ifndef REP_FINAL
#define REP_FINAL 1
#endif

#ifndef KREP_GU
#define KREP_GU 1
#endif
#ifndef EREP_GU
#define EREP_GU 1
#endif
#ifndef KREP_DN
#define KREP_DN 1
#endif
#ifndef EREP_DN
#define EREP_DN 1
#endif
#ifndef KREP_IN
#define KREP_IN 1
#endif
#ifndef EREP_IN
#define EREP_IN 1
#endif
#ifndef MK_PER_PHASE
#define MK_PER_PHASE 0
#endif

constexpr int DM = 2048, NB = 4, SEQ = 4096, MT = NB * SEQ;
constexpr int NE = 32, TOPK = 4, NSLOT_ROWS = MT * TOPK + NE * 256;
constexpr int NPROJ_T = 61, NPROJ = NPROJ_T * 256;
constexpr int XBCW = 3072;
constexpr int NWAVES = 8, NTHR = 512;
constexpr int NPH = 14;

constexpr size_t MiB = 1u << 20;
constexpr size_t WS_CTL = 0, CTL_ZERO_BYTES = 1 * MiB;
constexpr size_t WS_MOD = 1, WS_ROPE = 2, WS_WR = 3, WS_RSTD = 4, WS_LISTS = 8, WS_ACS = 16, WS_DT = 18, WS_DTRAW = 20;
constexpr size_t WS_WT_IN = 32, WS_WT_BS = 96, WS_WT_BA = 104, WS_WT_OUT = 112, WS_WT_GU = 128, WS_WT_DN = 640;
constexpr size_t WS_H = 896, WS_Z = 960, WS_XBC = 1024, WS_Q = 1120, WS_K = 1184, WS_V = 1248, WS_SGS = 1312, WS_SGA = 1376, WS_XBCC = 1440;
constexpr size_t WS_YDIAG = 1536, WS_STATES = 1664, WS_YBUF = 1792, WS_OATT = 1856, WS_OFIN = 1984, WS_M1 = 2048, WS_MERGED = 2176, WS_MIX = 2240;
constexpr size_t WS_X1 = 2368, WS_H2 = 2496, WS_ACT = 2560, WS_YS = 2848, WS_END = 3104;
constexpr int CW_BAR = 4096;
constexpr int CW_CNT = 16384;
constexpr size_t MOD_CB = 256 * 1024;
constexpr size_t LIST_STRIDE = 2 * MiB;

constexpr int RING_BYTES = 131072;
constexpr int TAB_OFF = RING_BYTES;
constexpr int MISC_OFF = RING_BYTES + 1024;
constexpr int LDS_BYTES = 147456;

#define RLX_AGENT __ATOMIC_RELAXED, __HIP_MEMORY_SCOPE_AGENT
#define LDS_WAIT() asm volatile("s_waitcnt lgkmcnt(0)" ::: "memory")
#define VM_WAIT() asm volatile("s_waitcnt vmcnt(0)" ::: "memory")
#define SBAR() __builtin_amdgcn_sched_barrier(0)
__device__ __forceinline__ unsigned f2bf(float f) { unsigned u = __builtin_bit_cast(unsigned, f); return (u + 0x7fffu + ((u >> 16) & 1u)) >> 16; }

__device__ __forceinline__ float bf2f(unsigned short b) { return __builtin_bit_cast(float, (unsigned)b << 16); }
__device__ __forceinline__ float bflo(unsigned w) { return __builtin_bit_cast(float, w << 16); }
__device__ __forceinline__ float bfhi(unsigned w) { return __builtin_bit_cast(float, w & 0xffff0000u); }
__device__ __forceinline__ unsigned cvt_pk_bf16(float lo, float hi) { unsigned r; asm("v_cvt_pk_bf16_f32 %0, %1, %2" : "=v"(r) : "v"(lo), "v"(hi)); return r; }
__device__ __forceinline__ unsigned pk2(float lo, float hi) { return cvt_pk_bf16(lo, hi); }
__device__ __forceinline__ unsigned pk4_fp8(float a, float b, float c, float d) { int w = __builtin_amdgcn_cvt_pk_fp8_f32(a, b, 0, false); w = __builtin_amdgcn_cvt_pk_fp8_f32(c, d, w, true); return (unsigned)w; }
__device__ __forceinline__ float sigmoidf_(float x) { return __builtin_amdgcn_rcpf(1.0f + __builtin_amdgcn_exp2f(-1.4426950408889634f * x)); }
__device__ __forceinline__ float siluf_(float x) { return x * __builtin_amdgcn_rcpf(1.0f + __builtin_amdgcn_exp2f(-1.4426950408889634f * x)); }
__device__ __forceinline__ int otid(int wv) { int l; asm volatile("v_mbcnt_lo_u32_b32 %0, -1, 0\n\tv_mbcnt_hi_u32_b32 %0, -1, %0" : "=v"(l)); return wv * 64 + l; }
__device__ __forceinline__ float wave_sum(float v) {
#pragma unroll
    for (int o = 1; o < 64; o <<= 1) v += __shfl_xor(v, o);
    return v;
}

#define XB_TMO      128
#define XB_XCNT(j)  (256  + 64 * (j))
#define XB_XSUB(j)  (1280 + 64 * (j))
#define XB_XGEN(j)  (2304 + 64 * (j))
#define XB_TOP      3328
#define XB_TOPGEN   3392
#define XCD_BAR_WORDS 3456
#define XB_SPIN_CAP (1u << 18)
__device__ __forceinline__ unsigned xb_ld(unsigned* p)              { return __hip_atomic_load(p, __ATOMIC_RELAXED, __HIP_MEMORY_SCOPE_AGENT); }
__device__ __forceinline__ unsigned xb_add(unsigned* p, unsigned v) { return __hip_atomic_fetch_add(p, v, __ATOMIC_RELAXED, __HIP_MEMORY_SCOPE_AGENT); }
__device__ __forceinline__ unsigned xb_xcc_id() { return (unsigned)__builtin_amdgcn_s_getreg((3 << 11) | 20) & 0xFu; }
#define XB_SPIN(cond, bar) do { unsigned _sp = 0; while (cond) { __builtin_amdgcn_s_sleep(1); \
    if ((++_sp & 255u) == 0u) { if (xb_ld(&(bar)[XB_TMO])) break; if (_sp > XB_SPIN_CAP) { atomicAdd(&(bar)[XB_TMO], 1u); break; } } } } while (0)
struct XcdBarrier { unsigned* bar; unsigned x; volatile LAS unsigned* st; };
__device__ __forceinline__ XcdBarrier xcd_barrier_post(unsigned* bar, volatile LAS unsigned* st, bool leader  ) {
    XcdBarrier b; b.bar = bar; b.x = xb_xcc_id(); b.st = st;
    if (leader) (void)xb_add(&bar[XB_XCNT(b.x)], 1u);
    return b;
}
__device__ __forceinline__ void xcd_barrier_complete(unsigned* bar, unsigned x, unsigned& nloc, unsigned& nx) {
    const unsigned G = gridDim.x * gridDim.y * gridDim.z;
    unsigned sum, cnt, mine, sp = 0u;
    for (;;) {
        sum = 0u; cnt = 0u; mine = 0u;
#pragma unroll
        for (unsigned j = 0; j < 16; ++j) { const unsigned c = xb_ld(&bar[XB_XCNT(j)]); sum += c; cnt += (c > 0u) ? 1u : 0u; mine = (j == x) ? c : mine; }
        if (sum == G) break;
        __builtin_amdgcn_s_sleep(1);
        if ((++sp & 255u) == 0u) { if (xb_ld(&bar[XB_TMO])) break; if (sp > XB_SPIN_CAP) { atomicAdd(&bar[XB_TMO], 1u); break; } }
    }
    nloc = mine > 0u ? mine : 1u; nx = cnt > 0u ? cnt : 1u;
}
__device__ __forceinline__ void xcd_barrier(const XcdBarrier& b, bool leader  ) {
    asm volatile("s_waitcnt vmcnt(0)" ::: "memory");
    __syncthreads();
    if (leader) {
        unsigned* bar = b.bar;
        __builtin_amdgcn_s_waitcnt(0);
        unsigned nloc = b.st[0], nx = b.st[1];
        if (nloc == 0u) { xcd_barrier_complete(bar, b.x, nloc, nx); b.st[0] = nloc; b.st[1] = nx; }
        const unsigned old = xb_add(&bar[XB_XSUB(b.x)], 1u);
        const unsigned gen = old / nloc;
        if (old + 1u == (gen + 1u) * nloc) {
            __builtin_amdgcn_fence(__ATOMIC_RELEASE, "agent");
            asm volatile("s_waitcnt vmcnt(0)" ::: "memory");
            const unsigned og = xb_add(&bar[XB_TOP], 1u);
            const unsigned tg = og / nx;
            if (og + 1u == (tg + 1u) * nx) xb_add(&bar[XB_TOPGEN], 1u);
            else XB_SPIN(xb_ld(&bar[XB_TOPGEN]) == tg, bar);
            __builtin_amdgcn_fence(__ATOMIC_ACQUIRE, "agent");
            xb_add(&bar[XB_XGEN(b.x)], 1u);
            asm volatile("s_waitcnt vmcnt(0)" ::: "memory");
        } else {
            XB_SPIN(xb_ld(&bar[XB_XGEN(b.x)]) == gen, bar);
            __builtin_amdgcn_fence(__ATOMIC_ACQUIRE, "agent");
            asm volatile("s_waitcnt vmcnt(0)" ::: "memory");
        }
    }
    __syncthreads();
}
namespace pg8 {
constexpr int BM = 256, BK = 64, HALF = 128, HTB = HALF * BK * 2, STAGE_BYTES = 8 * HTB, NXCD = 8;
#ifndef PG8_WGM
#define PG8_WGM 8
#endif
constexpr int WGM = PG8_WGM;
__host__ __device__ __forceinline__ int lds_byte(int r, int c) { const int st = (r >> 4) * 2 + (c >> 5), rr = r & 15, cc = c & 31, ob = rr * 64 + cc * 2; return st * 1024 + (ob ^ (((ob >> 9) & 1) << 5)); }
__host__ __device__ __forceinline__ void stage_rc(int b, int& R, int& C) { const int st = b / 1024, sb = b % 1024, swz = sb ^ (((sb >> 9) & 1) << 5); R = (st >> 1) * 16 + swz / 64; C = (st & 1) * 32 + (swz % 64) / 2; }
__host__ __device__ __forceinline__ int perm32(int rho) { const int n = rho >> 4, i = rho & 15; return 8 * (i >> 2) + 4 * n + (i & 3); }

struct Unit { int pm, pn, e, ml; };

struct ProbDense {
    static constexpr bool PRELOAD = false;
    const char* A; const char* Bt; int rb;
    int nM, nN, nwg, G, c;
    __device__ __forceinline__ void init(const void* A_, const void* Bt_, int M, int N, int K_, int G_, int c_) { A = (const char*)A_; Bt = (const char*)Bt_; rb = K_ * 2; nM = M / BM; nN = N / BM; nwg = nM * nN; G = G_; c = c_; }
    __device__ __forceinline__ bool next(int i, Unit& u) const {
        const long L = (long)i * G + c; if (L >= nwg) return false;
        int wgid = (int)L; { const int q = nwg / NXCD, r = nwg % NXCD, xcd = wgid % NXCD, off = wgid / NXCD; wgid = (xcd < r ? xcd * (q + 1) : r * (q + 1) + (xcd - r) * q) + off; }
        const int nig = WGM * nN, gid = wgid / nig, fm = gid * WGM, gsz = (nM - fm) < WGM ? (nM - fm) : WGM;
        u.pm = fm + ((wgid % nig) % gsz); u.pn = (wgid % nig) / gsz; u.e = 0; u.ml = 0; return true;
    }
    __device__ __forceinline__ unsigned b_off(const Unit& u) const { return (unsigned)(u.pn * BM * rb); }
    __device__ __forceinline__ void a_offs(const Unit& u, int tid_, unsigned (&off)[2][2]) const {
        asm volatile("" : "+v"(tid_)); int R[2], C[2]; stage_rc(tid_ * 16, R[0], C[0]); stage_rc(tid_ * 16 + 8192, R[1], C[1]);
#pragma unroll
        for (int h = 0; h < 2; ++h)
#pragma unroll
            for (int i = 0; i < 2; ++i) off[h][i] = (unsigned)((u.pm * BM + h * HALF + R[i]) * rb + C[i] * 2);
    }
};

template <bool GATHER> struct ProbMoE {
    static constexpr bool PRELOAD = GATHER;
    const char* A; const char* Bt; int rb, nN; size_t estride;
    const int* list_tok; const LAS int* tab; int G, c;
    __device__ __forceinline__ bool next(int i, Unit& u) const {
        const int L = i * G + c; const int NT = __builtin_amdgcn_readfirstlane(tab[64]);
        if (L >= NT * nN) return false;
        int e = 0;
#pragma unroll 1
        for (int j = 1; j < 32; ++j) if (L >= tab[32 + j] * nN) e = j;
        const int tb = tab[32 + e], ntile = tab[33 + e] - tb, Lp = L - tb * nN;
        u.e = __builtin_amdgcn_readfirstlane(e); u.pn = __builtin_amdgcn_readfirstlane(Lp / ntile); u.ml = __builtin_amdgcn_readfirstlane(Lp % ntile); u.pm = __builtin_amdgcn_readfirstlane(tb + Lp % ntile); return true;
    }
    __device__ __forceinline__ unsigned b_off(const Unit& u) const { return (unsigned)(u.e * (unsigned)estride + u.pn * BM * rb); }
    __device__ __forceinline__ void a_offs(const Unit& u, int tid_, unsigned (&off)[2][2]) const {
        asm volatile("" : "+v"(tid_)); int R[2], C[2]; stage_rc(tid_ * 16, R[0], C[0]); stage_rc(tid_ * 16 + 8192, R[1], C[1]);
        if constexpr (GATHER) {
            const int cnt = __builtin_amdgcn_readfirstlane(tab[u.e]);
#pragma unroll
            for (int h = 0; h < 2; ++h)
#pragma unroll
                for (int i = 0; i < 2; ++i) { const int j = u.ml * BM + h * HALF + R[i]; const int tok = (j < cnt) ? list_tok[u.e * 16384 + j] : 0; off[h][i] = (unsigned)(tok * rb + C[i] * 2); }
        } else {
#pragma unroll
            for (int h = 0; h < 2; ++h)
#pragma unroll
                for (int i = 0; i < 2; ++i) off[h][i] = (unsigned)((u.pm * BM + h * HALF + R[i]) * rb + C[i] * 2);
        }
    }
};

typedef int v8i32 __attribute__((ext_vector_type(8)));
typedef int v4i32 __attribute__((ext_vector_type(4)));
__device__ __forceinline__ v8i32 cat8(bf16x8 a, bf16x8 b) { const v4i32 x = __builtin_bit_cast(v4i32, a), y = __builtin_bit_cast(v4i32, b); return __builtin_shufflevector(x, y, 0, 1, 2, 3, 4, 5, 6, 7); }
template <class Epi, class Prob, bool ALIGN_EPI, bool FP8 = false, int WSCALE = 127, int KREP = 1, int EREP = 1>
__device__ __forceinline__ void gemm_phase(LAS unsigned char* lds, const Prob& P, const Epi& E, int wv) {
    const int tid = otid(wv), wid = __builtin_amdgcn_readfirstlane(tid >> 6), lane = tid & 63, wr = wid >> 2, wc = wid & 3, fr = lane & 15, fq = lane >> 4;
    const int rb = P.rb, nt = rb / 128;
    unsigned voffB; { int R, C; stage_rc(tid * 16, R, C); const int Rb = Epi::PERM ? ((R & ~31) + perm32(R & 31)) : R; voffB = (unsigned)(Rb * rb + C * 2); }
    const unsigned qstep = (unsigned)(64 * rb);
    const unsigned kstep = 128u;
    const unsigned hstep = (unsigned)(HALF * rb);
    const __amdgpu_buffer_rsrc_t rA = __builtin_amdgcn_make_buffer_rsrc((void*)P.A, 0, 0x7fffffff, 0x00020000), rB = __builtin_amdgcn_make_buffer_rsrc((void*)P.Bt, 0, 0x7fffffff, 0x00020000);
    const unsigned ldsw = (unsigned)wid * 1024u;
    const int aoff = lds_byte(wr * 64 + fr, fq * 8), boff = lds_byte(wc * 32 + fr, fq * 8);
#define PG8_SA(b, h) (((b) * 2 + (h)) * HTB)
#define PG8_SB(b, h) ((4 + (b) * 2 + (h)) * HTB)
#define PG8_STAGE_B(bufoff, soff) do { _Pragma("unroll") for (int _i = 0; _i < 2; ++_i) \
        __builtin_amdgcn_raw_ptr_buffer_load_lds(rB, (LAS void*)(lds + (bufoff) + ldsw + _i * 8192), 16, voffB, (int)((soff) + _i * qstep), 0, 0); } while (0)
#define PG8_STAGE_A(bufoff, h, soff) do { _Pragma("unroll") for (int _i = 0; _i < 2; ++_i) { \
        if constexpr (Prob::PRELOAD) __builtin_amdgcn_raw_ptr_buffer_load_lds(rA, (LAS void*)(lds + (bufoff) + ldsw + _i * 8192), 16, offA[h][_i], (int)(soff), 0, 0); \
        else __builtin_amdgcn_raw_ptr_buffer_load_lds(rA, (LAS void*)(lds + (bufoff) + ldsw + _i * 8192), 16, offA[0][0], (int)((soff) + (h) * hstep + _i * qstep), 0, 0); } } while (0)
#define PG8_LDA(dst, b, h) do { _Pragma("unroll") for (int m = 0; m < 4; ++m) _Pragma("unroll") for (int k = 0; k < 2; ++k) dst[m][k] = *(const LAS bf16x8*)(lds + PG8_SA(b, h) + aoff + m * 2048 + k * 1024); } while (0)
#define PG8_LDB(dst, b, h) do { _Pragma("unroll") for (int n = 0; n < 2; ++n) _Pragma("unroll") for (int k = 0; k < 2; ++k) dst[n][k] = *(const LAS bf16x8*)(lds + PG8_SB(b, h) + boff + n * 2048 + k * 1024); } while (0)
#define PG8_MMA(ai, bj, At, Bt) do { __builtin_amdgcn_s_setprio(1); _Pragma("unroll") for (int m = 0; m < 4; ++m) _Pragma("unroll") for (int n = 0; n < 2; ++n) { \
        if constexpr (FP8) acc[ai][bj][m][n] = __builtin_amdgcn_mfma_scale_f32_16x16x128_f8f6f4(cat8(Bt[n][0], Bt[n][1]), cat8(At[m][0], At[m][1]), acc[ai][bj][m][n], 0, 0, 0, WSCALE, 0, 127); \
        else { _Pragma("unroll") for (int k = 0; k < 2; ++k) acc[ai][bj][m][n] = __builtin_amdgcn_mfma_f32_16x16x32_bf16(Bt[n][k], At[m][k], acc[ai][bj][m][n], 0, 0, 0); } } \
        __builtin_amdgcn_s_setprio(0); } while (0)
#define PG8_WAIT_V(n) asm volatile("s_waitcnt vmcnt(" #n ")" ::: "memory")
#define PG8_WAIT_L(n) asm volatile("s_waitcnt lgkmcnt(" #n ")" ::: "memory")
#define PG8_BAR __builtin_amdgcn_s_barrier()
    Unit cur, nxt; int ui = 0;
    if (!P.next(0, cur)) return;
    f32x4 acc[2][2][4][2];
#pragma unroll
    for (int a = 0; a < 2; ++a)
#pragma unroll
        for (int b = 0; b < 2; ++b)
#pragma unroll
            for (int m = 0; m < 4; ++m)
#pragma unroll
                for (int n = 0; n < 2; ++n) acc[a][b][m][n] = (f32x4){0.f, 0.f, 0.f, 0.f};
    bf16x8 At[4][2], B0[2][2], B1[2][2];
    unsigned offA[2][2];
    LAS u32x4* stash = (LAS u32x4*)(lds + RING_BYTES + 4096) + tid;
    P.a_offs(cur, tid, offA);
    unsigned cB = P.b_off(cur);
    PG8_STAGE_B(PG8_SB(0, 0), cB); PG8_STAGE_B(PG8_SB(0, 1), cB + hstep); PG8_STAGE_A(PG8_SA(0, 0), 0, 0u); PG8_STAGE_A(PG8_SA(0, 1), 1, 0u);
    if (wr == 1) PG8_BAR;
    PG8_WAIT_V(2); PG8_BAR;
    PG8_STAGE_B(PG8_SB(1, 0), cB + kstep); PG8_STAGE_A(PG8_SA(1, 0), 0, kstep); PG8_STAGE_B(PG8_SB(1, 1), cB + hstep + kstep);
    PG8_WAIT_V(6); PG8_BAR;
    for (;;) {
        const bool has_next = P.next(ui + 1, nxt);
        if constexpr (Prob::PRELOAD) {
            unsigned noffA[2][2];
            if (has_next) P.a_offs(nxt, tid, noffA);
            else {
#pragma unroll
                for (int h = 0; h < 2; ++h)
#pragma unroll
                    for (int i = 0; i < 2; ++i) noffA[h][i] = offA[h][i];
            }
            *stash = (u32x4){noffA[0][0], noffA[0][1], noffA[1][0], noffA[1][1]};
        }
        Unit nu = has_next ? nxt : cur;
        const unsigned nB = has_next ? P.b_off(nxt) : cB;
        for (int kr = 0; kr < KREP; ++kr) {
        if (KREP > 1 && kr > 0) {
#pragma unroll
            for (int a = 0; a < 2; ++a)
#pragma unroll
                for (int b = 0; b < 2; ++b)
#pragma unroll
                    for (int m = 0; m < 4; ++m)
#pragma unroll
                        for (int n = 0; n < 2; ++n) acc[a][b][m][n] = (f32x4){0.f, 0.f, 0.f, 0.f};
        }
        const bool fin = (kr == KREP - 1);
        for (int t = 0; t < nt; t += 2) {
            const bool last = (t == nt - 2);
            const unsigned a1 = (unsigned)(t + 1) * kstep;
            const unsigned a2 = last ? 0u : (unsigned)(t + 2) * kstep, b2 = last ? (fin ? nB : cB) : cB + (unsigned)(t + 2) * kstep;
            const unsigned a3 = a2 + kstep, b3 = b2 + kstep;
            PG8_LDB(B0, 0, 0); PG8_LDB(B1, 0, 1); SBAR(); PG8_LDA(At, 0, 0); PG8_STAGE_A(PG8_SA(1, 1), 1, a1);
            PG8_WAIT_V(8); PG8_WAIT_L(0); PG8_BAR; PG8_MMA(0, 0, At, B0); PG8_MMA(0, 1, At, B1); PG8_BAR; SBAR();
            if constexpr (Prob::PRELOAD) {
                const u32x4 nv = *stash; const bool sw = last && fin;
                offA[0][0] = sw ? nv[0] : offA[0][0]; offA[0][1] = sw ? nv[1] : offA[0][1]; offA[1][0] = sw ? nv[2] : offA[1][0]; offA[1][1] = sw ? nv[3] : offA[1][1];
            } else {
                const unsigned dlt = (last && fin) ? (unsigned)((nu.pm - cur.pm) * BM * rb) : 0u;
                offA[0][0] += dlt;
            }
            PG8_LDA(At, 0, 1); PG8_STAGE_B(PG8_SB(0, 0), b2); PG8_STAGE_B(PG8_SB(0, 1), b2 + hstep); PG8_STAGE_A(PG8_SA(0, 0), 0, a2);
            PG8_WAIT_V(8); PG8_WAIT_L(0); PG8_BAR; PG8_MMA(1, 0, At, B0); PG8_MMA(1, 1, At, B1); PG8_BAR; SBAR();
            PG8_LDB(B0, 1, 0); PG8_LDB(B1, 1, 1); SBAR(); PG8_LDA(At, 1, 0); PG8_STAGE_A(PG8_SA(0, 1), 1, a2);
            PG8_WAIT_V(8); PG8_WAIT_L(0); PG8_BAR; PG8_MMA(0, 0, At, B0); PG8_MMA(0, 1, At, B1); PG8_BAR; SBAR();
            PG8_LDA(At, 1, 1); PG8_STAGE_B(PG8_SB(1, 0), b3); PG8_STAGE_B(PG8_SB(1, 1), b3 + hstep); PG8_STAGE_A(PG8_SA(1, 0), 0, a3);
            PG8_WAIT_V(8); PG8_WAIT_L(0); PG8_BAR; PG8_MMA(1, 0, At, B0); PG8_MMA(1, 1, At, B1); PG8_BAR; SBAR();
        }
        }
        if constexpr (ALIGN_EPI) { if (wr == 0) PG8_BAR; }
        { int fr_ = fr, fq_ = fq; asm volatile("" : "+v"(fr_), "+v"(fq_)); E(acc, cur, wr, wc, fr_, fq_); if constexpr (EREP > 1) { asm volatile("" : "+v"(fr_), "+v"(fq_)); E(acc, cur, wr, wc, fr_, fq_); } }
        if (!has_next) break;
#pragma unroll
        for (int a = 0; a < 2; ++a)
#pragma unroll
            for (int b = 0; b < 2; ++b)
#pragma unroll
                for (int m = 0; m < 4; ++m)
#pragma unroll
                    for (int n = 0; n < 2; ++n) acc[a][b][m][n] = (f32x4){0.f, 0.f, 0.f, 0.f};
        cur = nxt; cB = nB; ++ui;
        if constexpr (ALIGN_EPI) { if (wr == 1) PG8_BAR; }
    }
    PG8_WAIT_V(0);
    if constexpr (!ALIGN_EPI) { if (wr == 0) PG8_BAR; }
    PG8_BAR;
#undef PG8_SA
#undef PG8_SB
#undef PG8_STAGE_A
#undef PG8_STAGE_B
#undef PG8_LDA
#undef PG8_LDB
#undef PG8_MMA
#undef PG8_WAIT_V
#undef PG8_WAIT_L
#undef PG8_BAR
}
}
namespace pg8 {
struct EpiInProj {
    static constexpr bool PERM = true;
    unsigned char* ws;
    __device__ __forceinline__ void operator()(const f32x4 (&acc)[2][2][4][2], const Unit& u, int wr, int wc, int fr, int fq) const {
        const int pn = u.pn; const int row0 = u.pm * BM + wr * 64 + fr;
        if (pn == 60) {
            if (wc == 0) { float* dst = (float*)(ws + WS_DTRAW * MiB);
#pragma unroll
                for (int ai = 0; ai < 2; ++ai)
#pragma unroll
                    for (int m = 0; m < 4; ++m) { float* rp = dst + (size_t)(row0 + ai * HALF + m * 16) * 32 + 8 * fq;
                        *(f32x4*)rp = acc[ai][0][m][0]; *(f32x4*)(rp + 4) = acc[ai][0][m][1]; } }
            return;
        }
        bf16* base; int ldc, colt; bool sig = false;
        if (pn < 8)       { base = (bf16*)(ws + WS_Z * MiB);   ldc = DM;   colt = pn * BM; }
        else if (pn < 20) { base = (bf16*)(ws + WS_XBC * MiB); ldc = XBCW; colt = (pn - 8) * BM; }
        else if (pn < 28) { base = (bf16*)(ws + WS_Q * MiB);   ldc = DM;   colt = (pn - 20) * BM; }
        else if (pn < 36) { base = (bf16*)(ws + WS_K * MiB);   ldc = DM;   colt = (pn - 28) * BM; }
        else if (pn < 44) { base = (bf16*)(ws + WS_V * MiB);   ldc = DM;   colt = (pn - 36) * BM; }
        else if (pn < 52) { base = (bf16*)(ws + WS_SGS * MiB); ldc = DM;   colt = (pn - 44) * BM; sig = true; }
        else              { base = (bf16*)(ws + WS_SGA * MiB); ldc = DM;   colt = (pn - 52) * BM; sig = true; }
        const int col0 = colt + wc * 32 + 8 * fq;
#pragma unroll
        for (int ai = 0; ai < 2; ++ai)
#pragma unroll
            for (int m = 0; m < 4; ++m) { bf16* rowp = base + (size_t)(row0 + ai * HALF + m * 16) * ldc + col0;
#pragma unroll
                for (int bj = 0; bj < 2; ++bj) { f32x4 v0 = acc[ai][bj][m][0], v1 = acc[ai][bj][m][1];
                    if (sig) {
#pragma unroll
                        for (int q = 0; q < 4; ++q) { v0[q] = sigmoidf_(v0[q]); v1[q] = sigmoidf_(v1[q]); } }
                    u32x4 w; w.x = cvt_pk_bf16(v0[0], v0[1]); w.y = cvt_pk_bf16(v0[2], v0[3]); w.z = cvt_pk_bf16(v1[0], v1[1]); w.w = cvt_pk_bf16(v1[2], v1[3]);
                    *(u32x4*)(rowp + bj * HALF) = w; } }
    }
};
struct EpiBr1 {
    static constexpr bool PERM = false;
    const bf16* sg; float* m1;
    __device__ __forceinline__ void operator()(const f32x4 (&acc)[2][2][4][2], const Unit& u, int wr, int wc, int fr, int fq) const {
        const int row0 = u.pm * BM + wr * 64 + fr, col0 = u.pn * BM + wc * 32 + 4 * fq;
#pragma unroll
        for (int ai = 0; ai < 2; ++ai)
#pragma unroll
            for (int m = 0; m < 4; ++m) { const size_t off = (size_t)(row0 + ai * HALF + m * 16) * DM + col0;
#pragma unroll
                for (int bj = 0; bj < 2; ++bj)
#pragma unroll
                    for (int n = 0; n < 2; ++n) { const u32x2 g = *(const u32x2*)(sg + off + bj * HALF + n * 16); const f32x4 a = acc[ai][bj][m][n];
                        *(f32x4*)(m1 + off + bj * HALF + n * 16) = (f32x4){a[0] * bflo(g.x), a[1] * bfhi(g.x), a[2] * bflo(g.y), a[3] * bfhi(g.y)}; } }
    }
};
struct EpiBr2 {
    static constexpr bool PERM = false;
    const bf16* sg; const float* m1; bf16* out;
    __device__ __forceinline__ void operator()(const f32x4 (&acc)[2][2][4][2], const Unit& u, int wr, int wc, int fr, int fq) const {
        const int row0 = u.pm * BM + wr * 64 + fr, col0 = u.pn * BM + wc * 32 + 4 * fq;
#pragma unroll
        for (int ai = 0; ai < 2; ++ai)
#pragma unroll
            for (int m = 0; m < 4; ++m) { const size_t off = (size_t)(row0 + ai * HALF + m * 16) * DM + col0;
#pragma unroll
                for (int bj = 0; bj < 2; ++bj)
#pragma unroll
                    for (int n = 0; n < 2; ++n) { const size_t o2 = off + bj * HALF + n * 16; const u32x2 g = *(const u32x2*)(sg + o2); const f32x4 a = acc[ai][bj][m][n]; const f32x4 p = *(const f32x4*)(m1 + o2);
                        u32x2 w; w.x = cvt_pk_bf16(p[0] + a[0] * bflo(g.x), p[1] + a[1] * bfhi(g.x)); w.y = cvt_pk_bf16(p[2] + a[2] * bflo(g.y), p[3] + a[3] * bfhi(g.y));
                        *(u32x2*)(out + o2) = w; } }
    }
};
struct EpiF32 {
    static constexpr bool PERM = false;
    float* out; int ldc;
    __device__ __forceinline__ void operator()(const f32x4 (&acc)[2][2][4][2], const Unit& u, int wr, int wc, int fr, int fq) const {
        const int row0 = u.pm * BM + wr * 64 + fr, col0 = u.pn * BM + wc * 32 + 4 * fq;
#pragma unroll
        for (int ai = 0; ai < 2; ++ai)
#pragma unroll
            for (int m = 0; m < 4; ++m) { const size_t off = (size_t)(row0 + ai * HALF + m * 16) * ldc + col0;
#pragma unroll
                for (int bj = 0; bj < 2; ++bj)
#pragma unroll
                    for (int n = 0; n < 2; ++n) *(f32x4*)(out + off + bj * HALF + n * 16) = acc[ai][bj][m][n]; }
    }
};
struct EpiGateUp {
    static constexpr bool PERM = true;
    const float* bgu; unsigned char* act;
    __device__ __forceinline__ void operator()(const f32x4 (&acc)[2][2][4][2], const Unit& u, int wr, int wc, int fr, int fq) const {
        const int row0 = u.pm * BM + wr * 64 + fr; const int f = u.pn * 128 + wc * 32 + 8 * fq;
        const float* bg = bgu + (size_t)u.e * 4096 + f;
        f32x4 bgate[2], bup[2];
#pragma unroll
        for (int n = 0; n < 2; ++n) { bgate[n] = *(const f32x4*)(bg + 4 * n); bup[n] = *(const f32x4*)(bg + 2048 + 4 * n); }
#pragma unroll
        for (int ai = 0; ai < 2; ++ai)
#pragma unroll
            for (int m = 0; m < 4; ++m) { u32x2 w;
#pragma unroll
                for (int n = 0; n < 2; ++n) { const f32x4 g4 = acc[ai][0][m][n] * 0.015625f + bgate[n], u4 = acc[ai][1][m][n] * 0.015625f + bup[n]; float r[4];
#pragma unroll
                    for (int q = 0; q < 4; ++q) { const float g = fminf(g4[q], 7.0f), up = fminf(fmaxf(u4[q], -7.0f), 7.0f); r[q] = (up + 1.0f) * g * sigmoidf_(1.702f * g); }
                    w[n] = pk4_fp8(r[0], r[1], r[2], r[3]); }
                *(u32x2*)(act + (size_t)(row0 + ai * HALF + m * 16) * DM + f) = w; }
    }
};
struct EpiDown {
    static constexpr bool PERM = true;
    const float* bdn; const int* list_dst; const float* list_w; const LAS int* tab; bf16* ys;
    __device__ __forceinline__ void operator()(const f32x4 (&acc)[2][2][4][2], const Unit& u, int wr, int wc, int fr, int fq) const {
        const int cnt = __builtin_amdgcn_readfirstlane(tab[u.e]); const int col0 = u.pn * BM + wc * 32 + 8 * fq; const float* bd = bdn + (size_t)u.e * DM + col0;
#pragma unroll
        for (int ai = 0; ai < 2; ++ai)
#pragma unroll
            for (int m = 0; m < 4; ++m) { const int j = u.ml * BM + ai * HALF + wr * 64 + m * 16 + fr;
                if (j < cnt) { const int dst = list_dst[u.e * 16384 + j]; const float w = list_w[u.e * 16384 + j]; bf16* rowp = ys + (size_t)dst * DM + col0;
#pragma unroll
                    for (int bj = 0; bj < 2; ++bj) { const f32x4 b0 = *(const f32x4*)(bd + bj * HALF), b1 = *(const f32x4*)(bd + bj * HALF + 4);
                        const f32x4 v0 = (acc[ai][bj][m][0] * 0.015625f + b0) * w, v1 = (acc[ai][bj][m][1] * 0.015625f + b1) * w;
                        u32x4 o; o.x = cvt_pk_bf16(v0[0], v0[1]); o.y = cvt_pk_bf16(v0[2], v0[3]); o.z = cvt_pk_bf16(v1[0], v1[1]); o.w = cvt_pk_bf16(v1[2], v1[3]);
                        *(u32x4*)(rowp + bj * HALF) = o; } } }
    }
};
}
namespace att {
constexpr int NW = 8, QBLK = 32, KVBLK = 64, QB = NW * QBLK;
constexpr int SHM_V = KVBLK * 128 * 2, SHM_K = KVBLK * 64 * 2;
constexpr int LDS_BYTES = 2 * SHM_V + 2 * SHM_K + NW * 64 * 4;
constexpr int QP = 2048, OP = 4096;
constexpr float SCALE = 0.125f, THR = 8.f;
#define KSWZ(row, colB) ((row) * 128 + ((colB) ^ ((((row) >> 1) & 7) << 4)))
__device__ __forceinline__ int v_st(int k, int c) { const int kk = (k & ~0xC) | ((k & 4) << 1) | ((k & 8) >> 1); return ((kk >> 3) * 4 + (c >> 5)) * 512 + ((kk & 7) * 32 + (c & 31)) * 2; }
__device__ __forceinline__ int v_rd_base(int lane) { return ((lane & 3) << 3) | (((lane >> 2) & 3) << 6) | (((lane >> 4) & 1) << 5) | (((lane >> 5) & 1) << 8); }
constexpr int v_rd_off(int d0, int ks, int half) { return d0 * 512 + ks * 4096 + half * 2048; }
__device__ __forceinline__ int crow(int r, int hi) { return (r & 3) + 8 * (r >> 2) + 4 * hi; }
__device__ __forceinline__ unsigned cvtpk(float lo, float hi) { unsigned r; asm volatile("v_cvt_pk_bf16_f32 %0, %1, %2" : "=v"(r) : "v"(lo), "v"(hi)); return r; }
__device__ __forceinline__ bf16x8 load8(const bf16* p) { return *reinterpret_cast<const bf16x8*>(p); }
__device__ __forceinline__ void mask_tile(f32x16& p0, f32x16& p1, int dq) {
    const float NEG = -__builtin_inff();
#pragma unroll
    for (int r = 0; r < 16; ++r) {
        const int c = (r & 3) + 8 * (r >> 2);
        if (dq - c < 0) p0[r] = NEG;
        if (dq - c - 32 < 0) p1[r] = NEG;
    }
}
__device__ __forceinline__ void partialSM(f32x16& p0, f32x16& p1, float& m_reg, float& mn, float& alpha) {
    float pmax = p0[0];
#pragma unroll
    for (int r = 1; r < 16; ++r) pmax = fmaxf(pmax, p0[r]);
#pragma unroll
    for (int r = 0; r < 16; ++r) pmax = fmaxf(pmax, p1[r]);
    { auto rr = __builtin_amdgcn_permlane32_swap(__float_as_uint(pmax), __float_as_uint(pmax), false, false);
      pmax = fmaxf(__uint_as_float(rr[0]), __uint_as_float(rr[1])); }
    constexpr float C2 = 1.4426950408889634f * SCALE;
    if (__builtin_expect(__all((pmax - m_reg) * SCALE <= THR), 1)) { mn = m_reg; alpha = 1.f; }
    else { mn = fmaxf(m_reg, pmax); alpha = __builtin_amdgcn_exp2f((m_reg - mn) * C2); m_reg = mn; }
    const float mnL = -mn * C2;
#pragma unroll
    for (int r = 0; r < 16; ++r) p0[r] = fmaf(p0[r], C2, mnL);
#pragma unroll
    for (int r = 0; r < 16; ++r) p1[r] = fmaf(p1[r], C2, mnL);
#pragma unroll
    for (int r = 0; r < 16; ++r) p0[r] = __builtin_amdgcn_exp2f(p0[r]);
}
__device__ __forceinline__ void finishSM(f32x16& p0, f32x16& p1, float alpha, float& l_reg, bf16x8& pa0, bf16x8& pa1, bf16x8& pa2, bf16x8& pa3) {
#pragma unroll
    for (int r = 0; r < 16; ++r) p1[r] = __builtin_amdgcn_exp2f(p1[r]);
    float ps = 0;
#pragma unroll
    for (int r = 0; r < 16; ++r) ps += p0[r];
#pragma unroll
    for (int r = 0; r < 16; ++r) ps += p1[r];
    { auto rr = __builtin_amdgcn_permlane32_swap(__float_as_uint(ps), __float_as_uint(ps), false, false);
      ps = __uint_as_float(rr[0]) + __uint_as_float(rr[1]); }
    l_reg = l_reg * alpha + ps;
#define PK4(P, B_, OUT) do { unsigned a0 = cvtpk(P[B_+0], P[B_+1]), a1 = cvtpk(P[B_+2], P[B_+3]);                          \
        unsigned b0 = cvtpk(P[B_+4], P[B_+5]), b1 = cvtpk(P[B_+6], P[B_+7]);                                             \
        auto r0 = __builtin_amdgcn_permlane32_swap(a0, b0, false, false); auto r1 = __builtin_amdgcn_permlane32_swap(a1, b1, false, false); \
        u32x4 w = {r0[0], r1[0], r0[1], r1[1]}; OUT = *reinterpret_cast<bf16x8*>(&w); } while (0)
    PK4(p0, 0, pa0); PK4(p0, 8, pa1); PK4(p1, 0, pa2); PK4(p1, 8, pa3);
#undef PK4
}
template <int KB>
__device__ __forceinline__ void qkt(f32x16& p0, f32x16& p1, const char* K_lds, int r32, int hi, const bf16x8* qr) {
    p0 = f32x16{}; p1 = f32x16{};
#pragma unroll
    for (int d0 = 0; d0 < 4; ++d0) { const char* a = K_lds + KB * SHM_K + KSWZ(r32, (d0 * 2 + hi) * 16);
        bf16x8 b0 = *reinterpret_cast<const bf16x8*>(a);
        bf16x8 b1 = *reinterpret_cast<const bf16x8*>(a + 32 * 128);
        p0 = __builtin_amdgcn_mfma_f32_32x32x16_bf16(b0, qr[d0], p0, 0, 0, 0);
        p1 = __builtin_amdgcn_mfma_f32_32x32x16_bf16(b1, qr[d0], p1, 0, 0, 0); }
}
template <int VB>
__device__ __forceinline__ void pv_tile(f32x16* o, int vb0, bf16x8 pa0, bf16x8 pa1, bf16x8 pa2, bf16x8 pa3) {
#define TRRD(dst, off) asm volatile("ds_read_b64_tr_b16 %0, %1 offset:%2" : "=&v"(dst) : "v"(vb0), "i"(off) : "memory")
#define PV_D0(d0) do { s16x4 l0, l1, l2, l3, h0, h1, h2, h3; constexpr int b_ = VB * SHM_V + v_rd_off(d0, 0, 0); \
        TRRD(l0, b_); TRRD(h0, b_ + 2048); TRRD(l1, b_ + 4096); TRRD(h1, b_ + 6144); TRRD(l2, b_ + 8192); TRRD(h2, b_ + 10240); TRRD(l3, b_ + 12288); TRRD(h3, b_ + 14336); \
        asm volatile("s_waitcnt lgkmcnt(0)" ::: "memory"); SBAR();   \
        o[d0] = __builtin_amdgcn_mfma_f32_32x32x16_bf16(pa0, (bf16x8){l0[0], l0[1], l0[2], l0[3], h0[0], h0[1], h0[2], h0[3]}, o[d0], 0, 0, 0);   \
        o[d0] = __builtin_amdgcn_mfma_f32_32x32x16_bf16(pa1, (bf16x8){l1[0], l1[1], l1[2], l1[3], h1[0], h1[1], h1[2], h1[3]}, o[d0], 0, 0, 0);   \
        o[d0] = __builtin_amdgcn_mfma_f32_32x32x16_bf16(pa2, (bf16x8){l2[0], l2[1], l2[2], l2[3], h2[0], h2[1], h2[2], h2[3]}, o[d0], 0, 0, 0);   \
        o[d0] = __builtin_amdgcn_mfma_f32_32x32x16_bf16(pa3, (bf16x8){l3[0], l3[1], l3[2], l3[3], h3[0], h3[1], h3[2], h3[3]}, o[d0], 0, 0, 0); } while (0)
    PV_D0(0); PV_D0(1); PV_D0(2); PV_D0(3);
#undef PV_D0
#undef TRRD
}
struct BlockRef { const bf16* Q; const bf16* K; const bf16* V; bf16* O; int P0; };
struct Seam { bf16x8 qr[4]; bf16x8 st_v0, st_v1, st_k0; };
#define VMW() asm volatile("s_waitcnt vmcnt(0)" ::: "memory")
#define VMWN(n) asm volatile("s_waitcnt vmcnt(%0)" :: "i"(n) : "memory")
#define SLOAD_H(Kp, Vp, k0) do { S.st_v0 = load8((Vp) + (size_t)((k0) + sr) * QP + sc); S.st_v1 = load8((Vp) + (size_t)((k0) + 32 + sr) * QP + sc);              \
                                 S.st_k0 = load8((Kp) + (size_t)((k0) + krow) * QP + kc); } while (0)
#define SWRITE_HK(bf) do { *(bf16x8*)(K_lds + (bf) * SHM_K + kws) = S.st_k0; } while (0)
#define SWRITE_HV(bf) do { *(bf16x8*)(V_lds + (bf) * SHM_V + vst0) = S.st_v0; *(bf16x8*)(V_lds + (bf) * SHM_V + vst1) = S.st_v1; } while (0)
#define SWRITE_H(bf) do { SWRITE_HV(bf); SWRITE_HK(bf); } while (0)
__device__ __forceinline__ void attn_prime(const BlockRef& cur, char* lds, Seam& S, int wv) {
    const int tid = otid(wv), wid = __builtin_amdgcn_readfirstlane(tid >> 6), lane = tid & 63, r32 = lane & 31, hi = lane >> 5;
    const int sr = tid >> 4, sc = (tid & 15) * 8, krow = tid >> 3, kc = (tid & 7) * 8, kws = KSWZ(krow, kc * 2); char* K_lds = lds + 2 * SHM_V;
#pragma unroll
    for (int d0 = 0; d0 < 4; ++d0) S.qr[d0] = load8(cur.Q + (size_t)(wid * QBLK + r32) * QP + d0 * 16 + hi * 8);
    SLOAD_H(cur.K, cur.V, 0); VMW(); SWRITE_HK(0);
    __syncthreads();
}
__device__ __forceinline__ void attn_block(const BlockRef& cur, const BlockRef& nxt, char* lds, Seam& S, int wv) {
    const int tid = otid(wv), wid = __builtin_amdgcn_readfirstlane(tid >> 6), lane = tid & 63, r32 = lane & 31, hi = lane >> 5;
    const int NT = (cur.P0 + QB - 1) / KVBLK + 1;
    const int qlo = cur.P0 + wid * QBLK, qm = qlo + r32 - 4 * hi;
    char* V_lds = lds; char* K_lds = lds + 2 * SHM_V;
    float* ws = (float*)(lds + 2 * SHM_V + 2 * SHM_K) + wid * 64; float* li_l = ws, * al_l = ws + 32;
    float m_reg = -1e30f, l_reg = 0; f32x16 o[4] = {};
    const int sr = tid >> 4, sc = (tid & 15) * 8, vst0 = v_st(sr, sc), vst1 = v_st(32 + sr, sc);
    const int krow = tid >> 3, kc = (tid & 7) * 8, kws = KSWZ(krow, kc * 2);
    const int vb0 = (int)(uintptr_t)V_lds + v_rd_base(lane);
    const bf16* Kh = cur.K; const bf16* Vh = cur.V;
#define RESC(a) do { if (__any((a) < 1.f)) { if (hi == 0) al_l[r32] = (a); asm volatile("s_waitcnt lgkmcnt(0)" ::: "memory");              \
                     for (int d_ = 0; d_ < 4; ++d_) for (int r = 0; r < 16; ++r) o[d_][r] *= al_l[crow(r, hi)]; } } while (0)
#define KBASE(t) ((t) * KVBLK)
#define MASKT(P0_, P1_, t) do { const int kb_ = KBASE(t); if (kb_ + KVBLK - 1 > qlo) mask_tile(P0_, P1_, qm - kb_); } while (0)
    constexpr int NQL = 4;
#define SEAM_K0() do { VMWN(NQL); SWRITE_HK(0); SBAR(); } while (0)
    f32x16 pA0, pA1, pB0, pB1; float mnA, mnB, alA, alB; bf16x8 pa0, pa1, pa2, pa3;
    SWRITE_HV(0); SBAR();
    SLOAD_H(Kh, Vh, KBASE(1));
    SBAR(); qkt<0>(pA0, pA1, K_lds, r32, hi, S.qr);
    MASKT(pA0, pA1, 0); partialSM(pA0, pA1, m_reg, mnA, alA);
    VMW(); SWRITE_H(1);
    __syncthreads();
#define HALF_STEP(PX0, PX1, mnX, alX, PY0, PY1, alY, t, KB, VB, SB) do {                                                      \
        SBAR(); qkt<KB>(PX0, PX1, K_lds, r32, hi, S.qr);                                             \
        finishSM(PY0, PY1, alY, l_reg, pa0, pa1, pa2, pa3); SBAR();                                                           \
        if ((t) + 1 < NT) { SLOAD_H(Kh, Vh, KBASE((t) + 1)); SBAR(); }                                               \
        pv_tile<VB>(o, vb0, pa0, pa1, pa2, pa3); MASKT(PX0, PX1, (t)); partialSM(PX0, PX1, m_reg, mnX, alX);                                        \
        __syncthreads();                                                                                                      \
        if ((t) + 1 < NT) { VMW(); SWRITE_H(SB); }                                                                          \
        RESC(alX); __syncthreads(); } while (0)
    for (int t = 1; t + 1 < NT; t += 2) {
        HALF_STEP(pB0, pB1, mnB, alB, pA0, pA1, alA, t, 1, 0, 0);
        HALF_STEP(pA0, pA1, mnA, alA, pB0, pB1, alB, t + 1, 0, 1, 1);
    }
    const bool even = (NT & 1) == 0;
    if (even) { SBAR(); qkt<1>(pB0, pB1, K_lds, r32, hi, S.qr); SBAR(); }
    SLOAD_H(nxt.K, nxt.V, 0); SBAR();
#pragma unroll
    for (int d0 = 0; d0 < 4; ++d0) S.qr[d0] = load8(nxt.Q + (size_t)(wid * QBLK + r32) * QP + d0 * 16 + hi * 8);
    SBAR();
    finishSM(pA0, pA1, alA, l_reg, pa0, pa1, pa2, pa3); SBAR();
    pv_tile<0>(o, vb0, pa0, pa1, pa2, pa3);
    if (even) { MASKT(pB0, pB1, NT - 1); partialSM(pB0, pB1, m_reg, mnB, alB); __syncthreads(); RESC(alB);
        finishSM(pB0, pB1, alB, l_reg, pa0, pa1, pa2, pa3); SBAR(); pv_tile<1>(o, vb0, pa0, pa1, pa2, pa3); }
    SBAR(); SEAM_K0();
    if (hi == 0) li_l[r32] = l_reg; asm volatile("s_waitcnt lgkmcnt(0)" ::: "memory");
    float rli[16];
#pragma unroll
    for (int r = 0; r < 16; ++r) rli[r] = __builtin_amdgcn_rcpf(li_l[crow(r, hi)]);
    bf16* Ow = cur.O + (size_t)(wid * QBLK) * OP;
#pragma unroll
    for (int r = 0; r < 16; ++r) { const int orow = crow(r, hi);
#pragma unroll
        for (int d0 = 0; d0 < 4; ++d0) { const float v = o[d0][r] * rli[r];
            const float vn = __shfl_xor(v, 1);
            if ((r32 & 1) == 0) *(unsigned*)(Ow + (size_t)orow * OP + d0 * 32 + r32) = cvtpk(v, vn); } }
    __syncthreads();
#undef RESC
#undef KBASE
#undef MASKT
#undef SEAM_K0
#undef HALF_STEP
}
#undef VMW
#undef VMWN
#undef SLOAD_H
#undef SWRITE_HK
#undef SWRITE_HV
#undef SWRITE_H
#undef KSWZ
__device__ __forceinline__ BlockRef make_ref(int L, int pass, const bf16* Q, const bf16* K, const bf16* V, bf16* O) {
    const int bh = L >> 3, x = L & 7, qb = pass ? 15 - x : x, b = bh >> 5, map = bh & 31;
    const size_t seq0 = (size_t)b * SEQ, row0 = seq0 + (size_t)qb * QB;
    BlockRef r; r.Q = Q + row0 * QP + map * 64; r.K = K + seq0 * QP + map * 64; r.V = V + seq0 * QP + (map >> 1) * 128; r.O = O + row0 * OP + map * 128; r.P0 = qb * QB; return r;
}
__device__ __forceinline__ void attn_phase(char* lds, const bf16* Q, const bf16* K, const bf16* V, bf16* O, int first, int stride, int wv) {
    constexpr int total = NB * 32 * 8;
    int L = first; if (L >= total) return;
    int pass = 0;
    BlockRef cur = make_ref(L, 0, Q, K, V, O);
    Seam S;
    attn_prime(cur, lds, S, wv);
    for (;;) {
        const bool more_pass = pass == 0, more_item = L + stride < total, last = !more_pass && !more_item;
        int passn = pass + 1, Ln = L;
        if (!more_pass) { passn = 0; Ln = more_item ? L + stride : L; }
        const BlockRef nxt = last ? cur : make_ref(Ln, passn, Q, K, V, O);
        attn_block(cur, nxt, lds, S, wv);
        if (last) break;
        cur = nxt; pass = passn; L = Ln;
    }
}
}
struct Args { const float* in[29]; float* out; unsigned char* ws; int ph_lo, ph_hi; };
enum { I_X = 0, I_C, I_WADA, I_BADA, I_GPREMIX, I_GPOSTMIX, I_GPREFFN, I_GPOSTFFN, I_WIN, I_CONVW, I_CONVB, I_DTBIAS, I_ALOG, I_DSKIP, I_SSDNW,
       I_LQ1, I_LK1, I_LQ2, I_LK2, I_SUBLN, I_WBS, I_WBA, I_WOUT, I_WR, I_BR, I_WGU, I_BGU, I_WDN, I_BDN };
#define WSP(T, off) ((T*)(a.ws + (off) * MiB))

__device__ __forceinline__ void ph_mod(const Args& a, LAS unsigned char* lds, int wv) {
    LAS float* sc = (LAS float*)lds;
    LAS float* part = (LAS float*)(lds + 32768);
    const int tid = otid(wv); const float* c = a.in[I_C]; const float* W = a.in[I_WADA]; const float* bada = a.in[I_BADA]; float* mod = WSP(float, WS_MOD);
    for (int i = tid; i < NB * DM; i += NTHR) sc[i] = siluf_(c[i]);
    __syncthreads();
    for (int cb = blockIdx.x; cb < 256; cb += gridDim.x) {
        const int ks = tid / 12, quad = tid % 12;
        f32x4 acc[4] = {{0.f, 0.f, 0.f, 0.f}, {0.f, 0.f, 0.f, 0.f}, {0.f, 0.f, 0.f, 0.f}, {0.f, 0.f, 0.f, 0.f}};
        if (ks < 42) {
#pragma unroll 4
            for (int k = ks; k < DM; k += 42) { const f32x4 w = *(const f32x4*)(W + (size_t)k * 12288 + cb * 48 + quad * 4);
#pragma unroll
                for (int b = 0; b < 4; ++b) acc[b] += w * sc[b * DM + k]; }
#pragma unroll
            for (int b = 0; b < 4; ++b) *(LAS f32x4*)(part + (ks * 12 + quad) * 16 + b * 4) = acc[b];
        }
        __syncthreads();
        if (tid < 192) { const int col = tid % 48, b = tid / 48; float s = 0.f;
            for (int k2 = 0; k2 < 42; ++k2) s += part[(k2 * 12 + (col >> 2)) * 16 + b * 4 + (col & 3)];
            mod[b * 12288 + cb * 48 + col] = s + bada[cb * 48 + col]; }
        __syncthreads();
    }
}

constexpr int TRP = 68;
struct TrSrc { const float* p[4]; bool zero; };
__device__ __forceinline__ const float* tr_src(const float* W, int N, int k0, int d0, int kind, int lane, bool& zero) {
    const int j4 = (lane & 15) * 4; int scol; zero = false;
    if (kind == 0) scol = d0 + j4;
    else if (kind == 1) { const int r = d0 + j4;
        if (r < 5120) scol = r; else if (r < 15360) scol = r + 32; else if (r < 15392) scol = 5120 + (r - 15360); else { scol = 0; zero = true; } }
    else { const int t = d0 >> 8, w = d0 & 255; scol = 128 * t + (w < 128 ? w : 2048 + (w - 128)) + j4; }
    return W + (size_t)(k0 + (lane >> 4)) * N + scol;
}
__device__ __forceinline__ void tr_load8(const float* src, int N, bool zero, int half, f32x4 (&v)[8]) {
#pragma unroll
    for (int i = 0; i < 8; ++i) v[i] = zero ? (f32x4){0.f, 0.f, 0.f, 0.f} : *(const f32x4*)(src + (size_t)(4 * (8 * half + i)) * N);
}
__device__ __forceinline__ void tr_put8(const f32x4 (&v)[8], int half, LAS bf16* scr, int lane) {
#pragma unroll
    for (int i = 0; i < 8; ++i) { const int k = (lane >> 4) + 4 * (8 * half + i); u32x2 w; w.x = cvt_pk_bf16(v[i][0], v[i][1]); w.y = cvt_pk_bf16(v[i][2], v[i][3]);
        *(LAS u32x2*)(scr + k * TRP + (lane & 15) * 4) = w; }
}
__device__ __forceinline__ void tr_flush(bf16* WT, int K, int k0, int d0, int kind, const LAS bf16* scr, int lane) {
    typedef short v4i16_t __attribute__((ext_vector_type(4)));
    const int g = lane >> 4, i16 = lane & 15, q = (lane >> 2) & 3, pp = lane & 3;
#pragma unroll
    for (int nb = 0; nb < 4; ++nb) { const int lc = 16 * nb + i16;
        const int r = lc;
#pragma unroll
        for (int j = 0; j < 2; ++j) { const int kc = 8 * (g + 4 * j);
            const LAS bf16* a0 = scr + (kc + q) * TRP + 16 * nb + 4 * pp;
            const v4i16_t lo = __builtin_amdgcn_ds_read_tr16_b64_v4i16((LAS v4i16_t*)a0);
            const v4i16_t hi = __builtin_amdgcn_ds_read_tr16_b64_v4i16((LAS v4i16_t*)(a0 + 4 * TRP));
            u32x4 o; o.x = (unsigned)(unsigned short)lo[0] | ((unsigned)(unsigned short)lo[1] << 16); o.y = (unsigned)(unsigned short)lo[2] | ((unsigned)(unsigned short)lo[3] << 16);
            o.z = (unsigned)(unsigned short)hi[0] | ((unsigned)(unsigned short)hi[1] << 16); o.w = (unsigned)(unsigned short)hi[2] | ((unsigned)(unsigned short)hi[3] << 16);
            *(u32x4*)(WT + (size_t)(d0 + r) * K + k0 + kc) = o; } }
}
__device__ __forceinline__ void tr_flush8(unsigned char* WT, int K, int k0, int d0, int kind, const LAS bf16* scr, int lane) {
    typedef short v4i16_t __attribute__((ext_vector_type(4)));
    const int g = lane >> 4, i16 = lane & 15, q = (lane >> 2) & 3, pp = lane & 3;
#pragma unroll
    for (int nb = 0; nb < 4; ++nb) { const int lc = 16 * nb + i16;
        const int r = lc;
        const LAS bf16* a0 = scr + (16 * g + q) * TRP + 16 * nb + 4 * pp; unsigned o[4];
#pragma unroll
        for (int j = 0; j < 4; ++j) { const v4i16_t v = __builtin_amdgcn_ds_read_tr16_b64_v4i16((LAS v4i16_t*)(a0 + 4 * j * TRP));
            o[j] = pk4_fp8(bf2f((unsigned short)v[0]) * 64.f, bf2f((unsigned short)v[1]) * 64.f, bf2f((unsigned short)v[2]) * 64.f, bf2f((unsigned short)v[3]) * 64.f); }
        *(u32x4*)(WT + (size_t)(d0 + r) * K + k0 + 16 * g) = (u32x4){o[0], o[1], o[2], o[3]}; }
}
struct TrItem { const float* W; bf16* WT; int N, k0, d0, kind; bool fp8; };
__device__ __forceinline__ bool tr_decode(const Args& a, int it, TrItem& t) {
    constexpr int I_IN = (DM / 64) * (NPROJ / 64), I_SQ = (DM / 64) * (DM / 64), I_GU = (DM / 64) * (4096 / 64), I_DN = I_SQ;
    constexpr int NITEMS = I_IN + 3 * I_SQ + NE * I_GU + NE * I_DN;
    if (it >= NITEMS) return false;
    int r = it;
    if (r < I_IN) { constexpr int nblk = NPROJ / 64; t = TrItem{a.in[I_WIN], WSP(bf16, WS_WT_IN), 15392, 64 * (r / nblk), 64 * (r % nblk), 1, false}; return true; } r -= I_IN;
    if (r < I_SQ) { t = TrItem{a.in[I_WBS], WSP(bf16, WS_WT_BS), DM, 64 * (r / 32), 64 * (r % 32), 0, false}; return true; } r -= I_SQ;
    if (r < I_SQ) { t = TrItem{a.in[I_WBA], WSP(bf16, WS_WT_BA), DM, 64 * (r / 32), 64 * (r % 32), 0, false}; return true; } r -= I_SQ;
    if (r < I_SQ) { t = TrItem{a.in[I_WOUT], WSP(bf16, WS_WT_OUT), DM, 64 * (r / 32), 64 * (r % 32), 0, false}; return true; } r -= I_SQ;
    if (r < NE * I_GU) { const int e = r / I_GU, q = r % I_GU; t = TrItem{a.in[I_WGU] + (size_t)e * DM * 4096, (bf16*)(WSP(unsigned char, WS_WT_GU) + (size_t)e * 4096 * DM), 4096, 64 * (q / 64), 64 * (q % 64), 2, true}; return true; } r -= NE * I_GU;
    { const int e = r / I_DN, q = r % I_DN; t = TrItem{a.in[I_WDN] + (size_t)e * DM * DM, (bf16*)(WSP(unsigned char, WS_WT_DN) + (size_t)e * DM * DM), DM, 64 * (q / 32), 64 * (q % 32), 0, true}; return true; }
}
__device__ __forceinline__ void tr_all(const Args& a, LAS bf16* scr, int gw, int NGW, int lane) {
    TrItem cur; if (!tr_decode(a, gw, cur)) return;
    bool zc; const float* sc = tr_src(cur.W, cur.N, cur.k0, cur.d0, cur.kind, lane, zc);
    f32x4 v0[8], v1[8];
    tr_load8(sc, cur.N, zc, 0, v0);
    for (int it = gw;; ) {
        tr_load8(sc, cur.N, zc, 1, v1);
        tr_put8(v0, 0, scr, lane);
        const int itn = it + NGW; TrItem nxt; const bool more = tr_decode(a, itn, nxt);
        bool zn = zc; const float* sn = sc; if (more) sn = tr_src(nxt.W, nxt.N, nxt.k0, nxt.d0, nxt.kind, lane, zn);
        if (more) tr_load8(sn, nxt.N, zn, 0, v0);
        tr_put8(v1, 1, scr, lane);
        if (cur.fp8) tr_flush8((unsigned char*)cur.WT, DM, cur.k0, cur.d0, cur.kind, scr, lane); else tr_flush(cur.WT, DM, cur.k0, cur.d0, cur.kind, scr, lane);
        if (!more) break;
        cur = nxt; sc = sn; zc = zn; it = itn;
    }
}
__device__ __forceinline__ void sincos_acc(float angf, float& s_out, float& c_out) {
    const double ang = (double)angf; const double twopi = 6.283185307179586476925, inv2pi = 0.159154943091895335769;
    double q = ang * inv2pi; q = q - (double)(long long)(q + 0.5);
    const double r = q * twopi * 0.25, r2 = r * r;
    double s = r * (1.0 + r2 * (-1.0 / 6 + r2 * (1.0 / 120 + r2 * (-1.0 / 5040 + r2 * (1.0 / 362880 + r2 * (-1.0 / 39916800 + r2 * (1.0 / 6227020800.0)))))));
    double c = 1.0 + r2 * (-0.5 + r2 * (1.0 / 24 + r2 * (-1.0 / 720 + r2 * (1.0 / 40320 + r2 * (-1.0 / 3628800 + r2 * (1.0 / 479001600.0))))));
    double s2 = 2 * s * c, c2 = c * c - s * s; s = 2 * s2 * c2; c = c2 * c2 - s2 * s2;
    s_out = (float)s; c_out = (float)c;
}
__device__ __forceinline__ void rms_row_to_bf16(const float* xrow, const float* g, const float* scv, const float* shv, bf16* orow, int lane, float eps) {
    f32x4 v[8]; float s = 0.f;
#pragma unroll
    for (int j = 0; j < 8; ++j) { v[j] = *((const f32x4*)xrow + lane + 64 * j); s += (v[j].x * v[j].x + v[j].y * v[j].y) + (v[j].z * v[j].z + v[j].w * v[j].w); }
    const float rstd = 1.0f / sqrtf(wave_sum(s) * (1.0f / DM) + eps);
#pragma unroll
    for (int j = 0; j < 8; ++j) { const int o4 = lane + 64 * j; const f32x4 gg = *((const f32x4*)g + o4), s1 = *((const f32x4*)scv + o4), s0 = *((const f32x4*)shv + o4);
        const f32x4 y = v[j] * rstd * gg * (s1 + 1.0f) + s0;
        u32x2 w; w.x = pk2(y.x, y.y); w.y = pk2(y.z, y.w); *((u32x2*)orow + o4) = w; }
}
__device__ __forceinline__ void ph_prep(const Args& a, LAS unsigned char* lds, int vcu, int G, int wv) {
    const int tid = otid(wv), lane = tid & 63, wave = __builtin_amdgcn_readfirstlane(tid >> 6);
    const int gw = vcu * NWAVES + wave, NGW = G * NWAVES, gt = vcu * NTHR + tid, NGT = G * NTHR;
    const float* mod = WSP(float, WS_MOD);
    { float* rope = WSP(float, WS_ROPE);
      const float invf[8] = {1.0f, 0.19392274f, 0.03760603f, 0.0072926646f, 0.0014142136f, 0.0002742482f, 5.3182957e-05f, 1.0313385e-05f};
      for (int i = gt; i < SEQ * 8; i += NGT) { const int pos = i >> 3, j = i & 7; float fr_ = 1.0f;
#pragma unroll
          for (int q = 0; q < 8; ++q) fr_ = (j == q) ? invf[q] : fr_;
          const float ang = (float)pos * fr_; float s, c; sincos_acc(ang, s, c); rope[pos * 16 + j] = c; rope[pos * 16 + 8 + j] = s; } }
    { float* wr = WSP(float, WS_WR); const float* Wr = a.in[I_WR]; const float* g = a.in[I_GPREFFN];
      for (int i = gt; i < NB * DM * NE; i += NGT) { const int b = i / (DM * NE), r = i % (DM * NE), k = r / NE; wr[i] = g[k] * (1.0f + mod[b * 12288 + 8192 + k]) * Wr[r]; }
      if (vcu == 0 && tid < NB * NE) { const int b = tid / NE, e = tid % NE; float s = 0.f; for (int k = 0; k < DM; ++k) s += mod[b * 12288 + 6144 + k] * Wr[k * NE + e];
          ((float*)(a.ws + WS_MOD * MiB + MOD_CB))[tid] = s + a.in[I_BR][e]; } }
    { const float* x = a.in[I_X]; bf16* H = WSP(bf16, WS_H); const float* g = a.in[I_GPREMIX];
      for (int m = gw; m < MT; m += NGW) { const int b = m / SEQ; rms_row_to_bf16(x + (size_t)m * DM, g, mod + b * 12288 + 2048, mod + b * 12288, H + (size_t)m * DM, lane, 1e-6f); } }
    tr_all(a, (LAS bf16*)(lds + wave * 16384), gw, NGW, lane);
}

__device__ __forceinline__ void ph_conv(const Args& a, int vcu, int G, int wv) {
    const int gt = vcu * NTHR + otid(wv), NGT = G * NTHR;
    { const bf16* X = WSP(bf16, WS_XBC); bf16* Y = WSP(bf16, WS_XBCC); const float* cw = a.in[I_CONVW]; const float* cbias = a.in[I_CONVB];
      for (int it = gt; it < (XBCW / 8) * (MT / 64); it += NGT) { const int cg = it % (XBCW / 8), seg = it / (XBCW / 8), c0 = cg * 8, t0 = seg * 64;
          float w[4][8], bb[8];
#pragma unroll
          for (int k = 0; k < 4; ++k) { const f32x4 w0 = *(const f32x4*)(cw + k * XBCW + c0), w1 = *(const f32x4*)(cw + k * XBCW + c0 + 4);
#pragma unroll
              for (int q = 0; q < 4; ++q) { w[k][q] = w0[q]; w[k][4 + q] = w1[q]; } }
          { const f32x4 b0 = *(const f32x4*)(cbias + c0), b1 = *(const f32x4*)(cbias + c0 + 4);
#pragma unroll
            for (int q = 0; q < 4; ++q) { bb[q] = b0[q]; bb[4 + q] = b1[q]; } }
          float hs[3][8];
          const bool seqstart = (t0 % SEQ) == 0;
#pragma unroll
          for (int r = 0; r < 3; ++r) { u32x4 v = {0u, 0u, 0u, 0u}; if (!seqstart) v = *(const u32x4*)(X + (size_t)(t0 - 3 + r) * XBCW + c0);
              hs[r][0] = bflo(v.x); hs[r][1] = bfhi(v.x); hs[r][2] = bflo(v.y); hs[r][3] = bfhi(v.y); hs[r][4] = bflo(v.z); hs[r][5] = bfhi(v.z); hs[r][6] = bflo(v.w); hs[r][7] = bfhi(v.w); }
#pragma unroll 4
          for (int t = 0; t < 64; ++t) { const u32x4 v = *(const u32x4*)(X + (size_t)(t0 + t) * XBCW + c0);
              float xc[8] = {bflo(v.x), bfhi(v.x), bflo(v.y), bfhi(v.y), bflo(v.z), bfhi(v.z), bflo(v.w), bfhi(v.w)}; float y[8];
#pragma unroll
              for (int q = 0; q < 8; ++q) { const float s = bb[q] + w[0][q] * hs[0][q] + w[1][q] * hs[1][q] + w[2][q] * hs[2][q] + w[3][q] * xc[q]; y[q] = siluf_(s); hs[0][q] = hs[1][q]; hs[1][q] = hs[2][q]; hs[2][q] = xc[q]; }
              u32x4 o; o.x = pk2(y[0], y[1]); o.y = pk2(y[2], y[3]); o.z = pk2(y[4], y[5]); o.w = pk2(y[6], y[7]);
              *(u32x4*)(Y + (size_t)(t0 + t) * XBCW + c0) = o; } } }
    { const float* dr = WSP(float, WS_DTRAW); float* dt = WSP(float, WS_DT); const float* bias = a.in[I_DTBIAS];
      for (int i = gt; i < MT * 32; i += NGT) { const float x = dr[i] + bias[i & 31]; dt[i] = (x > 20.f) ? x : log1pf(__expf(x)); } }
    { const float* rope = WSP(float, WS_ROPE);
      for (int it = gt; it < MT * 32 * 2; it += NGT) { const int which = it / (MT * 32), r = it % (MT * 32), t = r >> 5, hd = r & 31; bf16* p = (which ? WSP(bf16, WS_K) : WSP(bf16, WS_Q)) + (size_t)t * DM + hd * 64;
          const u32x4 v1 = *(const u32x4*)p, v2 = *(const u32x4*)(p + 8); const float* rp = rope + (t % SEQ) * 16;
          const f32x4 c0 = *(const f32x4*)rp, c1 = *(const f32x4*)(rp + 4), s0 = *(const f32x4*)(rp + 8), s1 = *(const f32x4*)(rp + 12);
          const float x1[8] = {bflo(v1.x), bfhi(v1.x), bflo(v1.y), bfhi(v1.y), bflo(v1.z), bfhi(v1.z), bflo(v1.w), bfhi(v1.w)};
          const float x2[8] = {bflo(v2.x), bfhi(v2.x), bflo(v2.y), bfhi(v2.y), bflo(v2.z), bfhi(v2.z), bflo(v2.w), bfhi(v2.w)};
          const float cc[8] = {c0[0], c0[1], c0[2], c0[3], c1[0], c1[1], c1[2], c1[3]}, ss[8] = {s0[0], s0[1], s0[2], s0[3], s1[0], s1[1], s1[2], s1[3]};
          float y1[8], y2[8];
#pragma unroll
          for (int q = 0; q < 8; ++q) { y1[q] = x1[q] * cc[q] - x2[q] * ss[q]; y2[q] = x2[q] * cc[q] + x1[q] * ss[q]; }
          u32x4 o1, o2; o1.x = pk2(y1[0], y1[1]); o1.y = pk2(y1[2], y1[3]); o1.z = pk2(y1[4], y1[5]); o1.w = pk2(y1[6], y1[7]);
          o2.x = pk2(y2[0], y2[1]); o2.y = pk2(y2[2], y2[3]); o2.z = pk2(y2[4], y2[5]); o2.w = pk2(y2[6], y2[7]);
          *(u32x4*)p = o1; *(u32x4*)(p + 8) = o2; } }
}
constexpr int SP = 136;
#define SSD_FRAG(base, row, k0) (*(const LAS bf16x8*)((base) + (row) * SP + (k0)))
template <bool ALSO_T> __device__ __forceinline__ void ssd_stage128(const bf16* X, int t0, int col0, LAS bf16* dst, LAS bf16* dstT, int tid) {
#pragma unroll
    for (int i = 0; i < 4; ++i) { const int q = tid + NTHR * i, row = q >> 4, ch = q & 15;
        const u32x4 v = *(const u32x4*)(X + (size_t)(t0 + row) * XBCW + col0 + ch * 8);
        *(LAS u32x4*)(dst + row * SP + ch * 8) = v;
        if constexpr (ALSO_T) { const unsigned w[4] = {v.x, v.y, v.z, v.w};
#pragma unroll
            for (int j = 0; j < 4; ++j) { dstT[(ch * 8 + 2 * j) * SP + row] = (bf16)(w[j] & 0xffffu); dstT[(ch * 8 + 2 * j + 1) * SP + row] = (bf16)(w[j] >> 16); } } }
}
__device__ __forceinline__ void ph_ssd1(const Args& a, LAS unsigned char* lds, int first, int stride, int wv) {
    const int tid = otid(wv), lane = tid & 63, w = __builtin_amdgcn_readfirstlane(tid >> 6), l15 = lane & 15, lq = lane >> 4;
    LAS bf16* R1 = (LAS bf16*)lds;
    LAS bf16* R2 = (LAS bf16*)(lds + 34816);
    LAS bf16* R3 = (LAS bf16*)(lds + 69632);
    LAS float* acs = (LAS float*)(lds + 104448);
    LAS float* dts = (LAS float*)(lds + 108544);
    const bf16* X = WSP(bf16, WS_XBCC); const float* DT = WSP(float, WS_DT); float* ACS = WSP(float, WS_ACS); float* YD = WSP(float, WS_YDIAG); float* ST = WSP(float, WS_STATES);
    for (int u = first; u < NB * 32 * 4; u += stride) {
        const int g = u & 3, bc = u >> 2, t0 = bc * 128;
        ssd_stage128<false>(X, t0, 2560 + g * 128, R1, nullptr, tid);
        ssd_stage128<true>(X, t0, 2048 + g * 128, R2, R3, tid);
        { const int h = g * 8 + w; const float Ah = -__expf(a.in[I_ALOG][h]);
          const float d0 = DT[(size_t)(t0 + 2 * lane) * 32 + h], d1 = DT[(size_t)(t0 + 2 * lane + 1) * 32 + h];
          const float a0 = d0 * Ah, a1 = d1 * Ah; float s = a0 + a1;
#pragma unroll
          for (int o = 1; o < 64; o <<= 1) { const float t = __shfl_up(s, o); if (lane >= o) s += t; }
          acs[w * 128 + 2 * lane] = s - a1; acs[w * 128 + 2 * lane + 1] = s; dts[w * 128 + 2 * lane] = d0; dts[w * 128 + 2 * lane + 1] = d1;
          float* ag = ACS + ((size_t)bc * 32 + h) * 128; ag[2 * lane] = s - a1; ag[2 * lane + 1] = s; }
        __syncthreads();
        f32x4 S[8];
#pragma unroll
        for (int mt = 0; mt < 8; ++mt) { S[mt] = (f32x4){0.f, 0.f, 0.f, 0.f};
#pragma unroll
            for (int ks = 0; ks < 4; ++ks) S[mt] = __builtin_amdgcn_mfma_f32_16x16x32_bf16(SSD_FRAG(R2, 16 * mt + l15, 32 * ks + 8 * lq), SSD_FRAG(R1, 16 * w + l15, 32 * ks + 8 * lq), S[mt], 0, 0, 0); }
        __syncthreads();
        LAS bf16* G = R1; LAS bf16* Xt = R2; LAS bf16* Xwt = R2 + 64 * SP;
#pragma unroll 1
        for (int hh = 0; hh < 8; ++hh) {
            const int h = g * 8 + hh; const LAS float* ac = acs + hh * 128; const float aend = ac[127];
#pragma unroll
            for (int i = 0; i < 2; ++i) { const int q = tid + NTHR * i, l = q >> 3, ch = q & 7;
                const u32x4 v = *(const u32x4*)(X + (size_t)(t0 + l) * XBCW + h * 64 + ch * 8); const float dl = dts[hh * 128 + l], wl = dl * __expf(aend - ac[l]);
                const float xv[8] = {bflo(v.x), bfhi(v.x), bflo(v.y), bfhi(v.y), bflo(v.z), bfhi(v.z), bflo(v.w), bfhi(v.w)};
#pragma unroll
                for (int j = 0; j < 8; ++j) { Xt[(ch * 8 + j) * SP + l] = (bf16)f2bf(xv[j] * dl); Xwt[(ch * 8 + j) * SP + l] = (bf16)f2bf(xv[j] * wl); } }
            { const int l = 16 * w + l15; const float al = ac[l];
#pragma unroll
              for (int mt = 0; mt < 8; ++mt) { float gv[4];
#pragma unroll
                  for (int r = 0; r < 4; ++r) { const int s = 16 * mt + 4 * lq + r; gv[r] = (s <= l) ? S[mt][r] * __expf(al - ac[s]) : 0.f; }
                  u32x2 pk; pk.x = pk2(gv[0], gv[1]); pk.y = pk2(gv[2], gv[3]);
                  *(LAS u32x2*)(G + l * SP + 16 * mt + 4 * lq) = pk; } }
            __syncthreads();
#pragma unroll
            for (int pt = 0; pt < 4; ++pt) { f32x4 acc = {0.f, 0.f, 0.f, 0.f};
#pragma unroll
                for (int ks = 0; ks < 4; ++ks) acc = __builtin_amdgcn_mfma_f32_16x16x32_bf16(SSD_FRAG(Xt, 16 * pt + l15, 32 * ks + 8 * lq), SSD_FRAG(G, 16 * w + l15, 32 * ks + 8 * lq), acc, 0, 0, 0);
                *(f32x4*)(YD + (size_t)(t0 + 16 * w + l15) * DM + h * 64 + 16 * pt + 4 * lq) = acc; }
#pragma unroll
            for (int pt = 0; pt < 4; ++pt) { f32x4 acc = {0.f, 0.f, 0.f, 0.f};
#pragma unroll
                for (int ks = 0; ks < 4; ++ks) acc = __builtin_amdgcn_mfma_f32_16x16x32_bf16(SSD_FRAG(R3, 16 * w + l15, 32 * ks + 8 * lq), SSD_FRAG(Xwt, 16 * pt + l15, 32 * ks + 8 * lq), acc, 0, 0, 0);
                *(f32x4*)(ST + (((size_t)bc * 32 + h) * 64 + 16 * pt + l15) * 128 + 16 * w + 4 * lq) = acc; }
            __syncthreads();
        }
    }
}
__device__ __forceinline__ void ph_ssd2(const Args& a, int vcu, int G, int wv) {
    const int gt = vcu * NTHR + otid(wv), NGT = G * NTHR; float* ST = WSP(float, WS_STATES); const float* ACS = WSP(float, WS_ACS);
    for (int it = gt; it < NB * 32 * 2048; it += NGT) { const int q = it & 2047, bh = it >> 11, b = bh >> 5, h = bh & 31;
        f32x4 run = {0.f, 0.f, 0.f, 0.f};
#pragma unroll 4
        for (int c = 0; c < 32; ++c) { const size_t bc = (size_t)b * 32 + c; f32x4* p = (f32x4*)(ST + (bc * 32 + h) * 8192) + q; const f32x4 s = *p; const float dec = __expf(ACS[(bc * 32 + h) * 128 + 127]);
            *p = run; run = run * dec + s; } }
}
__device__ __forceinline__ void ph_ssd3(const Args& a, LAS unsigned char* lds, int first, int stride, int wv) {
    const int tid = otid(wv), lane = tid & 63, w = __builtin_amdgcn_readfirstlane(tid >> 6), l15 = lane & 15, lq = lane >> 4;
    LAS bf16* Cs = (LAS bf16*)lds; LAS bf16* Pv = (LAS bf16*)(lds + 34816); LAS float* acs = (LAS float*)(lds + 104448);
    const bf16* X = WSP(bf16, WS_XBCC); const float* ACS = WSP(float, WS_ACS); const float* YD = WSP(float, WS_YDIAG); const float* ST = WSP(float, WS_STATES);
    const bf16* Z = WSP(bf16, WS_Z); bf16* YB = WSP(bf16, WS_YBUF); const float* dskip = a.in[I_DSKIP]; const float* nw = a.in[I_SSDNW];
    for (int u = first; u < NB * 32 * 4; u += stride) {
        const int g = u & 3, bc = u >> 2, t0 = bc * 128;
        ssd_stage128<false>(X, t0, 2560 + g * 128, Cs, nullptr, tid);
#pragma unroll
        for (int i = 0; i < 2; ++i) { const int q = tid + NTHR * i; acs[q] = ACS[((size_t)bc * 32 + g * 8 + (q >> 7)) * 128 + (q & 127)]; }
        __syncthreads();
        const int l = 16 * w + l15; const size_t t = (size_t)t0 + l; float ss = 0.f;
#pragma unroll 1
        for (int hh = 0; hh < 8; ++hh) {
            const int h = g * 8 + hh;
#pragma unroll
            for (int i = 0; i < 4; ++i) { const int q = tid + NTHR * i, p = q >> 5, n4 = (q & 31) * 4;
                const f32x4 v = *(const f32x4*)(ST + ((size_t)bc * 32 + h) * 8192 + p * 128 + n4); u32x2 pk; pk.x = pk2(v[0], v[1]); pk.y = pk2(v[2], v[3]);
                *(LAS u32x2*)(Pv + p * SP + n4) = pk; }
            __syncthreads();
            const float ea = __expf(acs[hh * 128 + l]), dsk = dskip[h];
#pragma unroll
            for (int pt = 0; pt < 4; ++pt) { f32x4 acc = {0.f, 0.f, 0.f, 0.f};
#pragma unroll
                for (int ks = 0; ks < 4; ++ks) acc = __builtin_amdgcn_mfma_f32_16x16x32_bf16(SSD_FRAG(Pv, 16 * pt + l15, 32 * ks + 8 * lq), SSD_FRAG(Cs, 16 * w + l15, 32 * ks + 8 * lq), acc, 0, 0, 0);
                const int col = h * 64 + 16 * pt + 4 * lq;
                const f32x4 yd = *(const f32x4*)(YD + t * DM + col); const u32x2 xs = *(const u32x2*)(X + t * XBCW + col), zz = *(const u32x2*)(Z + t * DM + col);
                const float xv[4] = {bflo(xs.x), bfhi(xs.x), bflo(xs.y), bfhi(xs.y)}, zv[4] = {bflo(zz.x), bfhi(zz.x), bflo(zz.y), bfhi(zz.y)}; float uu[4];
#pragma unroll
                for (int r = 0; r < 4; ++r) { const float y = yd[r] + ea * acc[r] + dsk * xv[r]; uu[r] = y * siluf_(zv[r]); ss += uu[r] * uu[r]; }
                u32x2 pk; pk.x = pk2(uu[0], uu[1]); pk.y = pk2(uu[2], uu[3]); *(u32x2*)(YB + t * DM + col) = pk; }
            __syncthreads();
        }
        ss += __shfl_xor(ss, 16); ss += __shfl_xor(ss, 32);
        const float rstd = 1.0f / sqrtf(ss * (1.0f / 512.0f) + 1e-5f);
        VM_WAIT();
#pragma unroll 1
        for (int hh = 0; hh < 8; ++hh)
#pragma unroll
            for (int pt = 0; pt < 4; ++pt) { const int col = (g * 8 + hh) * 64 + 16 * pt + 4 * lq; u32x2* p = (u32x2*)(YB + t * DM + col); const u32x2 v = *p; const f32x4 wv = *(const f32x4*)(nw + col);
                u32x2 pk; pk.x = pk2(bflo(v.x) * rstd * wv[0], bfhi(v.x) * rstd * wv[1]); pk.y = pk2(bflo(v.y) * rstd * wv[2], bfhi(v.y) * rstd * wv[3]); *p = pk; }
        __syncthreads();
    }
}
__device__ __forceinline__ void ph_attn_combine(const Args& a, int vcu, int G, int wv) {
    const int tid = otid(wv), lane = tid & 63, wave = __builtin_amdgcn_readfirstlane(tid >> 6), gw = vcu * NWAVES + wave, NGW = G * NWAVES;
    float d1 = a.in[I_LQ1][lane] * a.in[I_LK1][lane], d2 = a.in[I_LQ2][lane] * a.in[I_LK2][lane]; d1 = wave_sum(d1); d2 = wave_sum(d2);
    const float lam = __expf(d1) - __expf(d2) + 0.2f;
    const bf16* OA = WSP(bf16, WS_OATT); bf16* OF = WSP(bf16, WS_OFIN); const float* sw = a.in[I_SUBLN];
    const int head = lane >> 2, dq = (lane & 3) * 32;
    for (int m = gw; m < MT; m += NGW) { const bf16* p0 = OA + (size_t)m * 4096 + (2 * head) * 128 + dq; const bf16* p1 = p0 + 128; float d[32]; float ss = 0.f;
#pragma unroll
        for (int i = 0; i < 4; ++i) { const u32x4 x = *(const u32x4*)(p0 + 8 * i), y = *(const u32x4*)(p1 + 8 * i);
            const unsigned xa[4] = {x.x, x.y, x.z, x.w}, ya[4] = {y.x, y.y, y.z, y.w};
#pragma unroll
            for (int j = 0; j < 4; ++j) { const float v0 = bflo(xa[j]) - lam * bflo(ya[j]), v1 = bfhi(xa[j]) - lam * bfhi(ya[j]); d[8 * i + 2 * j] = v0; d[8 * i + 2 * j + 1] = v1; ss += v0 * v0 + v1 * v1; } }
        ss += __shfl_xor(ss, 1); ss += __shfl_xor(ss, 2);
        const float rstd = 0.8f / sqrtf(ss * (1.0f / 128.0f) + 1e-5f);
        bf16* o = OF + (size_t)m * DM + head * 128 + dq;
#pragma unroll
        for (int i = 0; i < 4; ++i) { const f32x4 w0 = *(const f32x4*)(sw + dq + 8 * i), w1 = *(const f32x4*)(sw + dq + 8 * i + 4);
            u32x4 pk; pk.x = pk2(d[8 * i] * rstd * w0[0], d[8 * i + 1] * rstd * w0[1]); pk.y = pk2(d[8 * i + 2] * rstd * w0[2], d[8 * i + 3] * rstd * w0[3]);
            pk.z = pk2(d[8 * i + 4] * rstd * w1[0], d[8 * i + 5] * rstd * w1[1]); pk.w = pk2(d[8 * i + 6] * rstd * w1[2], d[8 * i + 7] * rstd * w1[3]);
            *(u32x4*)(o + 8 * i) = pk; } }
}
__device__ __forceinline__ void ph_rows1(const Args& a, int vcu, int G, int wv) {
    const int tid = otid(wv), lane = tid & 63, wave = __builtin_amdgcn_readfirstlane(tid >> 6), gw = vcu * NWAVES + wave, NGW = G * NWAVES;
    const float* mod = WSP(float, WS_MOD); const float* x = a.in[I_X]; const float* mix = WSP(float, WS_MIX); float* X1 = WSP(float, WS_X1); unsigned char* H2 = WSP(unsigned char, WS_H2); float* RS = WSP(float, WS_RSTD);
    const float* gpm = a.in[I_GPOSTMIX]; const float* gpf = a.in[I_GPREFFN];
    for (int m = gw; m < MT; m += NGW) { const int b = m / SEQ; const float* mb = mod + b * 12288;
        f32x4 v[8]; float s = 0.f;
#pragma unroll
        for (int j = 0; j < 8; ++j) { v[j] = *((const f32x4*)(mix + (size_t)m * DM) + lane + 64 * j); s += (v[j].x * v[j].x + v[j].y * v[j].y) + (v[j].z * v[j].z + v[j].w * v[j].w); }
        const float rstdm = 1.0f / sqrtf(wave_sum(s) * (1.0f / DM) + 1e-6f); float s1 = 0.f;
#pragma unroll
        for (int j = 0; j < 8; ++j) { const int o4 = lane + 64 * j; const f32x4 xx = *((const f32x4*)(x + (size_t)m * DM) + o4), gg = *((const f32x4*)gpm + o4), gt = *((const f32x4*)(mb + 4096) + o4);
            v[j] = xx + gt * (v[j] * rstdm * gg); *((f32x4*)(X1 + (size_t)m * DM) + o4) = v[j]; s1 += (v[j].x * v[j].x + v[j].y * v[j].y) + (v[j].z * v[j].z + v[j].w * v[j].w); }
        const float rstd1 = 1.0f / sqrtf(wave_sum(s1) * (1.0f / DM) + 1e-6f);
        if (lane == 0) RS[m] = rstd1;
#pragma unroll
        for (int j = 0; j < 8; ++j) { const int o4 = lane + 64 * j; const f32x4 gg = *((const f32x4*)gpf + o4), sc = *((const f32x4*)(mb + 8192) + o4), sh = *((const f32x4*)(mb + 6144) + o4);
            const f32x4 y = v[j] * rstd1 * gg * (sc + 1.0f) + sh; *((unsigned*)(H2 + (size_t)m * DM) + o4) = pk4_fp8(y.x, y.y, y.z, y.w); } }
}
__device__ __forceinline__ void ph_router(const Args& a, LAS unsigned char* lds, int first, int stride, int wv) {
    const int tid = otid(wv), lane = tid & 63, w = __builtin_amdgcn_readfirstlane(tid >> 6), r32 = lane & 31, hi = lane >> 5;
    LAS float* part = (LAS float*)lds;
    LAS float* lg = (LAS float*)(lds + 8 * 32 * 33 * 4);
    const float* X1 = WSP(float, WS_X1); const float* WR = WSP(float, WS_WR); const float* RS = WSP(float, WS_RSTD); const float* CB = (const float*)(a.ws + WS_MOD * MiB + MOD_CB);
    unsigned* cnt = (unsigned*)(a.ws + WS_CTL * MiB) + CW_CNT;
    int* ltok = (int*)(a.ws + WS_LISTS * MiB); float* lw = (float*)(a.ws + WS_LISTS * MiB + LIST_STRIDE); int* ldst = (int*)(a.ws + WS_LISTS * MiB + 2 * LIST_STRIDE);
    for (int tile = first; tile < MT / 32; tile += stride) {
        const int tok0 = tile * 32, b = tok0 / SEQ; const int kb = w * 256;
        const float* xr = X1 + (size_t)(tok0 + r32) * DM + kb; const float* wb = WR + ((size_t)b * DM + kb) * NE;
        f32x16 acc = {};
#pragma unroll 4
        for (int q = 0; q < 64; ++q) { const f32x4 xv = *(const f32x4*)(xr + 4 * q);
            const float a0 = hi ? xv[1] : xv[0], a1 = hi ? xv[3] : xv[2];
            const float b0 = wb[(4 * q + hi) * NE + r32], b1 = wb[(4 * q + 2 + hi) * NE + r32];
            acc = __builtin_amdgcn_mfma_f32_32x32x2f32(a0, b0, acc, 0, 0, 0);
            acc = __builtin_amdgcn_mfma_f32_32x32x2f32(a1, b1, acc, 0, 0, 0); }
#pragma unroll
        for (int r = 0; r < 16; ++r) part[(w * 32 + (r & 3) + 8 * (r >> 2) + 4 * hi) * 33 + r32] = acc[r];
        __syncthreads();
#pragma unroll
        for (int i = 0; i < 2; ++i) { const int o = tid + NTHR * i, tk = o >> 5, e = o & 31; float s = 0.f;
#pragma unroll
            for (int ww = 0; ww < 8; ++ww) s += part[(ww * 32 + tk) * 33 + e];
            lg[tk * 33 + e] = s * RS[tok0 + tk] + CB[b * NE + e]; }
        __syncthreads();
        if (tid < 32) { const int tk = tok0 + tid; float v[4]; int ix[4]; unsigned used = 0u;
#pragma unroll
            for (int k = 0; k < 4; ++k) { float best = -__builtin_inff(); int bi = 0;
                for (int e = 0; e < NE; ++e) { const float x = lg[tid * 33 + e]; if (!((used >> e) & 1u) && x > best) { best = x; bi = e; } }
                v[k] = best; ix[k] = bi; used |= 1u << bi; }
            float p[4], sum = 0.f;
#pragma unroll
            for (int k = 0; k < 4; ++k) { p[k] = __expf(v[k] - v[0]); sum += p[k]; }
            const float inv = 1.0f / sum;
#pragma unroll
            for (int k = 0; k < 4; ++k) { const int e = ix[k]; const unsigned pos = __hip_atomic_fetch_add(cnt + 64 * e, 1u, RLX_AGENT);
                ltok[e * 16384 + pos] = tk; lw[e * 16384 + pos] = p[k] * inv; ldst[e * 16384 + pos] = tk * 4 + k; } }
        __syncthreads();
    }
}
__device__ __forceinline__ void ph_final(const Args& a, int vcu, int G, int wv) {
    const int tid = otid(wv), lane = tid & 63, wave = __builtin_amdgcn_readfirstlane(tid >> 6), gw = vcu * NWAVES + wave, NGW = G * NWAVES;
    const float* mod = WSP(float, WS_MOD); const float* X1 = WSP(float, WS_X1); const bf16* YS = WSP(bf16, WS_YS); const float* gp = a.in[I_GPOSTFFN];
    for (int m = gw; m < MT; m += NGW) { const int b = m / SEQ; const float* mb = mod + b * 12288;
        f32x4 f[8]; float s = 0.f;
#pragma unroll
        for (int j = 0; j < 8; ++j) { f[j] = (f32x4){0.f, 0.f, 0.f, 0.f};
#pragma unroll
            for (int k = 0; k < 4; ++k) { const u32x2 v = *((const u32x2*)(YS + ((size_t)m * 4 + k) * DM) + lane + 64 * j); f[j] += (f32x4){bflo(v.x), bfhi(v.x), bflo(v.y), bfhi(v.y)}; }
            s += (f[j].x * f[j].x + f[j].y * f[j].y) + (f[j].z * f[j].z + f[j].w * f[j].w); }
        const float rstd = 1.0f / sqrtf(wave_sum(s) * (1.0f / DM) + 1e-6f);
#pragma unroll
        for (int j = 0; j < 8; ++j) { const int o4 = lane + 64 * j; const f32x4 xx = *((const f32x4*)(X1 + (size_t)m * DM) + o4), gg = *((const f32x4*)gp + o4), gt = *((const f32x4*)(mb + 10240) + o4);
            *((f32x4*)(a.out + (size_t)m * DM) + o4) = xx + gt * (f[j] * rstd * gg); } }
}
__device__ __forceinline__ void moe_table(const Args& a, LAS unsigned char* lds, int wv) {
    const int tid = otid(wv);
    LAS int* tab = (LAS int*)(lds + TAB_OFF); const unsigned* cnt = (const unsigned*)(a.ws + WS_CTL * MiB) + CW_CNT;
    __syncthreads();
    if (tid < 32) tab[tid] = (int)__hip_atomic_load(cnt + 64 * tid, RLX_AGENT);
    __syncthreads();
    if (tid == 0) { int s = 0; for (int e = 0; e < 32; ++e) { tab[32 + e] = s; s += (tab[e] + 255) >> 8; } tab[64] = s; }
    __syncthreads();
}

__global__ void __launch_bounds__(NTHR, 2) hybrid_fwd(Args a0) {
    typedef const __attribute__((address_space(4))) Args* kargp_t;
    Args a = a0;
#if defined(__HIP_DEVICE_COMPILE__)
#define ARGS() do { kargp_t q_ = (kargp_t)__builtin_amdgcn_kernarg_segment_ptr(); asm volatile("" : "+s"(q_)); a = *q_; } while (0)
#else
#define ARGS() do { } while (0)
#endif
    extern __shared__ __attribute__((aligned(16))) unsigned char lds_raw[];
    LAS unsigned char* lds = (LAS unsigned char*)lds_raw;
    volatile LAS unsigned* MISC = (volatile LAS unsigned*)(lds + MISC_OFF);
    int wv = __builtin_amdgcn_readfirstlane((int)threadIdx.x >> 6); asm volatile("" : "+s"(wv));
    const int tid = otid(wv); const int G = gridDim.x; const int bx = blockIdx.x;
    const int vcu = (G % 8 == 0) ? (bx % 8) * (G / 8) + bx / 8 : bx;
    for (int u = tid; u < (LDS_BYTES - MISC_OFF) / 4; u += NTHR) ((LAS unsigned*)(lds + MISC_OFF))[u] = 0u;
    __syncthreads();
    unsigned* ctl = (unsigned*)(a.ws + WS_CTL * MiB);
    XcdBarrier bar; bar.bar = ctl + CW_BAR; bar.x = 0; bar.st = nullptr;
    const int lo = a.ph_lo, hi = a.ph_hi;
    const bool fused = (hi - lo) > 1;
    if (fused) bar = xcd_barrier_post(ctl + CW_BAR, MISC + 8, tid == 0);
#ifndef ONLY_PHASE
#define ONLY_PHASE -1
#endif
#define IN(k) ((ONLY_PHASE < 0 || ONLY_PHASE == (k)) && lo <= (k) && (k) < hi)
#define REPEAT(n, body) do { body; if constexpr ((n) > 1) { if (fused) xcd_barrier(bar, otid(wv) == 0); else __syncthreads(); body; } } while (0)
#define SEAM(k) do { if (IN(k) && IN((k) + 1)) xcd_barrier(bar, otid(wv) == 0); } while (0)

    if (IN(0)) { ARGS(); REPEAT(REP_MOD, ph_mod(a, lds, wv)); } SEAM(0);
    if (IN(1)) { ARGS(); REPEAT(REP_PREP, ph_prep(a, lds, vcu, G, wv)); } SEAM(1);
    if (IN(2)) { ARGS();
        pg8::ProbDense P; P.init(WSP(bf16, WS_H), WSP(bf16, WS_WT_IN), MT, NPROJ, DM, G, bx);
        pg8::EpiInProj E{a.ws};
        REPEAT(REP_INPROJ, (pg8::gemm_phase<pg8::EpiInProj, pg8::ProbDense, true, false, 127, KREP_IN, EREP_IN>(lds, P, E, wv)));
    } SEAM(2);
    if (IN(3)) { ARGS(); ph_conv(a, vcu, G, wv); } SEAM(3);
    if (IN(4)) { ARGS();
        REPEAT(REP_SSD1, ph_ssd1(a, lds, bx, G, wv));
        __syncthreads();
        REPEAT(REP_ATTN, att::attn_phase((char*)lds_raw, WSP(bf16, WS_Q), WSP(bf16, WS_K), WSP(bf16, WS_V), WSP(bf16, WS_OATT), bx, G, wv));
    } SEAM(4);
    if (IN(5)) { ARGS(); ph_ssd2(a, vcu, G, wv); REPEAT(REP_COMB, ph_attn_combine(a, vcu, G, wv)); } SEAM(5);
    if (IN(6)) { ARGS(); REPEAT(REP_SSD3, ph_ssd3(a, lds, bx, G, wv)); } SEAM(6);
    if (IN(7)) { ARGS();
#define BR_BODY do { \
        { pg8::ProbDense P; P.init(WSP(bf16, WS_YBUF), WSP(bf16, WS_WT_BS), MT, DM, DM, G, bx); \
          pg8::EpiBr1 E{WSP(bf16, WS_SGS), WSP(float, WS_M1)}; \
          pg8::gemm_phase<pg8::EpiBr1, pg8::ProbDense, true>(lds, P, E, wv); } \
        __syncthreads(); \
        { pg8::ProbDense P; P.init(WSP(bf16, WS_OFIN), WSP(bf16, WS_WT_BA), MT, DM, DM, G, bx); \
          pg8::EpiBr2 E{WSP(bf16, WS_SGA), WSP(float, WS_M1), WSP(bf16, WS_MERGED)}; \
          pg8::gemm_phase<pg8::EpiBr2, pg8::ProbDense, true>(lds, P, E, wv); } } while (0)
        REPEAT(REP_BR, BR_BODY);
#undef BR_BODY
    } SEAM(7);
    if (IN(8)) { ARGS();
        pg8::ProbDense P; P.init(WSP(bf16, WS_MERGED), WSP(bf16, WS_WT_OUT), MT, DM, DM, G, bx);
        pg8::EpiF32 E{WSP(float, WS_MIX), DM};
        REPEAT(REP_OUT, (pg8::gemm_phase<pg8::EpiF32, pg8::ProbDense, true>(lds, P, E, wv)));
    } SEAM(8);
    if (IN(9)) { ARGS(); REPEAT(REP_ROWS1, ph_rows1(a, vcu, G, wv)); } SEAM(9);
    if (IN(10)) { ARGS(); ph_router(a, lds, bx, G, wv); } SEAM(10);
    if (IN(11)) { ARGS();
        moe_table(a, lds, wv);
        pg8::ProbMoE<true> P; P.A = (const char*)WSP(bf16, WS_H2); P.Bt = (const char*)WSP(bf16, WS_WT_GU); P.rb = DM; P.nN = 16; P.estride = (size_t)4096 * DM;
        P.list_tok = (const int*)(a.ws + WS_LISTS * MiB); P.tab = (const LAS int*)(lds + TAB_OFF); P.G = G; P.c = vcu;
        pg8::EpiGateUp E{a.in[I_BGU], WSP(unsigned char, WS_ACT)};
        REPEAT(REP_GU, (pg8::gemm_phase<pg8::EpiGateUp, pg8::ProbMoE<true>, true, true, 127, KREP_GU, EREP_GU>(lds, P, E, wv)));
    } SEAM(11);
    if (IN(12)) { ARGS();
        moe_table(a, lds, wv);
        pg8::ProbMoE<false> P; P.A = (const char*)WSP(bf16, WS_ACT); P.Bt = (const char*)WSP(bf16, WS_WT_DN); P.rb = DM; P.nN = 8; P.estride = (size_t)DM * DM;
        P.list_tok = nullptr; P.tab = (const LAS int*)(lds + TAB_OFF); P.G = G; P.c = vcu;
        pg8::EpiDown E{a.in[I_BDN], (const int*)(a.ws + WS_LISTS * MiB + 2 * LIST_STRIDE), (const float*)(a.ws + WS_LISTS * MiB + LIST_STRIDE), (const LAS int*)(lds + TAB_OFF), WSP(bf16, WS_YS)};
        REPEAT(REP_DN, (pg8::gemm_phase<pg8::EpiDown, pg8::ProbMoE<false>, true, true, 127, KREP_DN, EREP_DN>(lds, P, E, wv)));
    } SEAM(12);
    if (IN(13)) { ARGS(); REPEAT(REP_FINAL, ph_final(a, vcu, G, wv)); }
#undef IN
#undef SEAM
#undef REPEAT
#undef ARGS
}

extern "C" void kernel_launch(void* const* d_in, const int* in_sizes, int n_in, void* d_out, int out_size, void* d_ws, size_t ws_size, hipStream_t stream) {
    static int grid = 0;
    if (grid == 0) {
        if (n_in != 29 || in_sizes[0] != MT * DM || out_size != MT * DM || ws_size < WS_END * MiB) {
            fprintf(stderr, "kernel_launch: unexpected shapes (n_in %d, in0 %d, out %d, ws %zu); nothing launched\n", n_in, n_in > 0 ? in_sizes[0] : -1, out_size, ws_size); grid = -1; return; }
        int dev = 0, cus = 0, per_cu = 0;
        if (hipGetDevice(&dev) != hipSuccess || hipDeviceGetAttribute(&cus, hipDeviceAttributeMultiprocessorCount, dev) != hipSuccess) { grid = -1; return; }
        if (hipFuncSetAttribute((const void*)hybrid_fwd, hipFuncAttributeMaxDynamicSharedMemorySize, LDS_BYTES) != hipSuccess) { fprintf(stderr, "kernel_launch: hipFuncSetAttribute failed\n"); grid = -1; return; }
        if (hipOccupancyMaxActiveBlocksPerMultiprocessor(&per_cu, (const void*)hybrid_fwd, NTHR, LDS_BYTES) != hipSuccess || per_cu < 1)
            fprintf(stderr, "kernel_launch: note: occupancy query reports %d workgroups per CU\n", per_cu);
        (void)hipGetLastError();
        grid = cus;
    }
    if (grid < 0) return;
    (void)hipMemsetAsync((char*)d_ws + WS_CTL * MiB, 0, CTL_ZERO_BYTES, stream);
    Args a{};
    for (int i = 0; i < 29; ++i) a.in[i] = (const float*)d_in[i];
    a.out = (float*)d_out; a.ws = (unsigned char*)d_ws;
#if MK_PER_PHASE
    for (int k = 0; k < NPH; ++k) { a.ph_lo = k; a.ph_hi = k + 1; hipLaunchKernelGGL(hybrid_fwd, dim3(grid), dim3(NTHR), LDS_BYTES, stream, a); }
#else
    a.ph_lo = 0; a.ph_hi = NPH;
    hipLaunchKernelGGL(hybrid_fwd, dim3(grid), dim3(NTHR), LDS_BYTES, stream, a);
#endif
    const hipError_t le = hipPeekAtLastError();
    if (le != hipSuccess) fprintf(stderr, "kernel_launch: launch failed: %s\n", hipGetErrorName(le));
}
```

```cpp
#include <hip/hip_runtime.h>
#include <cstdio>
#include <cstdint>

#define LAS __attribute__((address_space(3)))
#define GAS __attribute__((address_space(1)))
typedef unsigned short bf16;
typedef short bf16x8 __attribute__((ext_vector_type(8)));
typedef short s16x4 __attribute__((ext_vector_type(4)));
typedef float f32x2 __attribute__((ext_vector_type(2)));
typedef float f32x4 __attribute__((ext_vector_type(4)));
typedef float f32x16 __attribute__((ext_vector_type(16)));
typedef unsigned u32x2 __attribute__((ext_vector_type(2)));
typedef unsigned u32x4 __attribute__((ext_vector_type(4)));

#ifndef REP_MOD
#define REP_MOD 1
#endif
#ifndef REP_PREP
#define REP_PREP 1
#endif
#ifndef REP_INPROJ
#define REP_INPROJ 1
#endif
#ifndef REP_SSD1
#define REP_SSD1 1
#endif
#ifndef REP_ATTN
#define REP_ATTN 1
#endif
#ifndef REP_COMB
#define REP_COMB 1
#endif
#ifndef REP_SSD3
#define REP_SSD3 1
#endif
#ifndef REP_BR
#define REP_BR 1
#endif
#ifndef REP_OUT
#define REP_OUT 1
#endif
#ifndef REP_ROWS1
#define REP_ROWS1 1
#endif
#ifndef REP_GU
#define REP_GU 1
#endif
#ifndef REP_DN
#define REP_DN 1
#endif
#ifndef REP_FINAL
#define REP_FINAL 1
#endif

#ifndef KREP_GU
#define KREP_GU 1
#endif
#ifndef EREP_GU
#define EREP_GU 1
#endif
#ifndef KREP_DN
#define KREP_DN 1
#endif
#ifndef EREP_DN
#define EREP_DN 1
#endif
#ifndef KREP_IN
#define KREP_IN 1
#endif
#ifndef EREP_IN
#define EREP_IN 1
#endif
#ifndef MK_PER_PHASE
#define MK_PER_PHASE 0
#endif

constexpr int DM = 2048, NB = 4, SEQ = 4096, MT = NB * SEQ;
constexpr int NE = 32, TOPK = 4, NSLOT_ROWS = MT * TOPK + NE * 256;
constexpr int NPROJ_T = 61, NPROJ = NPROJ_T * 256;
constexpr int XBCW = 3072;
constexpr int NWAVES = 8, NTHR = 512;
constexpr int NPH = 14;

constexpr size_t MiB = 1u << 20;
constexpr size_t WS_CTL = 0, CTL_ZERO_BYTES = 1 * MiB;
constexpr size_t WS_MOD = 1, WS_ROPE = 2, WS_WR = 3, WS_RSTD = 4, WS_LISTS = 8, WS_ACS = 16, WS_DT = 18, WS_DTRAW = 20;
constexpr size_t WS_WT_IN = 32, WS_WT_BS = 96, WS_WT_BA = 104, WS_WT_OUT = 112, WS_WT_GU = 128, WS_WT_DN = 640;
constexpr size_t WS_H = 896, WS_Z = 960, WS_XBC = 1024, WS_Q = 1120, WS_K = 1184, WS_V = 1248, WS_SGS = 1312, WS_SGA = 1376, WS_XBCC = 1440;
constexpr size_t WS_YDIAG = 1536, WS_STATES = 1664, WS_YBUF = 1792, WS_OATT = 1856, WS_OFIN = 1984, WS_M1 = 2048, WS_MERGED = 2176, WS_MIX = 2240;
constexpr size_t WS_X1 = 2368, WS_H2 = 2496, WS_ACT = 2560, WS_YS = 2848, WS_END = 3104;
constexpr int CW_BAR = 4096;
constexpr int CW_CNT = 16384;
constexpr size_t MOD_CB = 256 * 1024;
constexpr size_t LIST_STRIDE = 2 * MiB;

constexpr int RING_BYTES = 131072;
constexpr int TAB_OFF = RING_BYTES;
constexpr int MISC_OFF = RING_BYTES + 1024;
constexpr int LDS_BYTES = 147456;

#define RLX_AGENT __ATOMIC_RELAXED, __HIP_MEMORY_SCOPE_AGENT
#define LDS_WAIT() asm volatile("s_waitcnt lgkmcnt(0)" ::: "memory")
#define VM_WAIT() asm volatile("s_waitcnt vmcnt(0)" ::: "memory")
#define SBAR() __builtin_amdgcn_sched_barrier(0)
__device__ __forceinline__ unsigned f2bf(float f) { unsigned u = __builtin_bit_cast(unsigned, f); return (u + 0x7fffu + ((u >> 16) & 1u)) >> 16; }

__device__ __forceinline__ float bf2f(unsigned short b) { return __builtin_bit_cast(float, (unsigned)b << 16); }
__device__ __forceinline__ float bflo(unsigned w) { return __builtin_bit_cast(float, w << 16); }
__device__ __forceinline__ float bfhi(unsigned w) { return __builtin_bit_cast(float, w & 0xffff0000u); }
typedef __bf16 bf16x2_t __attribute__((ext_vector_type(2)));
__device__ __forceinline__ unsigned cvt_pk_bf16(float lo, float hi) { const f32x2 v = {lo, hi}; const bf16x2_t b = __builtin_convertvector(v, bf16x2_t); return __builtin_bit_cast(unsigned, b); }
__device__ __forceinline__ unsigned pk2(float lo, float hi) { return cvt_pk_bf16(lo, hi); }
__device__ __forceinline__ unsigned pk4_fp8(float a, float b, float c, float d) { int w = __builtin_amdgcn_cvt_pk_fp8_f32(a, b, 0, false); w = __builtin_amdgcn_cvt_pk_fp8_f32(c, d, w, true); return (unsigned)w; }
__device__ __forceinline__ float sigmoidf_(float x) { return __builtin_amdgcn_rcpf(1.0f + __builtin_amdgcn_exp2f(-1.4426950408889634f * x)); }
__device__ __forceinline__ float siluf_(float x) { return x * __builtin_amdgcn_rcpf(1.0f + __builtin_amdgcn_exp2f(-1.4426950408889634f * x)); }
__device__ __forceinline__ int otid(int wv) { int l; asm volatile("v_mbcnt_lo_u32_b32 %0, -1, 0\n\tv_mbcnt_hi_u32_b32 %0, -1, %0" : "=v"(l)); return wv * 64 + l; }
__device__ __forceinline__ float wave_sum(float v) {
#pragma unroll
    for (int o = 1; o < 64; o <<= 1) v += __shfl_xor(v, o);
    return v;
}

#define XB_TMO      128
#define XB_XCNT(j)  (256  + 64 * (j))
#define XB_XSUB(j)  (1280 + 64 * (j))
#define XB_XGEN(j)  (2304 + 64 * (j))
#define XB_TOP      3328
#define XB_TOPGEN   3392
#define XCD_BAR_WORDS 3456
#define XB_SPIN_CAP (1u << 18)
__device__ __forceinline__ unsigned xb_ld(unsigned* p)              { return __hip_atomic_load(p, __ATOMIC_RELAXED, __HIP_MEMORY_SCOPE_AGENT); }
__device__ __forceinline__ unsigned xb_add(unsigned* p, unsigned v) { return __hip_atomic_fetch_add(p, v, __ATOMIC_RELAXED, __HIP_MEMORY_SCOPE_AGENT); }
__device__ __forceinline__ unsigned xb_xcc_id() { return (unsigned)__builtin_amdgcn_s_getreg((3 << 11) | 20) & 0xFu; }
#define XB_SPIN(cond, bar) do { unsigned _sp = 0; while (cond) { __builtin_amdgcn_s_sleep(1); \
    if ((++_sp & 255u) == 0u) { if (xb_ld(&(bar)[XB_TMO])) break; if (_sp > XB_SPIN_CAP) { atomicAdd(&(bar)[XB_TMO], 1u); break; } } } } while (0)
struct XcdBarrier { unsigned* bar; unsigned x; volatile LAS unsigned* st; };
__device__ __forceinline__ XcdBarrier xcd_barrier_post(unsigned* bar, volatile LAS unsigned* st, bool leader  ) {
    XcdBarrier b; b.bar = bar; b.x = xb_xcc_id(); b.st = st;
    if (leader) (void)xb_add(&bar[XB_XCNT(b.x)], 1u);
    return b;
}
__device__ __forceinline__ void xcd_barrier_complete(unsigned* bar, unsigned x, unsigned& nloc, unsigned& nx) {
    const unsigned G = gridDim.x * gridDim.y * gridDim.z;
    unsigned sum, cnt, mine, sp = 0u;
    for (;;) {
        sum = 0u; cnt = 0u; mine = 0u;
#pragma unroll
        for (unsigned j = 0; j < 16; ++j) { const unsigned c = xb_ld(&bar[XB_XCNT(j)]); sum += c; cnt += (c > 0u) ? 1u : 0u; mine = (j == x) ? c : mine; }
        if (sum == G) break;
        __builtin_amdgcn_s_sleep(1);
        if ((++sp & 255u) == 0u) { if (xb_ld(&bar[XB_TMO])) break; if (sp > XB_SPIN_CAP) { atomicAdd(&bar[XB_TMO], 1u); break; } }
    }
    nloc = mine > 0u ? mine : 1u; nx = cnt > 0u ? cnt : 1u;
}
__device__ __forceinline__ void xcd_barrier(const XcdBarrier& b, bool leader  ) {
    asm volatile("s_waitcnt vmcnt(0)" ::: "memory");
    __syncthreads();
    if (leader) {
        unsigned* bar = b.bar;
        __builtin_amdgcn_s_waitcnt(0);
        unsigned nloc = b.st[0], nx = b.st[1];
        if (nloc == 0u) { xcd_barrier_complete(bar, b.x, nloc, nx); b.st[0] = nloc; b.st[1] = nx; }
        const unsigned old = xb_add(&bar[XB_XSUB(b.x)], 1u);
        const unsigned gen = old / nloc;
        if (old + 1u == (gen + 1u) * nloc) {
            __builtin_amdgcn_fence(__ATOMIC_RELEASE, "agent");
            asm volatile("s_waitcnt vmcnt(0)" ::: "memory");
            const unsigned og = xb_add(&bar[XB_TOP], 1u);
            const unsigned tg = og / nx;
            if (og + 1u == (tg + 1u) * nx) xb_add(&bar[XB_TOPGEN], 1u);
            else XB_SPIN(xb_ld(&bar[XB_TOPGEN]) == tg, bar);
            __builtin_amdgcn_fence(__ATOMIC_ACQUIRE, "agent");
            xb_add(&bar[XB_XGEN(b.x)], 1u);
            asm volatile("s_waitcnt vmcnt(0)" ::: "memory");
        } else {
            XB_SPIN(xb_ld(&bar[XB_XGEN(b.x)]) == gen, bar);
            __builtin_amdgcn_fence(__ATOMIC_ACQUIRE, "agent");
            asm volatile("s_waitcnt vmcnt(0)" ::: "memory");
        }
    }
    __syncthreads();
}
namespace pg8 {
constexpr int BM = 256, BK = 64, HALF = 128, HTB = HALF * BK * 2, STAGE_BYTES = 8 * HTB, NXCD = 8;
#ifndef PG8_WGM
#define PG8_WGM 8
#endif
constexpr int WGM = PG8_WGM;
__host__ __device__ __forceinline__ int lds_byte(int r, int c) { const int st = (r >> 4) * 2 + (c >> 5), rr = r & 15, cc = c & 31, ob = rr * 64 + cc * 2; return st * 1024 + (ob ^ (((ob >> 9) & 1) << 5)); }
__host__ __device__ __forceinline__ void stage_rc(int b, int& R, int& C) { const int st = b / 1024, sb = b % 1024, swz = sb ^ (((sb >> 9) & 1) << 5); R = (st >> 1) * 16 + swz / 64; C = (st & 1) * 32 + (swz % 64) / 2; }
__host__ __device__ __forceinline__ int perm32(int rho) { const int n = rho >> 4, i = rho & 15; return 8 * (i >> 2) + 4 * n + (i & 3); }

struct Unit { int pm, pn, e, ml; };

struct ProbDense {
    static constexpr bool PRELOAD = false;
    const char* A; const char* Bt; int rb;
    int nM, nN, nwg, G, c;
    __device__ __forceinline__ void init(const void* A_, const void* Bt_, int M, int N, int K_, int G_, int c_) { A = (const char*)A_; Bt = (const char*)Bt_; rb = K_ * 2; nM = M / BM; nN = N / BM; nwg = nM * nN; G = G_; c = c_; }
    __device__ __forceinline__ bool next(int i, Unit& u) const {
        const long L = (long)i * G + c; if (L >= nwg) return false;
        int wgid = (int)L; { const int q = nwg / NXCD, r = nwg % NXCD, xcd = wgid % NXCD, off = wgid / NXCD; wgid = (xcd < r ? xcd * (q + 1) : r * (q + 1) + (xcd - r) * q) + off; }
        const int nig = WGM * nN, gid = wgid / nig, fm = gid * WGM, gsz = (nM - fm) < WGM ? (nM - fm) : WGM;
        u.pm = fm + ((wgid % nig) % gsz); u.pn = (wgid % nig) / gsz; u.e = 0; u.ml = 0; return true;
    }
    __device__ __forceinline__ unsigned b_off(const Unit& u) const { return (unsigned)(u.pn * BM * rb); }
    __device__ __forceinline__ void a_offs(const Unit& u, int tid_, unsigned (&off)[2][2]) const {
        asm volatile("" : "+v"(tid_)); int R[2], C[2]; stage_rc(tid_ * 16, R[0], C[0]); stage_rc(tid_ * 16 + 8192, R[1], C[1]);
#pragma unroll
        for (int h = 0; h < 2; ++h)
#pragma unroll
            for (int i = 0; i < 2; ++i) off[h][i] = (unsigned)((u.pm * BM + h * HALF + R[i]) * rb + C[i] * 2);
    }
};

template <bool GATHER> struct ProbMoE {
    static constexpr bool PRELOAD = GATHER;
    const char* A; const char* Bt; int rb, nN; size_t estride;
    const int* list_tok; const LAS int* tab; int G, c;
    __device__ __forceinline__ bool next(int i, Unit& u) const {
        const int L = i * G + c; const int NT = __builtin_amdgcn_readfirstlane(tab[64]);
        if (L >= NT * nN) return false;
        int e = 0;
#pragma unroll 1
        for (int j = 1; j < 32; ++j) if (L >= tab[32 + j] * nN) e = j;
        const int tb = tab[32 + e], ntile = tab[33 + e] - tb, Lp = L - tb * nN;
        u.e = __builtin_amdgcn_readfirstlane(e); u.pn = __builtin_amdgcn_readfirstlane(Lp / ntile); u.ml = __builtin_amdgcn_readfirstlane(Lp % ntile); u.pm = __builtin_amdgcn_readfirstlane(tb + Lp % ntile); return true;
    }
    __device__ __forceinline__ unsigned b_off(const Unit& u) const { return (unsigned)(u.e * (unsigned)estride + u.pn * BM * rb); }
    __device__ __forceinline__ void a_offs(const Unit& u, int tid_, unsigned (&off)[2][2]) const {
        asm volatile("" : "+v"(tid_)); int R[2], C[2]; stage_rc(tid_ * 16, R[0], C[0]); stage_rc(tid_ * 16 + 8192, R[1], C[1]);
        if constexpr (GATHER) {
            const int cnt = __builtin_amdgcn_readfirstlane(tab[u.e]);
#pragma unroll
            for (int h = 0; h < 2; ++h)
#pragma unroll
                for (int i = 0; i < 2; ++i) { const int j = u.ml * BM + h * HALF + R[i]; const int tok = (j < cnt) ? list_tok[u.e * 16384 + j] : 0; off[h][i] = (unsigned)(tok * rb + C[i] * 2); }
        } else {
#pragma unroll
            for (int h = 0; h < 2; ++h)
#pragma unroll
                for (int i = 0; i < 2; ++i) off[h][i] = (unsigned)((u.pm * BM + h * HALF + R[i]) * rb + C[i] * 2);
        }
    }
};

typedef int v8i32 __attribute__((ext_vector_type(8)));
typedef int v4i32 __attribute__((ext_vector_type(4)));
__device__ __forceinline__ v8i32 cat8(bf16x8 a, bf16x8 b) { const v4i32 x = __builtin_bit_cast(v4i32, a), y = __builtin_bit_cast(v4i32, b); return __builtin_shufflevector(x, y, 0, 1, 2, 3, 4, 5, 6, 7); }
template <class Epi, class Prob, bool ALIGN_EPI, bool FP8 = false, int WSCALE = 127, int KREP = 1, int EREP = 1>
__device__ __forceinline__ void gemm_phase(LAS unsigned char* lds, const Prob& P, const Epi& E, int wv) {
    const int tid = otid(wv), wid = __builtin_amdgcn_readfirstlane(tid >> 6), lane = tid & 63, wr = wid >> 2, wc = wid & 3, fr = lane & 15, fq = lane >> 4;
    const int rb = P.rb, nt = rb / 128;
    unsigned voffB; { int R, C; stage_rc(tid * 16, R, C); const int Rb = Epi::PERM ? ((R & ~31) + perm32(R & 31)) : R; voffB = (unsigned)(Rb * rb + C * 2); }
    const unsigned qstep = (unsigned)(64 * rb);
    const unsigned kstep = 128u;
    const unsigned hstep = (unsigned)(HALF * rb);
    const __amdgpu_buffer_rsrc_t rA = __builtin_amdgcn_make_buffer_rsrc((void*)P.A, 0, 0x7fffffff, 0x00020000), rB = __builtin_amdgcn_make_buffer_rsrc((void*)P.Bt, 0, 0x7fffffff, 0x00020000);
    const unsigned ldsw = (unsigned)wid * 1024u;
    const int aoff = lds_byte(wr * 64 + fr, fq * 8), boff = lds_byte(wc * 32 + fr, fq * 8);
#define PG8_SA(b, h) (((b) * 2 + (h)) * HTB)
#define PG8_SB(b, h) ((4 + (b) * 2 + (h)) * HTB)
#define PG8_STAGE_B(bufoff, soff) do { _Pragma("unroll") for (int _i = 0; _i < 2; ++_i) \
        __builtin_amdgcn_raw_ptr_buffer_load_lds(rB, (LAS void*)(lds + (bufoff) + ldsw + _i * 8192), 16, voffB, (int)((soff) + _i * qstep), 0, 0); } while (0)
#define PG8_STAGE_A(bufoff, h, soff) do { _Pragma("unroll") for (int _i = 0; _i < 2; ++_i) { \
        if constexpr (Prob::PRELOAD) __builtin_amdgcn_raw_ptr_buffer_load_lds(rA, (LAS void*)(lds + (bufoff) + ldsw + _i * 8192), 16, offA[h][_i], (int)(soff), 0, 0); \
        else __builtin_amdgcn_raw_ptr_buffer_load_lds(rA, (LAS void*)(lds + (bufoff) + ldsw + _i * 8192), 16, offA[0][0], (int)((soff) + (h) * hstep + _i * qstep), 0, 0); } } while (0)
#define PG8_LDA(dst, b, h) do { _Pragma("unroll") for (int m = 0; m < 4; ++m) _Pragma("unroll") for (int k = 0; k < 2; ++k) dst[m][k] = *(const LAS bf16x8*)(lds + PG8_SA(b, h) + aoff + m * 2048 + k * 1024); } while (0)
#define PG8_LDB(dst, b, h) do { _Pragma("unroll") for (int n = 0; n < 2; ++n) _Pragma("unroll") for (int k = 0; k < 2; ++k) dst[n][k] = *(const LAS bf16x8*)(lds + PG8_SB(b, h) + boff + n * 2048 + k * 1024); } while (0)
#define PG8_MMA(ai, bj, At, Bt) do { __builtin_amdgcn_s_setprio(1); _Pragma("unroll") for (int m = 0; m < 4; ++m) _Pragma("unroll") for (int n = 0; n < 2; ++n) { \
        if constexpr (FP8) acc[ai][bj][m][n] = __builtin_amdgcn_mfma_scale_f32_16x16x128_f8f6f4(cat8(Bt[n][0], Bt[n][1]), cat8(At[m][0], At[m][1]), acc[ai][bj][m][n], 0, 0, 0, WSCALE, 0, 127); \
        else { _Pragma("unroll") for (int k = 0; k < 2; ++k) acc[ai][bj][m][n] = __builtin_amdgcn_mfma_f32_16x16x32_bf16(Bt[n][k], At[m][k], acc[ai][bj][m][n], 0, 0, 0); } } \
        __builtin_amdgcn_s_setprio(0); } while (0)
#define PG8_WAIT_V(n) asm volatile("s_waitcnt vmcnt(" #n ")" ::: "memory")
#define PG8_WAIT_L(n) asm volatile("s_waitcnt lgkmcnt(" #n ")" ::: "memory")
#define PG8_BAR __builtin_amdgcn_s_barrier()
    Unit cur, nxt; int ui = 0;
    if (!P.next(0, cur)) return;
    f32x4 acc[2][2][4][2];
#pragma unroll
    for (int a = 0; a < 2; ++a)
#pragma unroll
        for (int b = 0; b < 2; ++b)
#pragma unroll
            for (int m = 0; m < 4; ++m)
#pragma unroll
                for (int n = 0; n < 2; ++n) acc[a][b][m][n] = (f32x4){0.f, 0.f, 0.f, 0.f};
    bf16x8 At[4][2], B0[2][2], B1[2][2];
    unsigned offA[2][2];
    LAS u32x4* stash = (LAS u32x4*)(lds + RING_BYTES + 4096) + tid;
    P.a_offs(cur, tid, offA);
    unsigned cB = P.b_off(cur);
    PG8_STAGE_B(PG8_SB(0, 0), cB); PG8_STAGE_B(PG8_SB(0, 1), cB + hstep); PG8_STAGE_A(PG8_SA(0, 0), 0, 0u); PG8_STAGE_A(PG8_SA(0, 1), 1, 0u);
    if (wr == 1) PG8_BAR;
    PG8_WAIT_V(2); PG8_BAR;
    PG8_STAGE_B(PG8_SB(1, 0), cB + kstep); PG8_STAGE_A(PG8_SA(1, 0), 0, kstep); PG8_STAGE_B(PG8_SB(1, 1), cB + hstep + kstep);
    PG8_WAIT_V(6); PG8_BAR;
    for (;;) {
        const bool has_next = P.next(ui + 1, nxt);
        if constexpr (Prob::PRELOAD) {
            unsigned noffA[2][2];
            if (has_next) P.a_offs(nxt, tid, noffA);
            else {
#pragma unroll
                for (int h = 0; h < 2; ++h)
#pragma unroll
                    for (int i = 0; i < 2; ++i) noffA[h][i] = offA[h][i];
            }
            *stash = (u32x4){noffA[0][0], noffA[0][1], noffA[1][0], noffA[1][1]};
        }
        Unit nu = has_next ? nxt : cur;
        const unsigned nB = has_next ? P.b_off(nxt) : cB;
        for (int kr = 0; kr < KREP; ++kr) {
        if (KREP > 1 && kr > 0) {
#pragma unroll
            for (int a = 0; a < 2; ++a)
#pragma unroll
                for (int b = 0; b < 2; ++b)
#pragma unroll
                    for (int m = 0; m < 4; ++m)
#pragma unroll
                        for (int n = 0; n < 2; ++n) acc[a][b][m][n] = (f32x4){0.f, 0.f, 0.f, 0.f};
        }
        const bool fin = (kr == KREP - 1);
        for (int t = 0; t < nt; t += 2) {
            const bool last = (t == nt - 2);
            const unsigned a1 = (unsigned)(t + 1) * kstep;
            const unsigned a2 = last ? 0u : (unsigned)(t + 2) * kstep, b2 = last ? (fin ? nB : cB) : cB + (unsigned)(t + 2) * kstep;
            const unsigned a3 = a2 + kstep, b3 = b2 + kstep;
            PG8_LDB(B0, 0, 0); PG8_LDB(B1, 0, 1); SBAR(); PG8_LDA(At, 0, 0); PG8_STAGE_A(PG8_SA(1, 1), 1, a1);
            PG8_WAIT_V(8); PG8_WAIT_L(0); PG8_BAR; PG8_MMA(0, 0, At, B0); PG8_MMA(0, 1, At, B1); PG8_BAR; SBAR();
            if constexpr (Prob::PRELOAD) {
                const u32x4 nv = *stash; const bool sw = last && fin;
                offA[0][0] = sw ? nv[0] : offA[0][0]; offA[0][1] = sw ? nv[1] : offA[0][1]; offA[1][0] = sw ? nv[2] : offA[1][0]; offA[1][1] = sw ? nv[3] : offA[1][1];
            } else {
                const unsigned dlt = (last && fin) ? (unsigned)((nu.pm - cur.pm) * BM * rb) : 0u;
                offA[0][0] += dlt;
            }
            PG8_LDA(At, 0, 1); PG8_STAGE_B(PG8_SB(0, 0), b2); PG8_STAGE_B(PG8_SB(0, 1), b2 + hstep); PG8_STAGE_A(PG8_SA(0, 0), 0, a2);
            PG8_WAIT_V(8); PG8_WAIT_L(0); PG8_BAR; PG8_MMA(1, 0, At, B0); PG8_MMA(1, 1, At, B1); PG8_BAR; SBAR();
            PG8_LDB(B0, 1, 0); PG8_LDB(B1, 1, 1); SBAR(); PG8_LDA(At, 1, 0); PG8_STAGE_A(PG8_SA(0, 1), 1, a2);
            PG8_WAIT_V(8); PG8_WAIT_L(0); PG8_BAR; PG8_MMA(0, 0, At, B0); PG8_MMA(0, 1, At, B1); PG8_BAR; SBAR();
            PG8_LDA(At, 1, 1); PG8_STAGE_B(PG8_SB(1, 0), b3); PG8_STAGE_B(PG8_SB(1, 1), b3 + hstep); PG8_STAGE_A(PG8_SA(1, 0), 0, a3);
            PG8_WAIT_V(8); PG8_WAIT_L(0); PG8_BAR; PG8_MMA(1, 0, At, B0); PG8_MMA(1, 1, At, B1); PG8_BAR; SBAR();
        }
        }
        if constexpr (ALIGN_EPI) { if (wr == 0) PG8_BAR; }
        { int fr_ = fr, fq_ = fq; asm volatile("" : "+v"(fr_), "+v"(fq_)); E(acc, cur, wr, wc, fr_, fq_); if constexpr (EREP > 1) { asm volatile("" : "+v"(fr_), "+v"(fq_)); E(acc, cur, wr, wc, fr_, fq_); } }
        if (!has_next) break;
#pragma unroll
        for (int a = 0; a < 2; ++a)
#pragma unroll
            for (int b = 0; b < 2; ++b)
#pragma unroll
                for (int m = 0; m < 4; ++m)
#pragma unroll
                    for (int n = 0; n < 2; ++n) acc[a][b][m][n] = (f32x4){0.f, 0.f, 0.f, 0.f};
        cur = nxt; cB = nB; ++ui;
        if constexpr (ALIGN_EPI) { if (wr == 1) PG8_BAR; }
    }
    PG8_WAIT_V(0);
    if constexpr (!ALIGN_EPI) { if (wr == 0) PG8_BAR; }
    PG8_BAR;
#undef PG8_SA
#undef PG8_SB
#undef PG8_STAGE_A
#undef PG8_STAGE_B
#undef PG8_LDA
#undef PG8_LDB
#undef PG8_MMA
#undef PG8_WAIT_V
#undef PG8_WAIT_L
#undef PG8_BAR
}
}
namespace pg8 {
struct EpiInProj {
    static constexpr bool PERM = true;
    unsigned char* ws;
    __device__ __forceinline__ void operator()(const f32x4 (&acc)[2][2][4][2], const Unit& u, int wr, int wc, int fr, int fq) const {
        const int pn = u.pn; const int row0 = u.pm * BM + wr * 64 + fr;
        if (pn == 60) {
            if (wc == 0) { float* dst = (float*)(ws + WS_DTRAW * MiB);
#pragma unroll
                for (int ai = 0; ai < 2; ++ai)
#pragma unroll
                    for (int m = 0; m < 4; ++m) { float* rp = dst + (size_t)(row0 + ai * HALF + m * 16) * 32 + 8 * fq;
                        *(f32x4*)rp = acc[ai][0][m][0]; *(f32x4*)(rp + 4) = acc[ai][0][m][1]; } }
            return;
        }
        bf16* base; int ldc, colt; bool sig = false;
        if (pn < 8)       { base = (bf16*)(ws + WS_Z * MiB);   ldc = DM;   colt = pn * BM; }
        else if (pn < 20) { base = (bf16*)(ws + WS_XBC * MiB); ldc = XBCW; colt = (pn - 8) * BM; }
        else if (pn < 28) { base = (bf16*)(ws + WS_Q * MiB);   ldc = DM;   colt = (pn - 20) * BM; }
        else if (pn < 36) { base = (bf16*)(ws + WS_K * MiB);   ldc = DM;   colt = (pn - 28) * BM; }
        else if (pn < 44) { base = (bf16*)(ws + WS_V * MiB);   ldc = DM;   colt = (pn - 36) * BM; }
        else if (pn < 52) { base = (bf16*)(ws + WS_SGS * MiB); ldc = DM;   colt = (pn - 44) * BM; sig = true; }
        else              { base = (bf16*)(ws + WS_SGA * MiB); ldc = DM;   colt = (pn - 52) * BM; sig = true; }
        const int col0 = colt + wc * 32 + 8 * fq;
#pragma unroll
        for (int ai = 0; ai < 2; ++ai)
#pragma unroll
            for (int m = 0; m < 4; ++m) { bf16* rowp = base + (size_t)(row0 + ai * HALF + m * 16) * ldc + col0;
#pragma unroll
                for (int bj = 0; bj < 2; ++bj) { f32x4 v0 = acc[ai][bj][m][0], v1 = acc[ai][bj][m][1];
                    if (sig) {
#pragma unroll
                        for (int q = 0; q < 4; ++q) { v0[q] = sigmoidf_(v0[q]); v1[q] = sigmoidf_(v1[q]); } }
                    u32x4 w; w.x = cvt_pk_bf16(v0[0], v0[1]); w.y = cvt_pk_bf16(v0[2], v0[3]); w.z = cvt_pk_bf16(v1[0], v1[1]); w.w = cvt_pk_bf16(v1[2], v1[3]);
                    *(u32x4*)(rowp + bj * HALF) = w; } }
    }
};
struct EpiBr1 {
    static constexpr bool PERM = false;
    const bf16* sg; float* m1;
    __device__ __forceinline__ void operator()(const f32x4 (&acc)[2][2][4][2], const Unit& u, int wr, int wc, int fr, int fq) const {
        const int row0 = u.pm * BM + wr * 64 + fr, col0 = u.pn * BM + wc * 32 + 4 * fq;
#pragma unroll
        for (int ai = 0; ai < 2; ++ai)
#pragma unroll
            for (int m = 0; m < 4; ++m) { const size_t off = (size_t)(row0 + ai * HALF + m * 16) * DM + col0;
#pragma unroll
                for (int bj = 0; bj < 2; ++bj)
#pragma unroll
                    for (int n = 0; n < 2; ++n) { const u32x2 g = *(const u32x2*)(sg + off + bj * HALF + n * 16); const f32x4 a = acc[ai][bj][m][n];
                        *(f32x4*)(m1 + off + bj * HALF + n * 16) = (f32x4){a[0] * bflo(g.x), a[1] * bfhi(g.x), a[2] * bflo(g.y), a[3] * bfhi(g.y)}; } }
    }
};
struct EpiBr2 {
    static constexpr bool PERM = false;
    const bf16* sg; const float* m1; bf16* out;
    __device__ __forceinline__ void operator()(const f32x4 (&acc)[2][2][4][2], const Unit& u, int wr, int wc, int fr, int fq) const {
        const int row0 = u.pm * BM + wr * 64 + fr, col0 = u.pn * BM + wc * 32 + 4 * fq;
#pragma unroll
        for (int ai = 0; ai < 2; ++ai)
#pragma unroll
            for (int m = 0; m < 4; ++m) { const size_t off = (size_t)(row0 + ai * HALF + m * 16) * DM + col0;
#pragma unroll
                for (int bj = 0; bj < 2; ++bj)
#pragma unroll
                    for (int n = 0; n < 2; ++n) { const size_t o2 = off + bj * HALF + n * 16; const u32x2 g = *(const u32x2*)(sg + o2); const f32x4 a = acc[ai][bj][m][n]; const f32x4 p = *(const f32x4*)(m1 + o2);
                        u32x2 w; w.x = cvt_pk_bf16(p[0] + a[0] * bflo(g.x), p[1] + a[1] * bfhi(g.x)); w.y = cvt_pk_bf16(p[2] + a[2] * bflo(g.y), p[3] + a[3] * bfhi(g.y));
                        *(u32x2*)(out + o2) = w; } }
    }
};
struct EpiF32 {
    static constexpr bool PERM = false;
    float* out; int ldc;
    __device__ __forceinline__ void operator()(const f32x4 (&acc)[2][2][4][2], const Unit& u, int wr, int wc, int fr, int fq) const {
        const int row0 = u.pm * BM + wr * 64 + fr, col0 = u.pn * BM + wc * 32 + 4 * fq;
#pragma unroll
        for (int ai = 0; ai < 2; ++ai)
#pragma unroll
            for (int m = 0; m < 4; ++m) { const size_t off = (size_t)(row0 + ai * HALF + m * 16) * ldc + col0;
#pragma unroll
                for (int bj = 0; bj < 2; ++bj)
#pragma unroll
                    for (int n = 0; n < 2; ++n) *(f32x4*)(out + off + bj * HALF + n * 16) = acc[ai][bj][m][n]; }
    }
};
struct EpiGateUp {
    static constexpr bool PERM = true;
    const float* bgu; unsigned char* act;
    __device__ __forceinline__ void operator()(const f32x4 (&acc)[2][2][4][2], const Unit& u, int wr, int wc, int fr, int fq) const {
        const int row0 = u.pm * BM + wr * 64 + fr; const int f = u.pn * 128 + wc * 32 + 8 * fq;
        const float* bg = bgu + (size_t)u.e * 4096 + f;
        f32x4 bgate[2], bup[2];
#pragma unroll
        for (int n = 0; n < 2; ++n) { bgate[n] = *(const f32x4*)(bg + 4 * n); bup[n] = *(const f32x4*)(bg + 2048 + 4 * n); }
#pragma unroll
        for (int ai = 0; ai < 2; ++ai)
#pragma unroll
            for (int m = 0; m < 4; ++m) { u32x2 w;
#pragma unroll
                for (int n = 0; n < 2; ++n) { const f32x4 g4 = acc[ai][0][m][n] * 0.015625f + bgate[n], u4 = acc[ai][1][m][n] * 0.015625f + bup[n]; float r[4];
#pragma unroll
                    for (int q = 0; q < 4; ++q) { const float g = fminf(g4[q], 7.0f), up = fminf(fmaxf(u4[q], -7.0f), 7.0f); r[q] = (up + 1.0f) * g * sigmoidf_(1.702f * g); }
                    w[n] = pk4_fp8(r[0], r[1], r[2], r[3]); }
                *(u32x2*)(act + (size_t)(row0 + ai * HALF + m * 16) * DM + f) = w; }
    }
};
struct EpiDown {
    static constexpr bool PERM = true;
    const float* bdn; const int* list_dst; const float* list_w; const LAS int* tab; bf16* ys;
    __device__ __forceinline__ void operator()(const f32x4 (&acc)[2][2][4][2], const Unit& u, int wr, int wc, int fr, int fq) const {
        const int cnt = __builtin_amdgcn_readfirstlane(tab[u.e]); const int col0 = u.pn * BM + wc * 32 + 8 * fq; const float* bd = bdn + (size_t)u.e * DM + col0;
#pragma unroll
        for (int ai = 0; ai < 2; ++ai)
#pragma unroll
            for (int m = 0; m < 4; ++m) { const int j = u.ml * BM + ai * HALF + wr * 64 + m * 16 + fr;
                if (j < cnt) { const int dst = list_dst[u.e * 16384 + j]; const float w = list_w[u.e * 16384 + j]; bf16* rowp = ys + (size_t)dst * DM + col0;
#pragma unroll
                    for (int bj = 0; bj < 2; ++bj) { const f32x4 b0 = *(const f32x4*)(bd + bj * HALF), b1 = *(const f32x4*)(bd + bj * HALF + 4);
                        const f32x4 v0 = (acc[ai][bj][m][0] * 0.015625f + b0) * w, v1 = (acc[ai][bj][m][1] * 0.015625f + b1) * w;
                        u32x4 o; o.x = cvt_pk_bf16(v0[0], v0[1]); o.y = cvt_pk_bf16(v0[2], v0[3]); o.z = cvt_pk_bf16(v1[0], v1[1]); o.w = cvt_pk_bf16(v1[2], v1[3]);
                        *(u32x4*)(rowp + bj * HALF) = o; } } }
    }
};
}
namespace att {
constexpr int NW = 8, QBLK = 32, KVBLK = 64, QB = NW * QBLK;
constexpr int SHM_V = KVBLK * 128 * 2, SHM_K = KVBLK * 64 * 2;
constexpr int LDS_BYTES = 2 * SHM_V + 2 * SHM_K + NW * 64 * 4;
constexpr int QP = 2048, OP = 4096;
constexpr float SCALE = 0.125f, THR = 8.f;
#define KSWZ(row, colB) ((row) * 128 + ((colB) ^ ((((row) >> 1) & 7) << 4)))
__device__ __forceinline__ int v_st(int k, int c) { const int kk = (k & ~0xC) | ((k & 4) << 1) | ((k & 8) >> 1); return ((kk >> 3) * 4 + (c >> 5)) * 512 + ((kk & 7) * 32 + (c & 31)) * 2; }
__device__ __forceinline__ int v_rd_base(int lane) { return ((lane & 3) << 3) | (((lane >> 2) & 3) << 6) | (((lane >> 4) & 1) << 5) | (((lane >> 5) & 1) << 8); }
constexpr int v_rd_off(int d0, int ks, int half) { return d0 * 512 + ks * 4096 + half * 2048; }
__device__ __forceinline__ int crow(int r, int hi) { return (r & 3) + 8 * (r >> 2) + 4 * hi; }
__device__ __forceinline__ unsigned cvtpk(float lo, float hi) { unsigned r; asm volatile("v_cvt_pk_bf16_f32 %0, %1, %2" : "=v"(r) : "v"(lo), "v"(hi)); return r; }
__device__ __forceinline__ bf16x8 load8(const bf16* p) { return *reinterpret_cast<const bf16x8*>(p); }
__device__ __forceinline__ void mask_tile(f32x16& p0, f32x16& p1, int dq) {
    const float NEG = -__builtin_inff();
#pragma unroll
    for (int r = 0; r < 16; ++r) {
        const int c = (r & 3) + 8 * (r >> 2);
        if (dq - c < 0) p0[r] = NEG;
        if (dq - c - 32 < 0) p1[r] = NEG;
    }
}
__device__ __forceinline__ void partialSM(f32x16& p0, f32x16& p1, float& m_reg, float& mn, float& alpha) {
    float pmax = p0[0];
#pragma unroll
    for (int r = 1; r < 16; ++r) pmax = fmaxf(pmax, p0[r]);
#pragma unroll
    for (int r = 0; r < 16; ++r) pmax = fmaxf(pmax, p1[r]);
    { auto rr = __builtin_amdgcn_permlane32_swap(__float_as_uint(pmax), __float_as_uint(pmax), false, false);
      pmax = fmaxf(__uint_as_float(rr[0]), __uint_as_float(rr[1])); }
    constexpr float C2 = 1.4426950408889634f * SCALE;
    if (__builtin_expect(__all((pmax - m_reg) * SCALE <= THR), 1)) { mn = m_reg; alpha = 1.f; }
    else { mn = fmaxf(m_reg, pmax); alpha = __builtin_amdgcn_exp2f((m_reg - mn) * C2); m_reg = mn; }
    const float mnL = -mn * C2;
#pragma unroll
    for (int r = 0; r < 16; ++r) p0[r] = fmaf(p0[r], C2, mnL);
#pragma unroll
    for (int r = 0; r < 16; ++r) p1[r] = fmaf(p1[r], C2, mnL);
#pragma unroll
    for (int r = 0; r < 16; ++r) p0[r] = __builtin_amdgcn_exp2f(p0[r]);
}
__device__ __forceinline__ void finishSM(f32x16& p0, f32x16& p1, float alpha, float& l_reg, bf16x8& pa0, bf16x8& pa1, bf16x8& pa2, bf16x8& pa3) {
#pragma unroll
    for (int r = 0; r < 16; ++r) p1[r] = __builtin_amdgcn_exp2f(p1[r]);
    float ps = 0;
#pragma unroll
    for (int r = 0; r < 16; ++r) ps += p0[r];
#pragma unroll
    for (int r = 0; r < 16; ++r) ps += p1[r];
    { auto rr = __builtin_amdgcn_permlane32_swap(__float_as_uint(ps), __float_as_uint(ps), false, false);
      ps = __uint_as_float(rr[0]) + __uint_as_float(rr[1]); }
    l_reg = l_reg * alpha + ps;
#define PK4(P, B_, OUT) do { unsigned a0 = cvtpk(P[B_+0], P[B_+1]), a1 = cvtpk(P[B_+2], P[B_+3]);                          \
        unsigned b0 = cvtpk(P[B_+4], P[B_+5]), b1 = cvtpk(P[B_+6], P[B_+7]);                                             \
        auto r0 = __builtin_amdgcn_permlane32_swap(a0, b0, false, false); auto r1 = __builtin_amdgcn_permlane32_swap(a1, b1, false, false); \
        u32x4 w = {r0[0], r1[0], r0[1], r1[1]}; OUT = *reinterpret_cast<bf16x8*>(&w); } while (0)
    PK4(p0, 0, pa0); PK4(p0, 8, pa1); PK4(p1, 0, pa2); PK4(p1, 8, pa3);
#undef PK4
}
template <int KB>
__device__ __forceinline__ void qkt(f32x16& p0, f32x16& p1, const char* K_lds, int r32, int hi, const bf16x8* qr) {
    p0 = f32x16{}; p1 = f32x16{};
#pragma unroll
    for (int d0 = 0; d0 < 4; ++d0) { const char* a = K_lds + KB * SHM_K + KSWZ(r32, (d0 * 2 + hi) * 16);
        bf16x8 b0 = *reinterpret_cast<const bf16x8*>(a);
        bf16x8 b1 = *reinterpret_cast<const bf16x8*>(a + 32 * 128);
        p0 = __builtin_amdgcn_mfma_f32_32x32x16_bf16(b0, qr[d0], p0, 0, 0, 0);
        p1 = __builtin_amdgcn_mfma_f32_32x32x16_bf16(b1, qr[d0], p1, 0, 0, 0); }
}
template <int VB>
__device__ __forceinline__ void pv_tile(f32x16* o, int vb0, bf16x8 pa0, bf16x8 pa1, bf16x8 pa2, bf16x8 pa3) {
#define TRRD(dst, off) asm volatile("ds_read_b64_tr_b16 %0, %1 offset:%2" : "=&v"(dst) : "v"(vb0), "i"(off) : "memory")
#define PV_D0(d0) do { s16x4 l0, l1, l2, l3, h0, h1, h2, h3; constexpr int b_ = VB * SHM_V + v_rd_off(d0, 0, 0); \
        TRRD(l0, b_); TRRD(h0, b_ + 2048); TRRD(l1, b_ + 4096); TRRD(h1, b_ + 6144); TRRD(l2, b_ + 8192); TRRD(h2, b_ + 10240); TRRD(l3, b_ + 12288); TRRD(h3, b_ + 14336); \
        asm volatile("s_waitcnt lgkmcnt(0)" ::: "memory"); SBAR();   \
        o[d0] = __builtin_amdgcn_mfma_f32_32x32x16_bf16(pa0, (bf16x8){l0[0], l0[1], l0[2], l0[3], h0[0], h0[1], h0[2], h0[3]}, o[d0], 0, 0, 0);   \
        o[d0] = __builtin_amdgcn_mfma_f32_32x32x16_bf16(pa1, (bf16x8){l1[0], l1[1], l1[2], l1[3], h1[0], h1[1], h1[2], h1[3]}, o[d0], 0, 0, 0);   \
        o[d0] = __builtin_amdgcn_mfma_f32_32x32x16_bf16(pa2, (bf16x8){l2[0], l2[1], l2[2], l2[3], h2[0], h2[1], h2[2], h2[3]}, o[d0], 0, 0, 0);   \
        o[d0] = __builtin_amdgcn_mfma_f32_32x32x16_bf16(pa3, (bf16x8){l3[0], l3[1], l3[2], l3[3], h3[0], h3[1], h3[2], h3[3]}, o[d0], 0, 0, 0); } while (0)
    PV_D0(0); PV_D0(1); PV_D0(2); PV_D0(3);
#undef PV_D0
#undef TRRD
}
struct BlockRef { const bf16* Q; const bf16* K; const bf16* V; bf16* O; int P0; };
struct Seam { bf16x8 qr[4]; bf16x8 st_v0, st_v1, st_k0; };
#define VMW() asm volatile("s_waitcnt vmcnt(0)" ::: "memory")
#define VMWN(n) asm volatile("s_waitcnt vmcnt(%0)" :: "i"(n) : "memory")
#define SLOAD_H(Kp, Vp, k0) do { S.st_v0 = load8((Vp) + (size_t)((k0) + sr) * QP + sc); S.st_v1 = load8((Vp) + (size_t)((k0) + 32 + sr) * QP + sc);              \
                                 S.st_k0 = load8((Kp) + (size_t)((k0) + krow) * QP + kc); } while (0)
#define SWRITE_HK(bf) do { *(bf16x8*)(K_lds + (bf) * SHM_K + kws) = S.st_k0; } while (0)
#define SWRITE_HV(bf) do { *(bf16x8*)(V_lds + (bf) * SHM_V + vst0) = S.st_v0; *(bf16x8*)(V_lds + (bf) * SHM_V + vst1) = S.st_v1; } while (0)
#define SWRITE_H(bf) do { SWRITE_HV(bf); SWRITE_HK(bf); } while (0)
__device__ __forceinline__ void attn_prime(const BlockRef& cur, char* lds, Seam& S, int wv) {
    const int tid = otid(wv), wid = __builtin_amdgcn_readfirstlane(tid >> 6), lane = tid & 63, r32 = lane & 31, hi = lane >> 5;
    const int sr = tid >> 4, sc = (tid & 15) * 8, krow = tid >> 3, kc = (tid & 7) * 8, kws = KSWZ(krow, kc * 2); char* K_lds = lds + 2 * SHM_V;
#pragma unroll
    for (int d0 = 0; d0 < 4; ++d0) S.qr[d0] = load8(cur.Q + (size_t)(wid * QBLK + r32) * QP + d0 * 16 + hi * 8);
    SLOAD_H(cur.K, cur.V, 0); VMW(); SWRITE_HK(0);
    __syncthreads();
}
__device__ __forceinline__ void attn_block(const BlockRef& cur, const BlockRef& nxt, char* lds, Seam& S, int wv) {
    const int tid = otid(wv), wid = __builtin_amdgcn_readfirstlane(tid >> 6), lane = tid & 63, r32 = lane & 31, hi = lane >> 5;
    const int NT = (cur.P0 + QB - 1) / KVBLK + 1;
    const int qlo = cur.P0 + wid * QBLK, qm = qlo + r32 - 4 * hi;
    char* V_lds = lds; char* K_lds = lds + 2 * SHM_V;
    float* ws = (float*)(lds + 2 * SHM_V + 2 * SHM_K) + wid * 64; float* li_l = ws, * al_l = ws + 32;
    float m_reg = -1e30f, l_reg = 0; f32x16 o[4] = {};
    const int sr = tid >> 4, sc = (tid & 15) * 8, vst0 = v_st(sr, sc), vst1 = v_st(32 + sr, sc);
    const int krow = tid >> 3, kc = (tid & 7) * 8, kws = KSWZ(krow, kc * 2);
    const int vb0 = (int)(uintptr_t)V_lds + v_rd_base(lane);
    const bf16* Kh = cur.K; const bf16* Vh = cur.V;
#define RESC(a) do { if (__any((a) < 1.f)) { if (hi == 0) al_l[r32] = (a); asm volatile("s_waitcnt lgkmcnt(0)" ::: "memory");              \
                     for (int d_ = 0; d_ < 4; ++d_) for (int r = 0; r < 16; ++r) o[d_][r] *= al_l[crow(r, hi)]; } } while (0)
#define KBASE(t) ((t) * KVBLK)
#define MASKT(P0_, P1_, t) do { const int kb_ = KBASE(t); if (kb_ + KVBLK - 1 > qlo) mask_tile(P0_, P1_, qm - kb_); } while (0)
    constexpr int NQL = 4;
#define SEAM_K0() do { VMWN(NQL); SWRITE_HK(0); SBAR(); } while (0)
    f32x16 pA0, pA1, pB0, pB1; float mnA, mnB, alA, alB; bf16x8 pa0, pa1, pa2, pa3;
    SWRITE_HV(0); SBAR();
    SLOAD_H(Kh, Vh, KBASE(1));
    SBAR(); qkt<0>(pA0, pA1, K_lds, r32, hi, S.qr);
    MASKT(pA0, pA1, 0); partialSM(pA0, pA1, m_reg, mnA, alA);
    VMW(); SWRITE_H(1);
    __syncthreads();
#define HALF_STEP(PX0, PX1, mnX, alX, PY0, PY1, alY, t, KB, VB, SB) do {                                                      \
        SBAR(); qkt<KB>(PX0, PX1, K_lds, r32, hi, S.qr);                                             \
        finishSM(PY0, PY1, alY, l_reg, pa0, pa1, pa2, pa3); SBAR();                                                           \
        if ((t) + 1 < NT) { SLOAD_H(Kh, Vh, KBASE((t) + 1)); SBAR(); }                                               \
        pv_tile<VB>(o, vb0, pa0, pa1, pa2, pa3); MASKT(PX0, PX1, (t)); partialSM(PX0, PX1, m_reg, mnX, alX);                                        \
        __syncthreads();                                                                                                      \
        if ((t) + 1 < NT) { VMW(); SWRITE_H(SB); }                                                                          \
        RESC(alX); __syncthreads(); } while (0)
    for (int t = 1; t + 1 < NT; t += 2) {
        HALF_STEP(pB0, pB1, mnB, alB, pA0, pA1, alA, t, 1, 0, 0);
        HALF_STEP(pA0, pA1, mnA, alA, pB0, pB1, alB, t + 1, 0, 1, 1);
    }
    const bool even = (NT & 1) == 0;
    if (even) { SBAR(); qkt<1>(pB0, pB1, K_lds, r32, hi, S.qr); SBAR(); }
    SLOAD_H(nxt.K, nxt.V, 0); SBAR();
#pragma unroll
    for (int d0 = 0; d0 < 4; ++d0) S.qr[d0] = load8(nxt.Q + (size_t)(wid * QBLK + r32) * QP + d0 * 16 + hi * 8);
    SBAR();
    finishSM(pA0, pA1, alA, l_reg, pa0, pa1, pa2, pa3); SBAR();
    pv_tile<0>(o, vb0, pa0, pa1, pa2, pa3);
    if (even) { MASKT(pB0, pB1, NT - 1); partialSM(pB0, pB1, m_reg, mnB, alB); __syncthreads(); RESC(alB);
        finishSM(pB0, pB1, alB, l_reg, pa0, pa1, pa2, pa3); SBAR(); pv_tile<1>(o, vb0, pa0, pa1, pa2, pa3); }
    SBAR(); SEAM_K0();
    if (hi == 0) li_l[r32] = l_reg; asm volatile("s_waitcnt lgkmcnt(0)" ::: "memory");
    float rli[16];
#pragma unroll
    for (int r = 0; r < 16; ++r) rli[r] = __builtin_amdgcn_rcpf(li_l[crow(r, hi)]);
    bf16* Ow = cur.O + (size_t)(wid * QBLK) * OP;
#pragma unroll
    for (int r = 0; r < 16; ++r) { const int orow = crow(r, hi);
#pragma unroll
        for (int d0 = 0; d0 < 4; ++d0) { const float v = o[d0][r] * rli[r];
            const float vn = __shfl_xor(v, 1);
            if ((r32 & 1) == 0) *(unsigned*)(Ow + (size_t)orow * OP + d0 * 32 + r32) = cvtpk(v, vn); } }
    __syncthreads();
#undef RESC
#undef KBASE
#undef MASKT
#undef SEAM_K0
#undef HALF_STEP
}
#undef VMW
#undef VMWN
#undef SLOAD_H
#undef SWRITE_HK
#undef SWRITE_HV
#undef SWRITE_H
#undef KSWZ
__device__ __forceinline__ BlockRef make_ref(int L, int pass, const bf16* Q, const bf16* K, const bf16* V, bf16* O) {
    const int bh = L >> 3, x = L & 7, qb = pass ? 15 - x : x, b = bh >> 5, map = bh & 31;
    const size_t seq0 = (size_t)b * SEQ, row0 = seq0 + (size_t)qb * QB;
    BlockRef r; r.Q = Q + row0 * QP + map * 64; r.K = K + seq0 * QP + map * 64; r.V = V + seq0 * QP + (map >> 1) * 128; r.O = O + row0 * OP + map * 128; r.P0 = qb * QB; return r;
}
__device__ __forceinline__ void attn_phase(char* lds, const bf16* Q, const bf16* K, const bf16* V, bf16* O, int first, int stride, int wv) {
    constexpr int total = NB * 32 * 8;
    int L = first; if (L >= total) return;
    int pass = 0;
    BlockRef cur = make_ref(L, 0, Q, K, V, O);
    Seam S;
    attn_prime(cur, lds, S, wv);
    for (;;) {
        const bool more_pass = pass == 0, more_item = L + stride < total, last = !more_pass && !more_item;
        int passn = pass + 1, Ln = L;
        if (!more_pass) { passn = 0; Ln = more_item ? L + stride : L; }
        const BlockRef nxt = last ? cur : make_ref(Ln, passn, Q, K, V, O);
        attn_block(cur, nxt, lds, S, wv);
        if (last) break;
        cur = nxt; pass = passn; L = Ln;
    }
}
}
struct Args { const float* in[29]; float* out; unsigned char* ws; int ph_lo, ph_hi; };
enum { I_X = 0, I_C, I_WADA, I_BADA, I_GPREMIX, I_GPOSTMIX, I_GPREFFN, I_GPOSTFFN, I_WIN, I_CONVW, I_CONVB, I_DTBIAS, I_ALOG, I_DSKIP, I_SSDNW,
       I_LQ1, I_LK1, I_LQ2, I_LK2, I_SUBLN, I_WBS, I_WBA, I_WOUT, I_WR, I_BR, I_WGU, I_BGU, I_WDN, I_BDN };
#define WSP(T, off) ((T*)(a.ws + (off) * MiB))

__device__ __forceinline__ void ph_mod(const Args& a, LAS unsigned char* lds, int wv) {
    LAS float* sc = (LAS float*)lds;
    LAS float* part = (LAS float*)(lds + 32768);
    const int tid = otid(wv); const float* c = a.in[I_C]; const float* W = a.in[I_WADA]; const float* bada = a.in[I_BADA]; float* mod = WSP(float, WS_MOD);
    for (int i = tid; i < NB * DM; i += NTHR) sc[i] = siluf_(c[i]);
    __syncthreads();
    for (int cb = blockIdx.x; cb < 256; cb += gridDim.x) {
        const int ks = tid / 12, quad = tid % 12;
        f32x4 acc[4] = {{0.f, 0.f, 0.f, 0.f}, {0.f, 0.f, 0.f, 0.f}, {0.f, 0.f, 0.f, 0.f}, {0.f, 0.f, 0.f, 0.f}};
        if (ks < 42) {
#pragma unroll 4
            for (int k = ks; k < DM; k += 42) { const f32x4 w = *(const f32x4*)(W + (size_t)k * 12288 + cb * 48 + quad * 4);
#pragma unroll
                for (int b = 0; b < 4; ++b) acc[b] += w * sc[b * DM + k]; }
#pragma unroll
            for (int b = 0; b < 4; ++b) *(LAS f32x4*)(part + (ks * 12 + quad) * 16 + b * 4) = acc[b];
        }
        __syncthreads();
        if (tid < 192) { const int col = tid % 48, b = tid / 48; float s = 0.f;
            for (int k2 = 0; k2 < 42; ++k2) s += part[(k2 * 12 + (col >> 2)) * 16 + b * 4 + (col & 3)];
            mod[b * 12288 + cb * 48 + col] = s + bada[cb * 48 + col]; }
        __syncthreads();
    }
}

constexpr int TRP = 68;
struct TrSrc { const float* p[4]; bool zero; };
__device__ __forceinline__ const float* tr_src(const float* W, int N, int k0, int d0, int kind, int lane, bool& zero) {
    const int j4 = (lane & 15) * 4; int scol; zero = false;
    if (kind == 0) scol = d0 + j4;
    else if (kind == 1) { const int r = d0 + j4;
        if (r < 5120) scol = r; else if (r < 15360) scol = r + 32; else if (r < 15392) scol = 5120 + (r - 15360); else { scol = 0; zero = true; } }
    else { const int t = d0 >> 8, w = d0 & 255; scol = 128 * t + (w < 128 ? w : 2048 + (w - 128)) + j4; }
    return W + (size_t)(k0 + (lane >> 4)) * N + scol;
}
__device__ __forceinline__ void tr_load8(const float* src, int N, bool zero, int half, f32x4 (&v)[8]) {
#pragma unroll
    for (int i = 0; i < 8; ++i) v[i] = zero ? (f32x4){0.f, 0.f, 0.f, 0.f} : *(const f32x4*)(src + (size_t)(4 * (8 * half + i)) * N);
}
__device__ __forceinline__ void tr_put8(const f32x4 (&v)[8], int half, LAS bf16* scr, int lane) {
#pragma unroll
    for (int i = 0; i < 8; ++i) { const int k = (lane >> 4) + 4 * (8 * half + i); u32x2 w; w.x = cvt_pk_bf16(v[i][0], v[i][1]); w.y = cvt_pk_bf16(v[i][2], v[i][3]);
        *(LAS u32x2*)(scr + k * TRP + (lane & 15) * 4) = w; }
}
__device__ __forceinline__ void tr_flush(bf16* WT, int K, int k0, int d0, int kind, const LAS bf16* scr, int lane) {
    typedef short v4i16_t __attribute__((ext_vector_type(4)));
    const int g = lane >> 4, i16 = lane & 15, q = (lane >> 2) & 3, pp = lane & 3;
#pragma unroll
    for (int nb = 0; nb < 4; ++nb) { const int lc = 16 * nb + i16;
        const int r = lc;
#pragma unroll
        for (int j = 0; j < 2; ++j) { const int kc = 8 * (g + 4 * j);
            const LAS bf16* a0 = scr + (kc + q) * TRP + 16 * nb + 4 * pp;
            const v4i16_t lo = __builtin_amdgcn_ds_read_tr16_b64_v4i16((LAS v4i16_t*)a0);
            const v4i16_t hi = __builtin_amdgcn_ds_read_tr16_b64_v4i16((LAS v4i16_t*)(a0 + 4 * TRP));
            u32x4 o; o.x = (unsigned)(unsigned short)lo[0] | ((unsigned)(unsigned short)lo[1] << 16); o.y = (unsigned)(unsigned short)lo[2] | ((unsigned)(unsigned short)lo[3] << 16);
            o.z = (unsigned)(unsigned short)hi[0] | ((unsigned)(unsigned short)hi[1] << 16); o.w = (unsigned)(unsigned short)hi[2] | ((unsigned)(unsigned short)hi[3] << 16);
            *(u32x4*)(WT + (size_t)(d0 + r) * K + k0 + kc) = o; } }
}
__device__ __forceinline__ void tr_flush8(unsigned char* WT, int K, int k0, int d0, int kind, const LAS bf16* scr, int lane) {
    typedef short v4i16_t __attribute__((ext_vector_type(4)));
    const int g = lane >> 4, i16 = lane & 15, q = (lane >> 2) & 3, pp = lane & 3;
#pragma unroll
    for (int nb = 0; nb < 4; ++nb) { const int lc = 16 * nb + i16;
        const int r = lc;
        const LAS bf16* a0 = scr + (16 * g + q) * TRP + 16 * nb + 4 * pp; unsigned o[4];
#pragma unroll
        for (int j = 0; j < 4; ++j) { const v4i16_t v = __builtin_amdgcn_ds_read_tr16_b64_v4i16((LAS v4i16_t*)(a0 + 4 * j * TRP));
            o[j] = pk4_fp8(bf2f((unsigned short)v[0]) * 64.f, bf2f((unsigned short)v[1]) * 64.f, bf2f((unsigned short)v[2]) * 64.f, bf2f((unsigned short)v[3]) * 64.f); }
        *(u32x4*)(WT + (size_t)(d0 + r) * K + k0 + 16 * g) = (u32x4){o[0], o[1], o[2], o[3]}; }
}
struct TrItem { const float* W; bf16* WT; int N, k0, d0, kind; bool fp8; };
__device__ __forceinline__ bool tr_decode(const Args& a, int it, TrItem& t) {
    constexpr int I_IN = (DM / 64) * (NPROJ / 64), I_SQ = (DM / 64) * (DM / 64), I_GU = (DM / 64) * (4096 / 64), I_DN = I_SQ;
    constexpr int NITEMS = I_IN + 3 * I_SQ + NE * I_GU + NE * I_DN;
    if (it >= NITEMS) return false;
    int r = it;
    if (r < I_IN) { constexpr int nblk = NPROJ / 64; t = TrItem{a.in[I_WIN], WSP(bf16, WS_WT_IN), 15392, 64 * (r / nblk), 64 * (r % nblk), 1, false}; return true; } r -= I_IN;
    if (r < I_SQ) { t = TrItem{a.in[I_WBS], WSP(bf16, WS_WT_BS), DM, 64 * (r / 32), 64 * (r % 32), 0, false}; return true; } r -= I_SQ;
    if (r < I_SQ) { t = TrItem{a.in[I_WBA], WSP(bf16, WS_WT_BA), DM, 64 * (r / 32), 64 * (r % 32), 0, false}; return true; } r -= I_SQ;
    if (r < I_SQ) { t = TrItem{a.in[I_WOUT], WSP(bf16, WS_WT_OUT), DM, 64 * (r / 32), 64 * (r % 32), 0, false}; return true; } r -= I_SQ;
    if (r < NE * I_GU) { const int e = r / I_GU, q = r % I_GU; t = TrItem{a.in[I_WGU] + (size_t)e * DM * 4096, (bf16*)(WSP(unsigned char, WS_WT_GU) + (size_t)e * 4096 * DM), 4096, 64 * (q / 64), 64 * (q % 64), 2, true}; return true; } r -= NE * I_GU;
    { const int e = r / I_DN, q = r % I_DN; t = TrItem{a.in[I_WDN] + (size_t)e * DM * DM, (bf16*)(WSP(unsigned char, WS_WT_DN) + (size_t)e * DM * DM), DM, 64 * (q / 32), 64 * (q % 32), 0, true}; return true; }
}
__device__ __forceinline__ void tr_all(const Args& a, LAS bf16* scr, int gw, int NGW, int lane) {
    TrItem cur; if (!tr_decode(a, gw, cur)) return;
    bool zc; const float* sc = tr_src(cur.W, cur.N, cur.k0, cur.d0, cur.kind, lane, zc);
    f32x4 v0[8], v1[8];
    tr_load8(sc, cur.N, zc, 0, v0);
    for (int it = gw;; ) {
        tr_load8(sc, cur.N, zc, 1, v1);
        tr_put8(v0, 0, scr, lane);
        const int itn = it + NGW; TrItem nxt; const bool more = tr_decode(a, itn, nxt);
        bool zn = zc; const float* sn = sc; if (more) sn = tr_src(nxt.W, nxt.N, nxt.k0, nxt.d0, nxt.kind, lane, zn);
        if (more) tr_load8(sn, nxt.N, zn, 0, v0);
        tr_put8(v1, 1, scr, lane);
        if (cur.fp8) tr_flush8((unsigned char*)cur.WT, DM, cur.k0, cur.d0, cur.kind, scr, lane); else tr_flush(cur.WT, DM, cur.k0, cur.d0, cur.kind, scr, lane);
        if (!more) break;
        cur = nxt; sc = sn; zc = zn; it = itn;
    }
}
__device__ __forceinline__ void sincos_acc(float angf, float& s_out, float& c_out) {
    const double ang = (double)angf; const double twopi = 6.283185307179586476925, inv2pi = 0.159154943091895335769;
    double q = ang * inv2pi; q = q - (double)(long long)(q + 0.5);
    const double r = q * twopi * 0.25, r2 = r * r;
    double s = r * (1.0 + r2 * (-1.0 / 6 + r2 * (1.0 / 120 + r2 * (-1.0 / 5040 + r2 * (1.0 / 362880 + r2 * (-1.0 / 39916800 + r2 * (1.0 / 6227020800.0)))))));
    double c = 1.0 + r2 * (-0.5 + r2 * (1.0 / 24 + r2 * (-1.0 / 720 + r2 * (1.0 / 40320 + r2 * (-1.0 / 3628800 + r2 * (1.0 / 479001600.0))))));
    double s2 = 2 * s * c, c2 = c * c - s * s; s = 2 * s2 * c2; c = c2 * c2 - s2 * s2;
    s_out = (float)s; c_out = (float)c;
}
__device__ __forceinline__ void rms_row_to_bf16(const float* xrow, const float* g, const float* scv, const float* shv, bf16* orow, int lane, float eps) {
    f32x4 v[8]; float s = 0.f;
#pragma unroll
    for (int j = 0; j < 8; ++j) { v[j] = *((const f32x4*)xrow + lane + 64 * j); s += (v[j].x * v[j].x + v[j].y * v[j].y) + (v[j].z * v[j].z + v[j].w * v[j].w); }
    const float rstd = 1.0f / sqrtf(wave_sum(s) * (1.0f / DM) + eps);
#pragma unroll
    for (int j = 0; j < 8; ++j) { const int o4 = lane + 64 * j; const f32x4 gg = *((const f32x4*)g + o4), s1 = *((const f32x4*)scv + o4), s0 = *((const f32x4*)shv + o4);
        const f32x4 y = v[j] * rstd * gg * (s1 + 1.0f) + s0;
        u32x2 w; w.x = pk2(y.x, y.y); w.y = pk2(y.z, y.w); *((u32x2*)orow + o4) = w; }
}
__device__ __forceinline__ void ph_prep(const Args& a, LAS unsigned char* lds, int vcu, int G, int wv) {
    const int tid = otid(wv), lane = tid & 63, wave = __builtin_amdgcn_readfirstlane(tid >> 6);
    const int gw = vcu * NWAVES + wave, NGW = G * NWAVES, gt = vcu * NTHR + tid, NGT = G * NTHR;
    const float* mod = WSP(float, WS_MOD);
    { float* rope = WSP(float, WS_ROPE);
      const float invf[8] = {1.0f, 0.19392274f, 0.03760603f, 0.0072926646f, 0.0014142136f, 0.0002742482f, 5.3182957e-05f, 1.0313385e-05f};
      for (int i = gt; i < SEQ * 8; i += NGT) { const int pos = i >> 3, j = i & 7; float fr_ = 1.0f;
#pragma unroll
          for (int q = 0; q < 8; ++q) fr_ = (j == q) ? invf[q] : fr_;
          const float ang = (float)pos * fr_; float s, c; sincos_acc(ang, s, c); rope[pos * 16 + j] = c; rope[pos * 16 + 8 + j] = s; } }
    { float* wr = WSP(float, WS_WR); const float* Wr = a.in[I_WR]; const float* g = a.in[I_GPREFFN];
      for (int i = gt; i < NB * DM * NE; i += NGT) { const int b = i / (DM * NE), r = i % (DM * NE), k = r / NE; wr[i] = g[k] * (1.0f + mod[b * 12288 + 8192 + k]) * Wr[r]; }
      if (vcu == 0 && tid < NB * NE) { const int b = tid / NE, e = tid % NE; float s = 0.f; for (int k = 0; k < DM; ++k) s += mod[b * 12288 + 6144 + k] * Wr[k * NE + e];
          ((float*)(a.ws + WS_MOD * MiB + MOD_CB))[tid] = s + a.in[I_BR][e]; } }
    { const float* x = a.in[I_X]; bf16* H = WSP(bf16, WS_H); const float* g = a.in[I_GPREMIX];
      for (int m = gw; m < MT; m += NGW) { const int b = m / SEQ; rms_row_to_bf16(x + (size_t)m * DM, g, mod + b * 12288 + 2048, mod + b * 12288, H + (size_t)m * DM, lane, 1e-6f); } }
    tr_all(a, (LAS bf16*)(lds + wave * 16384), gw, NGW, lane);
}

__device__ __forceinline__ void ph_conv(const Args& a, int vcu, int G, int wv) {
    const int gt = vcu * NTHR + otid(wv), NGT = G * NTHR;
    { const bf16* X = WSP(bf16, WS_XBC); bf16* Y = WSP(bf16, WS_XBCC); const float* cw = a.in[I_CONVW]; const float* cbias = a.in[I_CONVB];
      for (int it = gt; it < (XBCW / 8) * (MT / 64); it += NGT) { const int cg = it % (XBCW / 8), seg = it / (XBCW / 8), c0 = cg * 8, t0 = seg * 64;
          float w[4][8], bb[8];
#pragma unroll
          for (int k = 0; k < 4; ++k) { const f32x4 w0 = *(const f32x4*)(cw + k * XBCW + c0), w1 = *(const f32x4*)(cw + k * XBCW + c0 + 4);
#pragma unroll
              for (int q = 0; q < 4; ++q) { w[k][q] = w0[q]; w[k][4 + q] = w1[q]; } }
          { const f32x4 b0 = *(const f32x4*)(cbias + c0), b1 = *(const f32x4*)(cbias + c0 + 4);
#pragma unroll
            for (int q = 0; q < 4; ++q) { bb[q] = b0[q]; bb[4 + q] = b1[q]; } }
          float hs[3][8];
          const bool seqstart = (t0 % SEQ) == 0;
#pragma unroll
          for (int r = 0; r < 3; ++r) { u32x4 v = {0u, 0u, 0u, 0u}; if (!seqstart) v = *(const u32x4*)(X + (size_t)(t0 - 3 + r) * XBCW + c0);
              hs[r][0] = bflo(v.x); hs[r][1] = bfhi(v.x); hs[r][2] = bflo(v.y); hs[r][3] = bfhi(v.y); hs[r][4] = bflo(v.z); hs[r][5] = bfhi(v.z); hs[r][6] = bflo(v.w); hs[r][7] = bfhi(v.w); }
#pragma unroll 4
          for (int t = 0; t < 64; ++t) { const u32x4 v = *(const u32x4*)(X + (size_t)(t0 + t) * XBCW + c0);
              float xc[8] = {bflo(v.x), bfhi(v.x), bflo(v.y), bfhi(v.y), bflo(v.z), bfhi(v.z), bflo(v.w), bfhi(v.w)}; float y[8];
#pragma unroll
              for (int q = 0; q < 8; ++q) { const float s = bb[q] + w[0][q] * hs[0][q] + w[1][q] * hs[1][q] + w[2][q] * hs[2][q] + w[3][q] * xc[q]; y[q] = siluf_(s); hs[0][q] = hs[1][q]; hs[1][q] = hs[2][q]; hs[2][q] = xc[q]; }
              u32x4 o; o.x = pk2(y[0], y[1]); o.y = pk2(y[2], y[3]); o.z = pk2(y[4], y[5]); o.w = pk2(y[6], y[7]);
              *(u32x4*)(Y + (size_t)(t0 + t) * XBCW + c0) = o; } } }
    { const float* dr = WSP(float, WS_DTRAW); float* dt = WSP(float, WS_DT); const float* bias = a.in[I_DTBIAS];
      for (int i = gt; i < MT * 32; i += NGT) { const float x = dr[i] + bias[i & 31]; dt[i] = (x > 20.f) ? x : log1pf(__expf(x)); } }
    { const float* rope = WSP(float, WS_ROPE);
      for (int it = gt; it < MT * 32 * 2; it += NGT) { const int which = it / (MT * 32), r = it % (MT * 32), t = r >> 5, hd = r & 31; bf16* p = (which ? WSP(bf16, WS_K) : WSP(bf16, WS_Q)) + (size_t)t * DM + hd * 64;
          const u32x4 v1 = *(const u32x4*)p, v2 = *(const u32x4*)(p + 8); const float* rp = rope + (t % SEQ) * 16;
          const f32x4 c0 = *(const f32x4*)rp, c1 = *(const f32x4*)(rp + 4), s0 = *(const f32x4*)(rp + 8), s1 = *(const f32x4*)(rp + 12);
          const float x1[8] = {bflo(v1.x), bfhi(v1.x), bflo(v1.y), bfhi(v1.y), bflo(v1.z), bfhi(v1.z), bflo(v1.w), bfhi(v1.w)};
          const float x2[8] = {bflo(v2.x), bfhi(v2.x), bflo(v2.y), bfhi(v2.y), bflo(v2.z), bfhi(v2.z), bflo(v2.w), bfhi(v2.w)};
          const float cc[8] = {c0[0], c0[1], c0[2], c0[3], c1[0], c1[1], c1[2], c1[3]}, ss[8] = {s0[0], s0[1], s0[2], s0[3], s1[0], s1[1], s1[2], s1[3]};
          float y1[8], y2[8];
#pragma unroll
          for (int q = 0; q < 8; ++q) { y1[q] = x1[q] * cc[q] - x2[q] * ss[q]; y2[q] = x2[q] * cc[q] + x1[q] * ss[q]; }
          u32x4 o1, o2; o1.x = pk2(y1[0], y1[1]); o1.y = pk2(y1[2], y1[3]); o1.z = pk2(y1[4], y1[5]); o1.w = pk2(y1[6], y1[7]);
          o2.x = pk2(y2[0], y2[1]); o2.y = pk2(y2[2], y2[3]); o2.z = pk2(y2[4], y2[5]); o2.w = pk2(y2[6], y2[7]);
          *(u32x4*)p = o1; *(u32x4*)(p + 8) = o2; } }
}
constexpr int SP = 136;
#define SSD_FRAG(base, row, k0) (*(const LAS bf16x8*)((base) + (row) * SP + (k0)))
__device__ __forceinline__ void ssd_stage128(const bf16* X, int t0, int col0, LAS bf16* dst, int tid) {
#pragma unroll
    for (int i = 0; i < 4; ++i) { const int q = tid + NTHR * i, row = q >> 4, ch = q & 15;
        const u32x4 v = *(const u32x4*)(X + (size_t)(t0 + row) * XBCW + col0 + ch * 8);
        *(LAS u32x4*)(dst + row * SP + ch * 8) = v; }
}
typedef short v4i16_t __attribute__((ext_vector_type(4)));
__device__ __forceinline__ bf16x8 ssd_frag_t(const LAS bf16* img, int pitch, int k0, int c0, int lane) {
    const LAS bf16* a = img + (k0 + 8 * (lane >> 4) + ((lane >> 2) & 3)) * pitch + c0 + 4 * (lane & 3);
    const v4i16_t lo = __builtin_amdgcn_ds_read_tr16_b64_v4i16((LAS v4i16_t*)a), hi = __builtin_amdgcn_ds_read_tr16_b64_v4i16((LAS v4i16_t*)(a + 4 * pitch));
    return (bf16x8){lo[0], lo[1], lo[2], lo[3], hi[0], hi[1], hi[2], hi[3]};
}
constexpr int XP = 72;
__device__ __forceinline__ void ph_ssd1(const Args& a, LAS unsigned char* lds, int first, int stride, int wv) {
    const int tid = otid(wv), lane = tid & 63, w = __builtin_amdgcn_readfirstlane(tid >> 6), l15 = lane & 15, lq = lane >> 4;
    LAS bf16* R1 = (LAS bf16*)lds;
    LAS bf16* R2 = (LAS bf16*)(lds + 34816);
    LAS bf16* Xd = (LAS bf16*)(lds + 69632);
    LAS bf16* Xw = (LAS bf16*)(lds + 69632 + 18432);
    LAS float* acs = (LAS float*)(lds + 110592);
    LAS float* dts = (LAS float*)(lds + 114688);
    const bf16* X = WSP(bf16, WS_XBCC); const float* DT = WSP(float, WS_DT); float* ACS = WSP(float, WS_ACS); bf16* YD = WSP(bf16, WS_YDIAG); float* ST = WSP(float, WS_STATES);
    for (int u = first; u < NB * 32 * 4; u += stride) {
        const int g = u & 3, bc = u >> 2, t0 = bc * 128;
        ssd_stage128(X, t0, 2560 + g * 128, R1, tid);
        ssd_stage128(X, t0, 2048 + g * 128, R2, tid);
        { const int h = g * 8 + w; const float Ah = -__expf(a.in[I_ALOG][h]);
          const float d0 = DT[(size_t)(t0 + 2 * lane) * 32 + h], d1 = DT[(size_t)(t0 + 2 * lane + 1) * 32 + h];
          const float a0 = d0 * Ah, a1 = d1 * Ah; float s = a0 + a1;
#pragma unroll
          for (int o = 1; o < 64; o <<= 1) { const float t = __shfl_up(s, o); if (lane >= o) s += t; }
          acs[w * 128 + 2 * lane] = s - a1; acs[w * 128 + 2 * lane + 1] = s; dts[w * 128 + 2 * lane] = d0; dts[w * 128 + 2 * lane + 1] = d1;
          float* ag = ACS + ((size_t)bc * 32 + h) * 128; ag[2 * lane] = s - a1; ag[2 * lane + 1] = s; }
        u32x4 xv[2];
#pragma unroll
        for (int i = 0; i < 2; ++i) { const int q = tid + NTHR * i; xv[i] = *(const u32x4*)(X + (size_t)(t0 + (q >> 3)) * XBCW + (g * 8) * 64 + (q & 7) * 8); }
        __syncthreads();
        f32x4 S[8];
#pragma unroll
        for (int mt = 0; mt < 8; ++mt) { S[mt] = (f32x4){0.f, 0.f, 0.f, 0.f};
#pragma unroll
            for (int ks = 0; ks < 4; ++ks) S[mt] = __builtin_amdgcn_mfma_f32_16x16x32_bf16(SSD_FRAG(R2, 16 * mt + l15, 32 * ks + 8 * lq), SSD_FRAG(R1, 16 * w + l15, 32 * ks + 8 * lq), S[mt], 0, 0, 0); }
        __syncthreads();
        LAS bf16* G = R1;
#pragma unroll 1
        for (int hh = 0; hh < 8; ++hh) {
            const int h = g * 8 + hh; const LAS float* ac = acs + hh * 128; const float aend = ac[127];
#pragma unroll
            for (int i = 0; i < 2; ++i) { const int q = tid + NTHR * i, l = q >> 3, ch = q & 7; const u32x4 v = xv[i];
                const float dl = dts[hh * 128 + l], wl = dl * __expf(aend - ac[l]);
                const float x8[8] = {bflo(v.x), bfhi(v.x), bflo(v.y), bfhi(v.y), bflo(v.z), bfhi(v.z), bflo(v.w), bfhi(v.w)};
                u32x4 o1, o2; o1.x = pk2(x8[0] * dl, x8[1] * dl); o1.y = pk2(x8[2] * dl, x8[3] * dl); o1.z = pk2(x8[4] * dl, x8[5] * dl); o1.w = pk2(x8[6] * dl, x8[7] * dl);
                o2.x = pk2(x8[0] * wl, x8[1] * wl); o2.y = pk2(x8[2] * wl, x8[3] * wl); o2.z = pk2(x8[4] * wl, x8[5] * wl); o2.w = pk2(x8[6] * wl, x8[7] * wl);
                *(LAS u32x4*)(Xd + l * XP + ch * 8) = o1; *(LAS u32x4*)(Xw + l * XP + ch * 8) = o2; }
            if (hh < 7) {
#pragma unroll
                for (int i = 0; i < 2; ++i) { const int q = tid + NTHR * i; xv[i] = *(const u32x4*)(X + (size_t)(t0 + (q >> 3)) * XBCW + (h + 1) * 64 + (q & 7) * 8); } }
            { const int l = 16 * w + l15; const float al = ac[l];
#pragma unroll
              for (int mt = 0; mt < 8; ++mt) { float gv[4];
#pragma unroll
                  for (int r = 0; r < 4; ++r) { const int s_ = 16 * mt + 4 * lq + r; gv[r] = (s_ <= l) ? S[mt][r] * __expf(al - ac[s_]) : 0.f; }
                  u32x2 pk; pk.x = pk2(gv[0], gv[1]); pk.y = pk2(gv[2], gv[3]);
                  *(LAS u32x2*)(G + l * SP + 16 * mt + 4 * lq) = pk; } }
            __syncthreads();
#pragma unroll
            for (int pt = 0; pt < 4; ++pt) { f32x4 acc = {0.f, 0.f, 0.f, 0.f};
#pragma unroll
                for (int ks = 0; ks < 4; ++ks) acc = __builtin_amdgcn_mfma_f32_16x16x32_bf16(ssd_frag_t(Xd, XP, 32 * ks, 16 * pt, lane), SSD_FRAG(G, 16 * w + l15, 32 * ks + 8 * lq), acc, 0, 0, 0);
                u32x2 pk; pk.x = pk2(acc[0], acc[1]); pk.y = pk2(acc[2], acc[3]);
                *(u32x2*)(YD + (size_t)(t0 + 16 * w + l15) * DM + h * 64 + 16 * pt + 4 * lq) = pk; }
#pragma unroll
            for (int pt = 0; pt < 4; ++pt) { f32x4 acc = {0.f, 0.f, 0.f, 0.f};
#pragma unroll
                for (int ks = 0; ks < 4; ++ks) acc = __builtin_amdgcn_mfma_f32_16x16x32_bf16(ssd_frag_t(R2, SP, 32 * ks, 16 * w, lane), ssd_frag_t(Xw, XP, 32 * ks, 16 * pt, lane), acc, 0, 0, 0);
                *(f32x4*)(ST + (((size_t)bc * 32 + h) * 64 + 16 * pt + l15) * 128 + 16 * w + 4 * lq) = acc; }
            __syncthreads();
        }
    }
}
__device__ __forceinline__ void ph_ssd2(const Args& a, int vcu, int G, int wv) {
    const int gt = vcu * NTHR + otid(wv), NGT = G * NTHR; float* ST = WSP(float, WS_STATES); const float* ACS = WSP(float, WS_ACS);
    for (int it = gt; it < NB * 32 * 2048; it += NGT) { const int q = it & 2047, bh = it >> 11, b = bh >> 5, h = bh & 31;
        f32x4 run = {0.f, 0.f, 0.f, 0.f};
#pragma unroll 4
        for (int c = 0; c < 32; ++c) { const size_t bc = (size_t)b * 32 + c; f32x4* p = (f32x4*)(ST + (bc * 32 + h) * 8192) + q; const f32x4 s = *p; const float dec = __expf(ACS[(bc * 32 + h) * 128 + 127]);
            *p = run; run = run * dec + s; } }
}
__device__ __forceinline__ void ph_ssd3(const Args& a, LAS unsigned char* lds, int first, int stride, int wv) {
    const int tid = otid(wv), lane = tid & 63, w = __builtin_amdgcn_readfirstlane(tid >> 6), l15 = lane & 15, lq = lane >> 4;
    LAS bf16* Cs = (LAS bf16*)lds; LAS bf16* Pv = (LAS bf16*)(lds + 34816); LAS float* acs = (LAS float*)(lds + 104448);
    const bf16* X = WSP(bf16, WS_XBCC); const float* ACS = WSP(float, WS_ACS); const bf16* YD = WSP(bf16, WS_YDIAG); const float* ST = WSP(float, WS_STATES);
    const bf16* Z = WSP(bf16, WS_Z); bf16* YB = WSP(bf16, WS_YBUF); const float* dskip = a.in[I_DSKIP]; const float* nw = a.in[I_SSDNW];
    for (int u = first; u < NB * 32 * 4; u += stride) {
        const int g = u & 3, bc = u >> 2, t0 = bc * 128;
        ssd_stage128(X, t0, 2560 + g * 128, Cs, tid);
#pragma unroll
        for (int i = 0; i < 2; ++i) { const int q = tid + NTHR * i; acs[q] = ACS[((size_t)bc * 32 + g * 8 + (q >> 7)) * 128 + (q & 127)]; }
        __syncthreads();
        const int l = 16 * w + l15; const size_t t = (size_t)t0 + l; float ss = 0.f;
        f32x4 pvv[4];
#pragma unroll
        for (int i = 0; i < 4; ++i) { const int q = tid + NTHR * i; pvv[i] = *(const f32x4*)(ST + ((size_t)bc * 32 + g * 8) * 8192 + (q >> 5) * 128 + (q & 31) * 4); }
#pragma unroll 1
        for (int hh = 0; hh < 8; ++hh) {
            const int h = g * 8 + hh;
#pragma unroll
            for (int i = 0; i < 4; ++i) { const int q = tid + NTHR * i, p = q >> 5, n4 = (q & 31) * 4; u32x2 pk; pk.x = pk2(pvv[i][0], pvv[i][1]); pk.y = pk2(pvv[i][2], pvv[i][3]);
                *(LAS u32x2*)(Pv + p * SP + n4) = pk; }
            if (hh < 7) {
#pragma unroll
                for (int i = 0; i < 4; ++i) { const int q = tid + NTHR * i; pvv[i] = *(const f32x4*)(ST + ((size_t)bc * 32 + h + 1) * 8192 + (q >> 5) * 128 + (q & 31) * 4); } }
            u32x2 ydv[4], xsv[4], zzv[4];
#pragma unroll
            for (int pt = 0; pt < 4; ++pt) { const int col = h * 64 + 16 * pt + 4 * lq; ydv[pt] = *(const u32x2*)(YD + t * DM + col); xsv[pt] = *(const u32x2*)(X + t * XBCW + col); zzv[pt] = *(const u32x2*)(Z + t * DM + col); }
            __syncthreads();
            const float ea = __expf(acs[hh * 128 + l]), dsk = dskip[h];
#pragma unroll
            for (int pt = 0; pt < 4; ++pt) { f32x4 acc = {0.f, 0.f, 0.f, 0.f};
#pragma unroll
                for (int ks = 0; ks < 4; ++ks) acc = __builtin_amdgcn_mfma_f32_16x16x32_bf16(SSD_FRAG(Pv, 16 * pt + l15, 32 * ks + 8 * lq), SSD_FRAG(Cs, 16 * w + l15, 32 * ks + 8 * lq), acc, 0, 0, 0);
                const int col = h * 64 + 16 * pt + 4 * lq;
                const float ydf[4] = {bflo(ydv[pt].x), bfhi(ydv[pt].x), bflo(ydv[pt].y), bfhi(ydv[pt].y)}, xv[4] = {bflo(xsv[pt].x), bfhi(xsv[pt].x), bflo(xsv[pt].y), bfhi(xsv[pt].y)}, zv[4] = {bflo(zzv[pt].x), bfhi(zzv[pt].x), bflo(zzv[pt].y), bfhi(zzv[pt].y)}; float uu[4];
#pragma unroll
                for (int r = 0; r < 4; ++r) { const float y = ydf[r] + ea * acc[r] + dsk * xv[r]; uu[r] = y * siluf_(zv[r]); ss += uu[r] * uu[r]; }
                u32x2 pk; pk.x = pk2(uu[0], uu[1]); pk.y = pk2(uu[2], uu[3]); *(u32x2*)(YB + t * DM + col) = pk; }
            __syncthreads();
        }
        ss += __shfl_xor(ss, 16); ss += __shfl_xor(ss, 32);
        const float rstd = __builtin_amdgcn_rsqf(ss * (1.0f / 512.0f) + 1e-5f);
        VM_WAIT();
#pragma unroll 1
        for (int hh = 0; hh < 8; ++hh)
#pragma unroll
            for (int pt = 0; pt < 4; ++pt) { const int col = (g * 8 + hh) * 64 + 16 * pt + 4 * lq; u32x2* p = (u32x2*)(YB + t * DM + col); const u32x2 v = *p; const f32x4 wv = *(const f32x4*)(nw + col);
                u32x2 pk; pk.x = pk2(bflo(v.x) * rstd * wv[0], bfhi(v.x) * rstd * wv[1]); pk.y = pk2(bflo(v.y) * rstd * wv[2], bfhi(v.y) * rstd * wv[3]); *p = pk; }
        __syncthreads();
    }
}
__device__ __forceinline__ void ph_attn_combine(const Args& a, int vcu, int G, int wv) {
    const int tid = otid(wv), lane = tid & 63, wave = __builtin_amdgcn_readfirstlane(tid >> 6), gw = vcu * NWAVES + wave, NGW = G * NWAVES;
    float d1 = a.in[I_LQ1][lane] * a.in[I_LK1][lane], d2 = a.in[I_LQ2][lane] * a.in[I_LK2][lane]; d1 = wave_sum(d1); d2 = wave_sum(d2);
    const float lam = __expf(d1) - __expf(d2) + 0.2f;
    const bf16* OA = WSP(bf16, WS_OATT); bf16* OF = WSP(bf16, WS_OFIN); const float* sw = a.in[I_SUBLN];
    const int head = lane >> 2, dq = (lane & 3) * 32;
    for (int m = gw; m < MT; m += NGW) { const bf16* p0 = OA + (size_t)m * 4096 + (2 * head) * 128 + dq; const bf16* p1 = p0 + 128; float d[32]; float ss = 0.f;
#pragma unroll
        for (int i = 0; i < 4; ++i) { const u32x4 x = *(const u32x4*)(p0 + 8 * i), y = *(const u32x4*)(p1 + 8 * i);
            const unsigned xa[4] = {x.x, x.y, x.z, x.w}, ya[4] = {y.x, y.y, y.z, y.w};
#pragma unroll
            for (int j = 0; j < 4; ++j) { const float v0 = bflo(xa[j]) - lam * bflo(ya[j]), v1 = bfhi(xa[j]) - lam * bfhi(ya[j]); d[8 * i + 2 * j] = v0; d[8 * i + 2 * j + 1] = v1; ss += v0 * v0 + v1 * v1; } }
        ss += __shfl_xor(ss, 1); ss += __shfl_xor(ss, 2);
        const float rstd = 0.8f / sqrtf(ss * (1.0f / 128.0f) + 1e-5f);
        bf16* o = OF + (size_t)m * DM + head * 128 + dq;
#pragma unroll
        for (int i = 0; i < 4; ++i) { const f32x4 w0 = *(const f32x4*)(sw + dq + 8 * i), w1 = *(const f32x4*)(sw + dq + 8 * i + 4);
            u32x4 pk; pk.x = pk2(d[8 * i] * rstd * w0[0], d[8 * i + 1] * rstd * w0[1]); pk.y = pk2(d[8 * i + 2] * rstd * w0[2], d[8 * i + 3] * rstd * w0[3]);
            pk.z = pk2(d[8 * i + 4] * rstd * w1[0], d[8 * i + 5] * rstd * w1[1]); pk.w = pk2(d[8 * i + 6] * rstd * w1[2], d[8 * i + 7] * rstd * w1[3]);
            *(u32x4*)(o + 8 * i) = pk; } }
}
__device__ __forceinline__ void ph_rows1(const Args& a, int vcu, int G, int wv) {
    const int tid = otid(wv), lane = tid & 63, wave = __builtin_amdgcn_readfirstlane(tid >> 6), gw = vcu * NWAVES + wave, NGW = G * NWAVES;
    const float* mod = WSP(float, WS_MOD); const float* x = a.in[I_X]; const float* mix = WSP(float, WS_MIX); float* X1 = WSP(float, WS_X1); unsigned char* H2 = WSP(unsigned char, WS_H2); float* RS = WSP(float, WS_RSTD);
    const float* gpm = a.in[I_GPOSTMIX]; const float* gpf = a.in[I_GPREFFN];
    for (int m = gw; m < MT; m += NGW) { const int b = m / SEQ; const float* mb = mod + b * 12288;
        f32x4 v[8]; float s = 0.f;
#pragma unroll
        for (int j = 0; j < 8; ++j) { v[j] = *((const f32x4*)(mix + (size_t)m * DM) + lane + 64 * j); s += (v[j].x * v[j].x + v[j].y * v[j].y) + (v[j].z * v[j].z + v[j].w * v[j].w); }
        const float rstdm = 1.0f / sqrtf(wave_sum(s) * (1.0f / DM) + 1e-6f); float s1 = 0.f;
#pragma unroll
        for (int j = 0; j < 8; ++j) { const int o4 = lane + 64 * j; const f32x4 xx = *((const f32x4*)(x + (size_t)m * DM) + o4), gg = *((const f32x4*)gpm + o4), gt = *((const f32x4*)(mb + 4096) + o4);
            v[j] = xx + gt * (v[j] * rstdm * gg); *((f32x4*)(X1 + (size_t)m * DM) + o4) = v[j]; s1 += (v[j].x * v[j].x + v[j].y * v[j].y) + (v[j].z * v[j].z + v[j].w * v[j].w); }
        const float rstd1 = 1.0f / sqrtf(wave_sum(s1) * (1.0f / DM) + 1e-6f);
        if (lane == 0) RS[m] = rstd1;
#pragma unroll
        for (int j = 0; j < 8; ++j) { const int o4 = lane + 64 * j; const f32x4 gg = *((const f32x4*)gpf + o4), sc = *((const f32x4*)(mb + 8192) + o4), sh = *((const f32x4*)(mb + 6144) + o4);
            const f32x4 y = v[j] * rstd1 * gg * (sc + 1.0f) + sh; *((unsigned*)(H2 + (size_t)m * DM) + o4) = pk4_fp8(y.x, y.y, y.z, y.w); } }
}
__device__ __forceinline__ void ph_router(const Args& a, LAS unsigned char* lds, int first, int stride, int wv) {
    const int tid = otid(wv), lane = tid & 63, w = __builtin_amdgcn_readfirstlane(tid >> 6), r32 = lane & 31, hi = lane >> 5;
    LAS float* part = (LAS float*)lds;
    LAS float* lg = (LAS float*)(lds + 8 * 32 * 33 * 4);
    const float* X1 = WSP(float, WS_X1); const float* WR = WSP(float, WS_WR); const float* RS = WSP(float, WS_RSTD); const float* CB = (const float*)(a.ws + WS_MOD * MiB + MOD_CB);
    unsigned* cnt = (unsigned*)(a.ws + WS_CTL * MiB) + CW_CNT;
    int* ltok = (int*)(a.ws + WS_LISTS * MiB); float* lw = (float*)(a.ws + WS_LISTS * MiB + LIST_STRIDE); int* ldst = (int*)(a.ws + WS_LISTS * MiB + 2 * LIST_STRIDE);
    for (int tile = first; tile < MT / 32; tile += stride) {
        const int tok0 = tile * 32, b = tok0 / SEQ; const int kb = w * 256;
        const float* xr = X1 + (size_t)(tok0 + r32) * DM + kb; const float* wb = WR + ((size_t)b * DM + kb) * NE;
        f32x16 acc = {};
#pragma unroll 4
        for (int q = 0; q < 64; ++q) { const f32x4 xv = *(const f32x4*)(xr + 4 * q);
            const float a0 = hi ? xv[1] : xv[0], a1 = hi ? xv[3] : xv[2];
            const float b0 = wb[(4 * q + hi) * NE + r32], b1 = wb[(4 * q + 2 + hi) * NE + r32];
            acc = __builtin_amdgcn_mfma_f32_32x32x2f32(a0, b0, acc, 0, 0, 0);
            acc = __builtin_amdgcn_mfma_f32_32x32x2f32(a1, b1, acc, 0, 0, 0); }
#pragma unroll
        for (int r = 0; r < 16; ++r) part[(w * 32 + (r & 3) + 8 * (r >> 2) + 4 * hi) * 33 + r32] = acc[r];
        __syncthreads();
#pragma unroll
        for (int i = 0; i < 2; ++i) { const int o = tid + NTHR * i, tk = o >> 5, e = o & 31; float s = 0.f;
#pragma unroll
            for (int ww = 0; ww < 8; ++ww) s += part[(ww * 32 + tk) * 33 + e];
            lg[tk * 33 + e] = s * RS[tok0 + tk] + CB[b * NE + e]; }
        __syncthreads();
        if (tid < 32) { const int tk = tok0 + tid; float v[4]; int ix[4]; unsigned used = 0u;
#pragma unroll
            for (int k = 0; k < 4; ++k) { float best = -__builtin_inff(); int bi = 0;
                for (int e = 0; e < NE; ++e) { const float x = lg[tid * 33 + e]; if (!((used >> e) & 1u) && x > best) { best = x; bi = e; } }
                v[k] = best; ix[k] = bi; used |= 1u << bi; }
            float p[4], sum = 0.f;
#pragma unroll
            for (int k = 0; k < 4; ++k) { p[k] = __expf(v[k] - v[0]); sum += p[k]; }
            const float inv = 1.0f / sum;
#pragma unroll
            for (int k = 0; k < 4; ++k) { const int e = ix[k]; const unsigned pos = __hip_atomic_fetch_add(cnt + 64 * e, 1u, RLX_AGENT);
                ltok[e * 16384 + pos] = tk; lw[e * 16384 + pos] = p[k] * inv; ldst[e * 16384 + pos] = tk * 4 + k; } }
        __syncthreads();
    }
}
__device__ __forceinline__ void ph_final(const Args& a, int vcu, int G, int wv) {
    const int tid = otid(wv), lane = tid & 63, wave = __builtin_amdgcn_readfirstlane(tid >> 6), gw = vcu * NWAVES + wave, NGW = G * NWAVES;
    const float* mod = WSP(float, WS_MOD); const float* X1 = WSP(float, WS_X1); const bf16* YS = WSP(bf16, WS_YS); const float* gp = a.in[I_GPOSTFFN];
    for (int m = gw; m < MT; m += NGW) { const int b = m / SEQ; const float* mb = mod + b * 12288;
        f32x4 f[8]; float s = 0.f;
#pragma unroll
        for (int j = 0; j < 8; ++j) { f[j] = (f32x4){0.f, 0.f, 0.f, 0.f};
#pragma unroll
            for (int k = 0; k < 4; ++k) { const u32x2 v = *((const u32x2*)(YS + ((size_t)m * 4 + k) * DM) + lane + 64 * j); f[j] += (f32x4){bflo(v.x), bfhi(v.x), bflo(v.y), bfhi(v.y)}; }
            s += (f[j].x * f[j].x + f[j].y * f[j].y) + (f[j].z * f[j].z + f[j].w * f[j].w); }
        const float rstd = 1.0f / sqrtf(wave_sum(s) * (1.0f / DM) + 1e-6f);
#pragma unroll
        for (int j = 0; j < 8; ++j) { const int o4 = lane + 64 * j; const f32x4 xx = *((const f32x4*)(X1 + (size_t)m * DM) + o4), gg = *((const f32x4*)gp + o4), gt = *((const f32x4*)(mb + 10240) + o4);
            *((f32x4*)(a.out + (size_t)m * DM) + o4) = xx + gt * (f[j] * rstd * gg); } }
}
__device__ __forceinline__ void moe_table(const Args& a, LAS unsigned char* lds, int wv) {
    const int tid = otid(wv);
    LAS int* tab = (LAS int*)(lds + TAB_OFF); const unsigned* cnt = (const unsigned*)(a.ws + WS_CTL * MiB) + CW_CNT;
    __syncthreads();
    if (tid < 32) tab[tid] = (int)__hip_atomic_load(cnt + 64 * tid, RLX_AGENT);
    __syncthreads();
    if (tid == 0) { int s = 0; for (int e = 0; e < 32; ++e) { tab[32 + e] = s; s += (tab[e] + 255) >> 8; } tab[64] = s; }
    __syncthreads();
}

__global__ void __launch_bounds__(NTHR, 2) hybrid_fwd(Args a0) {
    typedef const __attribute__((address_space(4))) Args* kargp_t;
    Args a = a0;
#if defined(__HIP_DEVICE_COMPILE__)
#define ARGS() do { kargp_t q_ = (kargp_t)__builtin_amdgcn_kernarg_segment_ptr(); asm volatile("" : "+s"(q_)); a = *q_; } while (0)
#else
#define ARGS() do { } while (0)
#endif
    extern __shared__ __attribute__((aligned(16))) unsigned char lds_raw[];
    LAS unsigned char* lds = (LAS unsigned char*)lds_raw;
    volatile LAS unsigned* MISC = (volatile LAS unsigned*)(lds + MISC_OFF);
    int wv = __builtin_amdgcn_readfirstlane((int)threadIdx.x >> 6); asm volatile("" : "+s"(wv));
    const int tid = otid(wv); const int G = gridDim.x; const int bx = blockIdx.x;
    const int vcu = (G % 8 == 0) ? (bx % 8) * (G / 8) + bx / 8 : bx;
    for (int u = tid; u < (LDS_BYTES - MISC_OFF) / 4; u += NTHR) ((LAS unsigned*)(lds + MISC_OFF))[u] = 0u;
    __syncthreads();
    unsigned* ctl = (unsigned*)(a.ws + WS_CTL * MiB);
    XcdBarrier bar; bar.bar = ctl + CW_BAR; bar.x = 0; bar.st = nullptr;
    const int lo = a.ph_lo, hi = a.ph_hi;
    const bool fused = (hi - lo) > 1;
    if (fused) bar = xcd_barrier_post(ctl + CW_BAR, MISC + 8, tid == 0);
#ifndef ONLY_PHASE
#define ONLY_PHASE -1
#endif
#define IN(k) ((ONLY_PHASE < 0 || ONLY_PHASE == (k)) && lo <= (k) && (k) < hi)
#define REPEAT(n, body) do { body; if constexpr ((n) > 1) { if (fused) xcd_barrier(bar, otid(wv) == 0); else __syncthreads(); body; } } while (0)
#define SEAM(k) do { if (IN(k) && IN((k) + 1)) xcd_barrier(bar, otid(wv) == 0); } while (0)

    if (IN(0)) { ARGS(); REPEAT(REP_MOD, ph_mod(a, lds, wv)); } SEAM(0);
    if (IN(1)) { ARGS(); REPEAT(REP_PREP, ph_prep(a, lds, vcu, G, wv)); } SEAM(1);
    if (IN(2)) { ARGS();
        pg8::ProbDense P; P.init(WSP(bf16, WS_H), WSP(bf16, WS_WT_IN), MT, NPROJ, DM, G, bx);
        pg8::EpiInProj E{a.ws};
        REPEAT(REP_INPROJ, (pg8::gemm_phase<pg8::EpiInProj, pg8::ProbDense, true, false, 127, KREP_IN, EREP_IN>(lds, P, E, wv)));
    } SEAM(2);
    if (IN(3)) { ARGS(); ph_conv(a, vcu, G, wv); } SEAM(3);
    if (IN(4)) { ARGS();
        REPEAT(REP_SSD1, ph_ssd1(a, lds, bx, G, wv));
        __syncthreads();
        REPEAT(REP_ATTN, att::attn_phase((char*)lds_raw, WSP(bf16, WS_Q), WSP(bf16, WS_K), WSP(bf16, WS_V), WSP(bf16, WS_OATT), bx, G, wv));
    } SEAM(4);
    if (IN(5)) { ARGS(); ph_ssd2(a, vcu, G, wv); REPEAT(REP_COMB, ph_attn_combine(a, vcu, G, wv)); } SEAM(5);
    if (IN(6)) { ARGS(); REPEAT(REP_SSD3, ph_ssd3(a, lds, bx, G, wv)); } SEAM(6);
    if (IN(7)) { ARGS();
#define BR_BODY do { \
        { pg8::ProbDense P; P.init(WSP(bf16, WS_YBUF), WSP(bf16, WS_WT_BS), MT, DM, DM, G, bx); \
          pg8::EpiBr1 E{WSP(bf16, WS_SGS), WSP(float, WS_M1)}; \
          pg8::gemm_phase<pg8::EpiBr1, pg8::ProbDense, true>(lds, P, E, wv); } \
        __syncthreads(); \
        { pg8::ProbDense P; P.init(WSP(bf16, WS_OFIN), WSP(bf16, WS_WT_BA), MT, DM, DM, G, bx); \
          pg8::EpiBr2 E{WSP(bf16, WS_SGA), WSP(float, WS_M1), WSP(bf16, WS_MERGED)}; \
          pg8::gemm_phase<pg8::EpiBr2, pg8::ProbDense, true>(lds, P, E, wv); } } while (0)
        REPEAT(REP_BR, BR_BODY);
#undef BR_BODY
    } SEAM(7);
    if (IN(8)) { ARGS();
        pg8::ProbDense P; P.init(WSP(bf16, WS_MERGED), WSP(bf16, WS_WT_OUT), MT, DM, DM, G, bx);
        pg8::EpiF32 E{WSP(float, WS_MIX), DM};
        REPEAT(REP_OUT, (pg8::gemm_phase<pg8::EpiF32, pg8::ProbDense, true>(lds, P, E, wv)));
    } SEAM(8);
    if (IN(9)) { ARGS(); REPEAT(REP_ROWS1, ph_rows1(a, vcu, G, wv)); } SEAM(9);
    if (IN(10)) { ARGS(); ph_router(a, lds, bx, G, wv); } SEAM(10);
    if (IN(11)) { ARGS();
        moe_table(a, lds, wv);
        pg8::ProbMoE<true> P; P.A = (const char*)WSP(bf16, WS_H2); P.Bt = (const char*)WSP(bf16, WS_WT_GU); P.rb = DM; P.nN = 16; P.estride = (size_t)4096 * DM;
        P.list_tok = (const int*)(a.ws + WS_LISTS * MiB); P.tab = (const LAS int*)(lds + TAB_OFF); P.G = G; P.c = vcu;
        pg8::EpiGateUp E{a.in[I_BGU], WSP(unsigned char, WS_ACT)};
        REPEAT(REP_GU, (pg8::gemm_phase<pg8::EpiGateUp, pg8::ProbMoE<true>, true, true, 127, KREP_GU, EREP_GU>(lds, P, E, wv)));
    } SEAM(11);
    if (IN(12)) { ARGS();
        moe_table(a, lds, wv);
        pg8::ProbMoE<false> P; P.A = (const char*)WSP(bf16, WS_ACT); P.Bt = (const char*)WSP(bf16, WS_WT_DN); P.rb = DM; P.nN = 8; P.estride = (size_t)DM * DM;
        P.list_tok = nullptr; P.tab = (const LAS int*)(lds + TAB_OFF); P.G = G; P.c = vcu;
        pg8::EpiDown E{a.in[I_BDN], (const int*)(a.ws + WS_LISTS * MiB + 2 * LIST_STRIDE), (const float*)(a.ws + WS_LISTS * MiB + LIST_STRIDE), (const LAS int*)(lds + TAB_OFF), WSP(bf16, WS_YS)};
        REPEAT(REP_DN, (pg8::gemm_phase<pg8::EpiDown, pg8::ProbMoE<false>, true, true, 127, KREP_DN, EREP_DN>(lds, P, E, wv)));
    } SEAM(12);
    if (IN(13)) { ARGS(); REPEAT(REP_FINAL, ph_final(a, vcu, G, wv)); }
#undef IN
#undef SEAM
#undef REPEAT
#undef ARGS
}

extern "C" void kernel_launch(void* const* d_in, const int* in_sizes, int n_in, void* d_out, int out_size, void* d_ws, size_t ws_size, hipStream_t stream) {
    static int grid = 0;
    if (grid == 0) {
        if (n_in != 29 || in_sizes[0] != MT * DM || out_size != MT * DM || ws_size < WS_END * MiB) {
            fprintf(stderr, "kernel_launch: unexpected shapes (n_in %d, in0 %d, out %d, ws %zu); nothing launched\n", n_in, n_in > 0 ? in_sizes[0] : -1, out_size, ws_size); grid = -1; return; }
        int dev = 0, cus = 0, per_cu = 0;
        if (hipGetDevice(&dev) != hipSuccess || hipDeviceGetAttribute(&cus, hipDeviceAttributeMultiprocessorCount, dev) != hipSuccess) { grid = -1; return; }
        if (hipFuncSetAttribute((const void*)hybrid_fwd, hipFuncAttributeMaxDynamicSharedMemorySize, LDS_BYTES) != hipSuccess) { fprintf(stderr, "kernel_launch: hipFuncSetAttribute failed\n"); grid = -1; return; }
        if (hipOccupancyMaxActiveBlocksPerMultiprocessor(&per_cu, (const void*)hybrid_fwd, NTHR, LDS_BYTES) != hipSuccess || per_cu < 1)
            fprintf(stderr, "kernel_launch: note: occupancy query reports %d workgroups per CU\n", per_cu);
        (void)hipGetLastError();
        grid = cus;
    }
    if (grid < 0) return;
    (void)hipMemsetAsync((char*)d_ws + WS_CTL * MiB, 0, CTL_ZERO_BYTES, stream);
    Args a{};
    for (int i = 0; i < 29; ++i) a.in[i] = (const float*)d_in[i];
    a.out = (float*)d_out; a.ws = (unsigned char*)d_ws;
#if MK_PER_PHASE
    for (int k = 0; k < NPH; ++k) { a.ph_lo = k; a.ph_hi = k + 1; hipLaunchKernelGGL(hybrid_fwd, dim3(grid), dim3(NTHR), LDS_BYTES, stream, a); }
#else
    a.ph_lo = 0; a.ph_hi = NPH;
    hipLaunchKernelGGL(hybrid_fwd, dim3(grid), dim3(NTHR), LDS_BYTES, stream, a);
#endif
    const hipError_t le = hipPeekAtLastError();
    if (le != hipSuccess) fprintf(stderr, "kernel_launch: launch failed: %s\n", hipGetErrorName(le));
}
```
